# Optimizing an MI355X kernel written in HIP

```python
import math
import jax, jax.numpy as jnp
from jax import lax
import numpy as np

D_MODEL = 1024
BATCH = 2
SEQ = 8192
DEPTH = 1

GRID_W = 64
CTX_LEN = 256
RET_HEADS = 4
RET_DK = D_MODEL // RET_HEADS
RET_DV = 2 * D_MODEL // RET_HEADS
RET_CHUNK = 128
DIFF_DH = 64
DIFF_HEADS = D_MODEL // (2 * DIFF_DH)
DIFF_DV = 2 * DIFF_DH
Q_BLOCK = 128
N_EXPERTS = 32
TOP_K = 4
D_FF = D_MODEL
SWIGLU_LIMIT = 7.0
SWIGLU_ALPHA = 1.702
MOE_BLOCK = 128
ROPE_BASE = 10000.0
EPS = 1e-6

RET_QK_W = RET_HEADS * RET_DK
RET_V_W = RET_HEADS * RET_DV
DIFF_QK_W = DIFF_HEADS * 2 * DIFF_DH
DIFF_V_W = DIFF_HEADS * DIFF_DV
IN_SPLITS = (RET_QK_W, RET_QK_W, RET_V_W, RET_V_W, DIFF_QK_W, DIFF_QK_W, DIFF_V_W, D_MODEL, D_MODEL)
IN_COLS = sum(IN_SPLITS)

kernel_name = "hybrid_retention_diffattn_moe_dit_block"


def _rmsnorm(x, g):
    xf = x.astype(jnp.float32)
    y = xf * lax.rsqrt(jnp.mean(xf * xf, axis=-1, keepdims=True) + EPS)
    return (y * g.astype(jnp.float32)).astype(x.dtype)


def _modulate(h, shift, scale):
    return h * (1.0 + scale) + shift


def _rope_axis(x, pos):
    half = x.shape[-1] // 2
    inv = ROPE_BASE ** (-jnp.arange(half, dtype=jnp.float32) / half)
    ang = pos.astype(jnp.float32)[:, None] * inv[None, :]
    cos, sin = jnp.cos(ang), jnp.sin(ang)
    x1 = x[..., :half].astype(jnp.float32)
    x2 = x[..., half:].astype(jnp.float32)
    return jnp.concatenate([x1 * cos - x2 * sin, x1 * sin + x2 * cos], axis=-1).astype(x.dtype)


def _rope_2d(x, row, col):
    d2 = x.shape[-1] // 2
    return jnp.concatenate([_rope_axis(x[..., :d2], row), _rope_axis(x[..., d2:], col)], axis=-1)


def _project(h, w_in):
    p = h @ w_in
    return jnp.split(p, np.cumsum(IN_SPLITS)[:-1].tolist(), axis=-1)


def _ret_heads(t, d):
    b, l, _ = t.shape
    return t.reshape(b, l, RET_HEADS, d).transpose(0, 2, 1, 3).astype(jnp.float32)


def _retention_scan(q, k, v, log_gamma, s0):
    b, h, l, _ = q.shape
    dv = v.shape[-1]
    n = l // RET_CHUNK

    def chunks(t):
        return t.reshape(b, h, n, RET_CHUNK, t.shape[-1]).transpose(2, 0, 1, 3, 4)

    j = jnp.arange(RET_CHUNK, dtype=jnp.float32)
    diff = j[:, None] - j[None, :]
    lg = log_gamma.astype(jnp.float32)
    decay_in = jnp.where(diff >= 0, jnp.exp(lg[:, None, None] * jnp.maximum(diff, 0.0)), 0.0)
    q_decay = jnp.exp(lg[:, None] * (j + 1.0))[:, :, None]
    k_decay = jnp.exp(lg[:, None] * (RET_CHUNK - 1.0 - j))[:, :, None]
    chunk_decay = jnp.exp(lg * RET_CHUNK)[:, None, None]

    def step(s, qkv):
        qc, kc, vc = qkv
        inner = jnp.einsum('bhid,bhjd->bhij', qc, kc) * decay_in
        o = jnp.einsum('bhij,bhjv->bhiv', inner, vc) + jnp.einsum('bhid,bhdv->bhiv', qc * q_decay, s)
        s = chunk_decay * s + jnp.einsum('bhjd,bhjv->bhdv', kc * k_decay, vc)
        return s, o

    s_fin, o = lax.scan(step, s0, (chunks(q), chunks(k), chunks(v)))
    return o.transpose(1, 2, 0, 3, 4).reshape(b, h, l, dv), s_fin


def _retention_bidir(q, k, v, log_g_fwd, log_g_bwd, s0_fwd, s0_bwd):
    o_f, s_f = _retention_scan(q, k, v, log_g_fwd, s0_fwd)
    flip = lambda t: t[:, :, ::-1]
    o_b, s_b = _retention_scan(flip(q), flip(k), flip(v), log_g_bwd, s0_bwd)
    return o_f + flip(o_b), s_f, s_b


def _diff_qk(t, g, row, col):
    b, l, _ = t.shape
    t = _rmsnorm(t.reshape(b, l, DIFF_HEADS, 2, DIFF_DH), g).transpose(0, 2, 3, 1, 4)
    if row is not None:
        t = _rope_2d(t, row, col)
    return t[:, :, 0], t[:, :, 1]


def _diff_attend(q1, q2, k1, k2, v, lam):
    scale = DIFF_DH ** -0.5
    s1 = jnp.einsum('bhqd,bhkd->bhqk', q1, k1).astype(jnp.float32) * scale
    s2 = jnp.einsum('bhqd,bhkd->bhqk', q2, k2).astype(jnp.float32) * scale
    a = jax.nn.softmax(s1, axis=-1) - lam * jax.nn.softmax(s2, axis=-1)
    return jnp.einsum('bhqk,bhkv->bhqv', a.astype(v.dtype), v)


def _diff_attend_blocks(q1, q2, k1, k2, v, lam):
    b, h, l, dh = q1.shape
    nb = l // Q_BLOCK
    blk = lambda t: t.reshape(b, h, nb, Q_BLOCK, dh).transpose(2, 0, 1, 3, 4)
    o = lax.map(lambda qq: _diff_attend(qq[0], qq[1], k1, k2, v, lam), (blk(q1), blk(q2)))
    return o.transpose(1, 2, 0, 3, 4).reshape(b, h, l, v.shape[-1])


def _moe(h, router_w, router_b, w1, b1, w2, b2):
    b, l, d = h.shape
    xt = h.reshape(-1, d)
    t = xt.shape[0]
    logits = (xt @ router_w + router_b).astype(jnp.float32)
    top_val, top_idx = lax.top_k(logits, TOP_K)
    gate = jax.nn.softmax(top_val, axis=-1)
    p = t * TOP_K
    expert_flat = top_idx.reshape(-1)
    order = jnp.argsort(expert_flat)
    sorted_e = expert_flat[order]
    counts = jnp.bincount(expert_flat, length=N_EXPERTS)
    padded = (counts + MOE_BLOCK - 1) // MOE_BLOCK * MOE_BLOCK
    pad_end = jnp.cumsum(padded)
    pad_start = pad_end - padded
    cnt_start = jnp.cumsum(counts) - counts
    dest = pad_start[sorted_e] + jnp.arange(p, dtype=jnp.int32) - cnt_start[sorted_e]
    n_blocks = -(-p // MOE_BLOCK) + N_EXPERTS
    rows = n_blocks * MOE_BLOCK
    row_tok = jnp.full((rows,), t, dtype=jnp.int32).at[dest].set((order // TOP_K).astype(jnp.int32))
    row_gate = jnp.zeros((rows,), jnp.float32).at[dest].set(gate.reshape(-1)[order])
    block_e = jnp.minimum(jnp.searchsorted(pad_end, jnp.arange(n_blocks) * MOE_BLOCK, side='right'),
                          N_EXPERTS - 1)
    x_pad = jnp.concatenate([xt, jnp.zeros((1, d), xt.dtype)], axis=0)
    xb = x_pad[row_tok].reshape(n_blocks, MOE_BLOCK, d)

    def expert_block(args):
        xblk, e = args
        hh = xblk @ w1[e] + b1[e]
        glu = jnp.minimum(hh[:, :D_FF], SWIGLU_LIMIT)
        lin = jnp.clip(hh[:, D_FF:], -SWIGLU_LIMIT, SWIGLU_LIMIT)
        act = glu * jax.nn.sigmoid(SWIGLU_ALPHA * glu) * (lin + 1.0)
        return act @ w2[e] + b2[e]

    yb = lax.map(expert_block, (xb, block_e)).reshape(rows, d)
    y = jax.ops.segment_sum(yb * row_gate[:, None].astype(yb.dtype), row_tok, num_segments=t + 1)[:t]
    return y.reshape(b, l, d)


def _layer(x, ctx, c, c_ctx, row, col, layer_idx, need_ctx_out,
           norm1_g, norm2_g, w_mod, b_mod, w_in, ret_decay_logit, ret_norm_g,
           diff_q_norm_g, diff_k_norm_g, diff_lambda, diff_norm_g,
           w_br_ret, w_br_diff, w_out, router_w, router_b, exp_w1, exp_b1, exp_w2, exp_b2):
    b, l, d = x.shape
    mod_l = (jax.nn.silu(c) @ w_mod + b_mod)[:, None, :]
    mod_c = (jax.nn.silu(c_ctx) @ w_mod + b_mod)[None, None, :]
    sh_a, sc_a, g_a, sh_f, sc_f, g_f = jnp.split(mod_l, 6, axis=-1)
    csh_a, csc_a, cg_a, csh_f, csc_f, cg_f = jnp.split(mod_c, 6, axis=-1)

    hl = _modulate(_rmsnorm(x, norm1_g), sh_a, sc_a)
    hc = _modulate(_rmsnorm(ctx, norm1_g), csh_a, csc_a)
    rq, rk, rv, rg, dq, dk, dv, ga, gb = _project(hl, w_in)
    crq, crk, crv, crg, cdq, cdk, cdv, cga, cgb = _project(hc, w_in)

    log_g = jax.nn.log_sigmoid(ret_decay_logit.astype(jnp.float32))
    qs = RET_DK ** -0.5
    lq = _rope_2d(_ret_heads(rq, RET_DK) * qs, row, col)
    lk = _rope_2d(_ret_heads(rk, RET_DK), row, col)
    lv = _ret_heads(rv, RET_DV)
    cq = _ret_heads(crq, RET_DK) * qs
    ck = _ret_heads(crk, RET_DK)
    cv = _ret_heads(crv, RET_DV)
    s0 = jnp.zeros((b, RET_HEADS, RET_DK, RET_DV), jnp.float32)
    ret_c, s_f, s_b = _retention_bidir(cq, ck, cv, log_g[0], log_g[1], s0, s0)
    ret_l, _, _ = _retention_bidir(lq, lk, lv, log_g[0], log_g[1], s_f, s_b)

    def ret_branch(o, gate):
        y = _rmsnorm(o, ret_norm_g[:, None, :])
        y = y.transpose(0, 2, 1, 3).reshape(o.shape[0], o.shape[2], RET_V_W).astype(gate.dtype)
        return (y * jax.nn.silu(gate)) @ w_br_ret

    lambda_init = 0.8 - 0.6 * math.exp(-0.3 * layer_idx)
    lp = diff_lambda.astype(jnp.float32)
    lam = jnp.exp(jnp.sum(lp[0] * lp[1])) - jnp.exp(jnp.sum(lp[2] * lp[3])) + lambda_init
    lq1, lq2 = _diff_qk(dq, diff_q_norm_g, row, col)
    lk1, lk2 = _diff_qk(dk, diff_k_norm_g, row, col)
    cq1, cq2 = _diff_qk(cdq, diff_q_norm_g, None, None)
    ck1, ck2 = _diff_qk(cdk, diff_k_norm_g, None, None)
    lvd = dv.reshape(b, l, DIFF_HEADS, DIFF_DV).transpose(0, 2, 1, 3)
    cvd = cdv.reshape(b, ctx.shape[1], DIFF_HEADS, DIFF_DV).transpose(0, 2, 1, 3)
    k1_all = jnp.concatenate([ck1, lk1], axis=2)
    k2_all = jnp.concatenate([ck2, lk2], axis=2)
    v_all = jnp.concatenate([cvd, lvd], axis=2)
    diff_l = _diff_attend_blocks(lq1, lq2, k1_all, k2_all, v_all, lam)

    def diff_branch(o):
        y = _rmsnorm(o, diff_norm_g) * (1.0 - lambda_init)
        y = y.transpose(0, 2, 1, 3).reshape(o.shape[0], o.shape[2], DIFF_V_W)
        return y @ w_br_diff

    def merge(yr, yd, gate_r, gate_d):
        return (jax.nn.sigmoid(gate_r) * yr + jax.nn.sigmoid(gate_d) * yd) @ w_out

    x_new = x + g_a * merge(ret_branch(ret_l, rg), diff_branch(diff_l), ga, gb)
    x_new = x_new + g_f * _moe(_modulate(_rmsnorm(x_new, norm2_g), sh_f, sc_f),
                               router_w, router_b, exp_w1, exp_b1, exp_w2, exp_b2)
    if need_ctx_out:
        diff_c = _diff_attend(cq1, cq2, ck1, ck2, cvd, lam)
        ctx = ctx + cg_a * merge(ret_branch(ret_c, crg), diff_branch(diff_c), cga, cgb)
        ctx = ctx + cg_f * _moe(_modulate(_rmsnorm(ctx, norm2_g), csh_f, csc_f),
                                router_w, router_b, exp_w1, exp_b1, exp_w2, exp_b2)
    return x_new, ctx


def setup_inputs(seed: int = 0) -> dict:
    key = jax.random.key(seed)
    ks = jax.random.split(key, 32)
    f32 = jnp.float32
    nrm = lambda k, shape, s: jax.random.normal(k, shape, f32) * s
    decay_base = jnp.asarray(np.log(2.0 ** (5 + np.arange(RET_HEADS)) - 1.0), f32)
    return {
        "x": nrm(ks[0], (BATCH, SEQ, D_MODEL), 1.0),
        "c": nrm(ks[1], (BATCH, D_MODEL), 1.0),
        "ctx": nrm(ks[2], (BATCH, CTX_LEN, D_MODEL), 1.0),
        "c_ctx": nrm(ks[3], (D_MODEL,), 1.0),
        "norm1_g": 1.0 + nrm(ks[4], (DEPTH, D_MODEL), 0.1),
        "norm2_g": 1.0 + nrm(ks[5], (DEPTH, D_MODEL), 0.1),
        "w_mod": nrm(ks[6], (DEPTH, D_MODEL, 6 * D_MODEL), 0.5 * D_MODEL ** -0.5),
        "b_mod": nrm(ks[7], (DEPTH, 6 * D_MODEL), 0.02),
        "w_in": nrm(ks[8], (DEPTH, D_MODEL, IN_COLS), D_MODEL ** -0.5),
        "ret_decay_logit": decay_base[None, None, :] + nrm(ks[9], (DEPTH, 2, RET_HEADS), 0.1),
        "ret_norm_g": 1.0 + nrm(ks[10], (DEPTH, RET_HEADS, RET_DV), 0.1),
        "diff_q_norm_g": 1.0 + nrm(ks[11], (DEPTH, DIFF_DH), 0.1),
        "diff_k_norm_g": 1.0 + nrm(ks[12], (DEPTH, DIFF_DH), 0.1),
        "diff_lambda": nrm(ks[13], (DEPTH, 4, DIFF_DH), 0.1),
        "diff_norm_g": 1.0 + nrm(ks[14], (DEPTH, DIFF_DV), 0.1),
        "w_br_ret": nrm(ks[15], (DEPTH, RET_V_W, D_MODEL), RET_V_W ** -0.5),
        "w_br_diff": nrm(ks[16], (DEPTH, DIFF_V_W, D_MODEL), DIFF_V_W ** -0.5),
        "w_out": nrm(ks[17], (DEPTH, D_MODEL, D_MODEL), D_MODEL ** -0.5),
        "router_w": nrm(ks[18], (DEPTH, D_MODEL, N_EXPERTS), D_MODEL ** -0.5),
        "router_b": nrm(ks[19], (DEPTH, N_EXPERTS), 0.01),
        "exp_w1": nrm(ks[20], (DEPTH, N_EXPERTS, D_MODEL, 2 * D_FF), D_MODEL ** -0.5),
        "exp_b1": nrm(ks[21], (DEPTH, N_EXPERTS, 2 * D_FF), 0.02),
        "exp_w2": nrm(ks[22], (DEPTH, N_EXPERTS, D_FF, D_MODEL), D_FF ** -0.5),
        "exp_b2": nrm(ks[23], (DEPTH, N_EXPERTS, D_MODEL), 0.02),
    }


def reference(x, c, ctx, c_ctx, norm1_g, norm2_g, w_mod, b_mod, w_in, ret_decay_logit, ret_norm_g,
              diff_q_norm_g, diff_k_norm_g, diff_lambda, diff_norm_g, w_br_ret, w_br_diff, w_out,
              router_w, router_b, exp_w1, exp_b1, exp_w2, exp_b2):
    n_tok = x.shape[1]
    ROWS = n_tok // GRID_W
    row = jnp.repeat(jnp.arange(ROWS, dtype=jnp.int32), GRID_W)
    col = jnp.tile(jnp.arange(GRID_W, dtype=jnp.int32), ROWS)
    for i in range(DEPTH):
        x, ctx = _layer(x, ctx, c, c_ctx, row, col, i, i < DEPTH - 1,
                        norm1_g[i], norm2_g[i], w_mod[i], b_mod[i], w_in[i], ret_decay_logit[i], ret_norm_g[i],
                        diff_q_norm_g[i], diff_k_norm_g[i], diff_lambda[i], diff_norm_g[i],
                        w_br_ret[i], w_br_diff[i], w_out[i], router_w[i], router_b[i],
                        exp_w1[i], exp_b1[i], exp_w2[i], exp_b2[i])
    return x
```

```cpp
#include <hip/hip_runtime.h>
#include <hip/hip_cooperative_groups.h>
#include <cstdio>
#include <cstdint>
namespace cg = cooperative_groups;

#ifndef MK_ONE_LAUNCH
#define MK_ONE_LAUNCH 1
#endif

#define DEVI __device__ __forceinline__
#define LAS __attribute__((address_space(3)))
typedef unsigned short bf16_t;
typedef short bf16x8 __attribute__((ext_vector_type(8)));
typedef short s16x4 __attribute__((ext_vector_type(4)));
typedef float f32x4 __attribute__((ext_vector_type(4)));
typedef float f32x16 __attribute__((ext_vector_type(16)));
typedef unsigned u32x4 __attribute__((ext_vector_type(4)));
typedef unsigned u32x2 __attribute__((ext_vector_type(2)));

constexpr int NB = 2, LSEQ = 8192, CTXL = 256, SEQ = LSEQ + CTXL;
constexpr int T = NB * LSEQ;
constexpr int TT = NB * SEQ;
constexpr int DM = 1024, NP = 11264;
constexpr int C_RQ = 0, C_RK = 1024, C_RV = 2048, C_RG = 4096, C_DQ = 6144, C_DK = 7168, C_DV = 8192, C_GA = 9216, C_GB = 10240;
constexpr int NE = 32, CAP = 16384, MAXTILES = 288;
constexpr float EPS = 1e-6f;
constexpr float LOG2E = 1.4426950408889634f;

constexpr size_t al256(size_t x) { return (x + 255) / 256 * 256; }
constexpr size_t WS_CNT = 0;
constexpr size_t WS_Q = 1024;
constexpr size_t WS_BAR = 4096;
constexpr size_t WS_ZERO_BYTES = 4096 + 16384;
constexpr size_t WS_MOD = WS_ZERO_BYTES;
constexpr size_t WS_SCAL = al256(WS_MOD + 3 * 6144 * 4);
constexpr size_t WS_TABR = WS_SCAL + 256;
constexpr size_t WS_TABD = WS_TABR + 128 * 64 * 8;
constexpr size_t WS_WIN = al256(WS_TABD + 128 * 16 * 8);
constexpr size_t WS_WBR = WS_WIN + (size_t)NP * DM * 2;
constexpr size_t WS_WBD = WS_WBR + (size_t)1024 * 2048 * 2;
constexpr size_t WS_WOUT = WS_WBD + (size_t)1024 * 1024 * 2;
constexpr size_t WS_W1 = WS_WOUT + (size_t)1024 * 1024 * 2;
constexpr size_t WS_W2 = WS_W1 + (size_t)NE * 2048 * 1024 * 2;
constexpr size_t WS_HL = WS_W2 + (size_t)NE * 1024 * 1024 * 2;
constexpr size_t WS_P = WS_HL + (size_t)TT * DM * 2;
constexpr size_t WS_KT = WS_P + (size_t)TT * NP * 2;
constexpr size_t WS_VT = WS_KT + (size_t)NB * 1024 * SEQ * 2;
constexpr size_t WS_OI = WS_VT + (size_t)NB * 2048 * SEQ * 2;
constexpr size_t WS_OF = WS_OI + (size_t)T * 2048 * 2;
constexpr size_t WS_OB = WS_OF + (size_t)T * 2048 * 2;
constexpr size_t WS_OD = WS_OB + (size_t)T * 2048 * 2;
constexpr size_t WS_LTOK = WS_OD + (size_t)T * 1024 * 2;
constexpr size_t WS_LGATE = WS_LTOK + (size_t)NE * CAP * 4;
constexpr size_t WS_POS = WS_LGATE + (size_t)NE * CAP * 4;
constexpr size_t WS_DV = WS_POS + (size_t)T * 4 * 4;
constexpr size_t WS_DUMMY = WS_DV + (size_t)NB * 8 * SEQ * 128 * 2;
constexpr size_t WS_END = WS_DUMMY + (size_t)128 * 2048 * 2;
constexpr size_t WS_ACT = WS_P;
constexpr size_t WS_Y = WS_P + (size_t)MAXTILES * 256 * 1024 * 2;
static_assert(WS_Y + (size_t)MAXTILES * 256 * 1024 * 2 <= WS_KT, "act/y overlay must fit in P");
static_assert(WS_END <= ((size_t)1 << 30), "workspace must fit 1 GiB");

struct Params {
    const float *x, *c, *ctx, *c_ctx, *norm1_g, *norm2_g, *w_mod, *b_mod, *w_in, *ret_decay, *ret_norm_g, *dq_g, *dk_g, *dlam, *dn_g,
        *w_br_ret, *w_br_diff, *w_out, *router_w, *router_b, *w1, *b1, *w2, *b2;
    float* out; unsigned char* ws;
    int ph_lo, ph_hi;
};

DEVI float bf2f(unsigned u) { return __uint_as_float(u << 16); }
DEVI unsigned f2bf(float f) { unsigned u = __float_as_uint(f); return (u + 0x7fffu + ((u >> 16) & 1u)) >> 16; }
typedef __bf16 bf16x2_t __attribute__((ext_vector_type(2)));
typedef float f32x2_t __attribute__((ext_vector_type(2)));
DEVI unsigned pk2(float lo, float hi) { const f32x2_t v = {lo, hi}; const bf16x2_t b = __builtin_convertvector(v, bf16x2_t); return __builtin_bit_cast(unsigned, b); }
DEVI unsigned pk2a(float lo, float hi) { unsigned r; asm volatile("v_cvt_pk_bf16_f32 %0, %1, %2" : "=v"(r) : "v"(lo), "v"(hi)); return r; }
DEVI float lo_f(unsigned w) { return __uint_as_float(w << 16); }
DEVI float hi_f(unsigned w) { return __uint_as_float(w & 0xffff0000u); }
DEVI float wave_sum(float v) {
#pragma unroll
    for (int o = 1; o < 64; o <<= 1) v += __shfl_xor(v, o);
    return v;
}
DEVI int lane_id_fresh() { int l; asm volatile("v_mbcnt_lo_u32_b32 %0, -1, 0\n\tv_mbcnt_hi_u32_b32 %0, -1, %0" : "=v"(l)); return l; }
DEVI float sigmoidf_(float x) { return __builtin_amdgcn_rcpf(1.f + __builtin_amdgcn_exp2f(-x * LOG2E)); }
DEVI float siluf_(float x) { return x * sigmoidf_(x); }
#define LDS_WAIT() asm volatile("s_waitcnt lgkmcnt(0)" ::: "memory")
#define VM_WAIT() asm volatile("s_waitcnt vmcnt(0)" ::: "memory")


#define XB_TMO      128
#define XB_XCNT(j)  (256  + 64 * (j))
#define XB_XSUB(j)  (1280 + 64 * (j))
#define XB_XGEN(j)  (2304 + 64 * (j))
#define XB_TOP      3328
#define XB_TOPGEN   3392
#define XCD_BAR_WORDS 3456
#define XB_SPIN_CAP (1u << 18)
DEVI unsigned xb_ld(unsigned* p)              { return __hip_atomic_load(p, __ATOMIC_RELAXED, __HIP_MEMORY_SCOPE_AGENT); }
DEVI unsigned xb_add(unsigned* p, unsigned v) { return __hip_atomic_fetch_add(p, v, __ATOMIC_RELAXED, __HIP_MEMORY_SCOPE_AGENT); }
DEVI unsigned xb_xcc_id() { return (unsigned)__builtin_amdgcn_s_getreg((3 << 11) | 20) & 0xFu; }
#define XB_SPIN(cond, bar) do { unsigned _sp = 0; while (cond) { __builtin_amdgcn_s_sleep(1); \
    if ((++_sp & 255u) == 0u) { if (xb_ld(&(bar)[XB_TMO])) break; if (_sp > XB_SPIN_CAP) { atomicAdd(&(bar)[XB_TMO], 1u); break; } } } } while (0)
struct XcdBarrier { unsigned* bar; unsigned x; volatile LAS unsigned* st; };
DEVI XcdBarrier xcd_barrier_post(unsigned* bar, volatile LAS unsigned* st) {
    XcdBarrier b; b.bar = bar; b.x = xb_xcc_id(); b.st = st;
    if (threadIdx.x == 0) (void)xb_add(&bar[XB_XCNT(b.x)], 1u);
    return b;
}
DEVI void xcd_barrier_complete(unsigned* bar, unsigned x, unsigned& nloc, unsigned& nx) {
    const unsigned G = gridDim.x * gridDim.y * gridDim.z;
    unsigned sum, cnt, mine, sp = 0u;
    for (;;) {
        sum = 0u; cnt = 0u; mine = 0u;
#pragma unroll
        for (unsigned j = 0; j < 16; ++j) { const unsigned c = xb_ld(&bar[XB_XCNT(j)]); sum += c; cnt += (c > 0u) ? 1u : 0u; mine = (j == x) ? c : mine; }
        if (sum == G) break;
        __builtin_amdgcn_s_sleep(1);
        if ((++sp & 255u) == 0u) { if (xb_ld(&bar[XB_TMO])) break; if (sp > XB_SPIN_CAP) { atomicAdd(&bar[XB_TMO], 1u); break; } }
    }
    nloc = mine > 0u ? mine : 1u; nx = cnt > 0u ? cnt : 1u;
}
DEVI void xcd_barrier(const XcdBarrier& b) {
    asm volatile("s_waitcnt vmcnt(0)" ::: "memory");
    __syncthreads();
    if (threadIdx.x == 0) {
        unsigned* bar = b.bar;
        __builtin_amdgcn_s_waitcnt(0);
        unsigned nloc = b.st[0], nx = b.st[1];
        if (nloc == 0u) { xcd_barrier_complete(bar, b.x, nloc, nx); b.st[0] = nloc; b.st[1] = nx; }
        const unsigned old = xb_add(&bar[XB_XSUB(b.x)], 1u);
        const unsigned gen = old / nloc;
        if (old + 1u == (gen + 1u) * nloc) {
            __builtin_amdgcn_fence(__ATOMIC_RELEASE, "agent");
            asm volatile("s_waitcnt vmcnt(0)" ::: "memory");
            const unsigned og = xb_add(&bar[XB_TOP], 1u);
            const unsigned tg = og / nx;
            if (og + 1u == (tg + 1u) * nx) xb_add(&bar[XB_TOPGEN], 1u);
            else XB_SPIN(xb_ld(&bar[XB_TOPGEN]) == tg, bar);
            __builtin_amdgcn_fence(__ATOMIC_ACQUIRE, "agent");
            xb_add(&bar[XB_XGEN(b.x)], 1u);
            asm volatile("s_waitcnt vmcnt(0)" ::: "memory");
        } else {
            XB_SPIN(xb_ld(&bar[XB_XGEN(b.x)]) == gen, bar);
            __builtin_amdgcn_fence(__ATOMIC_ACQUIRE, "agent");
            asm volatile("s_waitcnt vmcnt(0)" ::: "memory");
        }
    }
    __syncthreads();
}

namespace pg8 {
constexpr int BM = 256, BK = 64, HALF = 128, HTB = HALF * BK * 2, STAGE_BYTES = 8 * HTB, NXCD = 8, WGM = 8;
__host__ __device__ __forceinline__ int lds_byte(int r, int c) { const int st = (r >> 4) * 2 + (c >> 5), rr = r & 15, cc = c & 31, ob = rr * 64 + cc * 2; return st * 1024 + (ob ^ (((ob >> 9) & 1) << 5)); }
__host__ __device__ __forceinline__ void stage_rc(int b, int& R, int& C) { const int st = b / 1024, sb = b % 1024, swz = sb ^ (((sb >> 9) & 1) << 5); R = (st >> 1) * 16 + swz / 64; C = (st & 1) * 32 + (swz % 64) / 2; }
__host__ __device__ __forceinline__ int perm32(int rho) { const int n = rho >> 4, i = rho & 15; return 8 * (i >> 2) + 4 * n + (i & 3); }
struct Unit { int pm, pn, g; };

DEVI int conv_count(int units, int G) { const int Rf = units / G, rem = units - Rf * G; return rem ? (G - rem) / (Rf + 1) : 0; }
DEVI bool adopt(int units, int G, int c, int nconv, int i, long& L) {
    const int Rf = units / G, rem = units - Rf * G;
    if (i > Rf) return false;
    if (i == Rf && c >= rem) { const int j = c - rem; if (j >= nconv * Rf) return false; L = (long)(j / nconv) * G + (G - nconv) + (j % nconv); }
    return true;
}
struct ProbDense {
    const char* A; const char* Bt; int K, nM, nN, nwg, G, c, nconv;
    DEVI void init(const void* A_, const void* Bt_, int M, int N, int K_, int G_, int c_, int nconv_ = 0) { A = (const char*)A_; Bt = (const char*)Bt_; K = K_; nM = M / BM; nN = N / BM; nwg = nM * nN; G = G_; c = c_; nconv = nconv_; }
    DEVI bool next(int i, Unit& u) const {
        long L = (long)i * G + c;
        if (nconv) { if (!adopt(nwg, G, c, nconv, i, L)) return false; }
        if (L >= nwg) return false;
        int wgid = (int)L; { const int q = nwg / NXCD, r = nwg % NXCD, xcd = wgid % NXCD, off = wgid / NXCD; wgid = (xcd < r ? xcd * (q + 1) : r * (q + 1) + (xcd - r) * q) + off; }
        const int nig = WGM * nN, gid = wgid / nig, fm = gid * WGM, gsz = (nM - fm) < WGM ? (nM - fm) : WGM;
        u.pm = fm + ((wgid % nig) % gsz); u.pn = (wgid % nig) / gsz; u.g = 0; return true;
    }
    DEVI void a_offs(const Unit& u, const int (&R)[2], const int (&C)[2], unsigned (&va)[2][2]) const {
#pragma unroll
        for (int h = 0; h < 2; ++h)
#pragma unroll
            for (int i = 0; i < 2; ++i) va[h][i] = (unsigned)(((u.pm * BM + h * HALF + R[i]) * K + C[i]) * 2);
    }
    DEVI const char* b_base(const Unit& u) const { return Bt + (size_t)u.pn * BM * K * 2; }
};

struct ProbMoe {
    const char* A; const char* Bt; int K, nN, NT, G, c, nconv; size_t bstride;
    const LAS int* tile_e; const LAS int* tile_s0; const LAS int* cnt; const int* ltok; bool gather;
    DEVI bool next(int i, Unit& u) const {
        long Ll = (long)i * G + c;
        if (nconv) { if (!adopt(NT * nN, G, c, nconv, i, Ll)) return false; }
        const int L = (int)Ll; const int tile = L / nN; if (tile >= NT) return false;
        u.pm = tile; u.pn = L % nN; u.g = tile_e[tile]; return true;
    }
    DEVI void a_offs(const Unit& u, const int (&R)[2], const int (&C)[2], unsigned (&va)[2][2]) const {
        const int s0 = tile_s0[u.pm], n = cnt[u.g];
#pragma unroll
        for (int h = 0; h < 2; ++h)
#pragma unroll
            for (int i = 0; i < 2; ++i) {
                int row;
                if (gather) { const int slot = s0 + h * HALF + R[i]; row = (slot < n) ? ltok[u.g * CAP + slot] : 0; }
                else row = u.pm * BM + h * HALF + R[i];
                va[h][i] = (unsigned)((row * K + C[i]) * 2);
            }
    }
    DEVI const char* b_base(const Unit& u) const { return Bt + (size_t)u.g * bstride + (size_t)u.pn * BM * K * 2; }
};

template <class Prob, class Epi>
DEVI void gemm_phase(LAS unsigned char* lds, const Prob& S, const Epi& E) {
    const int tid = threadIdx.x, wid = __builtin_amdgcn_readfirstlane(tid >> 6), lane = tid & 63, wr = wid >> 2, wc = wid & 3, fr = lane & 15, fq = lane >> 4;
    const int K = S.K, nt = K / BK;
    int Rs[2], Cs[2]; unsigned voffB[2];
#pragma unroll
    for (int i = 0; i < 2; ++i) { int R, C; stage_rc(tid * 16 + i * 8192, R, C); Rs[i] = R; Cs[i] = C; const int Rb = (R & ~31) + perm32(R & 31); voffB[i] = (unsigned)(Rb * K + C) * 2u; }
    const size_t kstep = (size_t)(BK * 2);
    const size_t hstep = (size_t)HALF * K * 2;
    const unsigned ldsw = (unsigned)wid * 1024u;
    const int aoff = lds_byte(wr * 64 + fr, fq * 8), boff = lds_byte(wc * 32 + fr, fq * 8);
#define PG8_SA(b, h) (((b) * 2 + (h)) * HTB)
#define PG8_SB(b, h) ((4 + (b) * 2 + (h)) * HTB)
#define PG8_STAGE(bufoff, gbase, voff) do { _Pragma("unroll") for (int _i = 0; _i < 2; ++_i) \
        __builtin_amdgcn_global_load_lds((const unsigned*)((const char*)(gbase) + (voff)[_i]), (LAS unsigned*)(lds + (bufoff) + ldsw + _i * 8192), 16, 0, 0); } while (0)
#define PG8_LDA(dst, b, h) do { _Pragma("unroll") for (int m = 0; m < 4; ++m) _Pragma("unroll") for (int k = 0; k < 2; ++k) dst[m][k] = *(const LAS bf16x8*)(lds + PG8_SA(b, h) + aoff + m * 2048 + k * 1024); } while (0)
#define PG8_LDB(dst, b, h) do { _Pragma("unroll") for (int n = 0; n < 2; ++n) _Pragma("unroll") for (int k = 0; k < 2; ++k) dst[n][k] = *(const LAS bf16x8*)(lds + PG8_SB(b, h) + boff + n * 2048 + k * 1024); } while (0)
#define PG8_MMA(ai, bj, At, Bt) do { __builtin_amdgcn_s_setprio(1); _Pragma("unroll") for (int m = 0; m < 4; ++m) _Pragma("unroll") for (int n = 0; n < 2; ++n) _Pragma("unroll") for (int k = 0; k < 2; ++k) \
        acc[ai][bj][m][n] = __builtin_amdgcn_mfma_f32_16x16x32_bf16(Bt[n][k], At[m][k], acc[ai][bj][m][n], 0, 0, 0); __builtin_amdgcn_s_setprio(0); } while (0)
#define PG8_WAIT_V(n) asm volatile("s_waitcnt vmcnt(" #n ")" ::: "memory")
#define PG8_WAIT_L(n) asm volatile("s_waitcnt lgkmcnt(" #n ")" ::: "memory")
#define PG8_BAR __builtin_amdgcn_s_barrier()
#define PG8_SCHED __builtin_amdgcn_sched_barrier(0)
    Unit cur, nxt; int ui = 0;
    if (!S.next(0, cur)) return;
    f32x4 acc[2][2][4][2];
#pragma unroll
    for (int a = 0; a < 2; ++a)
#pragma unroll
        for (int b = 0; b < 2; ++b)
#pragma unroll
            for (int m = 0; m < 4; ++m)
#pragma unroll
                for (int n = 0; n < 2; ++n) acc[a][b][m][n] = (f32x4){0.f, 0.f, 0.f, 0.f};
    bf16x8 At[4][2], B0[2][2], B1[2][2];
    unsigned va[2][2], nva[2][2];
    S.a_offs(cur, Rs, Cs, va);
    const char* cB = S.b_base(cur);
    const char* A0 = S.A;
    PG8_STAGE(PG8_SB(0, 0), cB, voffB); PG8_STAGE(PG8_SB(0, 1), cB + hstep, voffB); PG8_STAGE(PG8_SA(0, 0), A0, va[0]); PG8_STAGE(PG8_SA(0, 1), A0, va[1]);
    if (wr == 1) PG8_BAR;
    PG8_WAIT_V(2); PG8_BAR;
    PG8_STAGE(PG8_SB(1, 0), cB + kstep, voffB); PG8_STAGE(PG8_SA(1, 0), A0 + kstep, va[0]); PG8_STAGE(PG8_SB(1, 1), cB + hstep + kstep, voffB);
    PG8_WAIT_V(6); PG8_BAR;
    for (;;) {
        const bool has_next = S.next(ui + 1, nxt);
        const char* nB = cB;
#pragma unroll
        for (int h = 0; h < 2; ++h)
#pragma unroll
            for (int i = 0; i < 2; ++i) nva[h][i] = va[h][i];
        if (has_next) { S.a_offs(nxt, Rs, Cs, nva); nB = S.b_base(nxt); }
        for (int t = 0; t < nt; t += 2) {
            const bool last = (t == nt - 2);
            const char* a1 = A0 + (size_t)(t + 1) * kstep;
            const char* a2 = last ? A0 : A0 + (size_t)(t + 2) * kstep; const char* b2 = last ? nB : cB + (size_t)(t + 2) * kstep;
            const char* a3 = a2 + kstep; const char* b3 = b2 + kstep;
            unsigned v2[2][2];
#pragma unroll
            for (int h = 0; h < 2; ++h)
#pragma unroll
                for (int i = 0; i < 2; ++i) v2[h][i] = last ? nva[h][i] : va[h][i];
            PG8_LDB(B0, 0, 0); PG8_LDB(B1, 0, 1); PG8_SCHED; PG8_LDA(At, 0, 0); PG8_STAGE(PG8_SA(1, 1), a1, va[1]);
            PG8_WAIT_V(8); PG8_WAIT_L(0); PG8_BAR; PG8_MMA(0, 0, At, B0); PG8_MMA(0, 1, At, B1); PG8_BAR; PG8_SCHED;
            PG8_LDA(At, 0, 1); PG8_STAGE(PG8_SB(0, 0), b2, voffB); PG8_STAGE(PG8_SB(0, 1), b2 + hstep, voffB); PG8_STAGE(PG8_SA(0, 0), a2, v2[0]);
            PG8_WAIT_V(8); PG8_WAIT_L(0); PG8_BAR; PG8_MMA(1, 0, At, B0); PG8_MMA(1, 1, At, B1); PG8_BAR; PG8_SCHED;
            PG8_LDB(B0, 1, 0); PG8_LDB(B1, 1, 1); PG8_SCHED; PG8_LDA(At, 1, 0); PG8_STAGE(PG8_SA(0, 1), a2, v2[1]);
            PG8_WAIT_V(8); PG8_WAIT_L(0); PG8_BAR; PG8_MMA(0, 0, At, B0); PG8_MMA(0, 1, At, B1); PG8_BAR; PG8_SCHED;
            PG8_LDA(At, 1, 1); PG8_STAGE(PG8_SB(1, 0), b3, voffB); PG8_STAGE(PG8_SB(1, 1), b3 + hstep, voffB); PG8_STAGE(PG8_SA(1, 0), a3, v2[0]);
            PG8_WAIT_V(8); PG8_WAIT_L(0); PG8_BAR; PG8_MMA(1, 0, At, B0); PG8_MMA(1, 1, At, B1); PG8_BAR; PG8_SCHED;
        }
        if (wr == 0) PG8_BAR;
        E(acc, cur, wr, wc, fr, fq);
        if (!has_next) break;
#pragma unroll
        for (int a = 0; a < 2; ++a)
#pragma unroll
            for (int b = 0; b < 2; ++b)
#pragma unroll
                for (int m = 0; m < 4; ++m)
#pragma unroll
                    for (int n = 0; n < 2; ++n) acc[a][b][m][n] = (f32x4){0.f, 0.f, 0.f, 0.f};
        cur = nxt; cB = nB; ++ui;
#pragma unroll
        for (int h = 0; h < 2; ++h)
#pragma unroll
            for (int i = 0; i < 2; ++i) va[h][i] = nva[h][i];
        if (wr == 1) PG8_BAR;
    }
    PG8_WAIT_V(0);
    PG8_BAR;
#undef PG8_SA
#undef PG8_SB
#undef PG8_STAGE
#undef PG8_LDA
#undef PG8_LDB
#undef PG8_MMA
#undef PG8_WAIT_V
#undef PG8_WAIT_L
#undef PG8_BAR
#undef PG8_SCHED
}
}

typedef f32x4 AccT[2][2][4][2];
#define EPI_LOOP(...) _Pragma("unroll") for (int ai = 0; ai < 2; ++ai) _Pragma("unroll") for (int m = 0; m < 4; ++m) { const int row = u.pm * 256 + ai * 128 + wr * 64 + m * 16 + fr; \
    _Pragma("unroll") for (int bj = 0; bj < 2; ++bj) { const int col = u.pn * 256 + bj * 128 + wc * 32 + 8 * fq; const f32x4 v0 = acc[ai][bj][m][0], v1 = acc[ai][bj][m][1]; __VA_ARGS__ } }

struct EpiStoreBf16 {
    bf16_t* O; int ldc;
    DEVI void operator()(const AccT& acc, const pg8::Unit& u, int wr, int wc, int fr, int fq) const {
        EPI_LOOP({ u32x4 w; w.x = pk2(v0[0], v0[1]); w.y = pk2(v0[2], v0[3]); w.z = pk2(v1[0], v1[1]); w.w = pk2(v1[2], v1[3]);
                   *(u32x4*)(O + (size_t)row * ldc + col) = w; })
    }
};
DEVI int rowc_of(int t) { return (t >> 13) * SEQ + CTXL + (t & 8191); }
struct EpiGate1 {
    float* M1; const bf16_t* P;
    DEVI void operator()(const AccT& acc, const pg8::Unit& u, int wr, int wc, int fr, int fq) const {
        EPI_LOOP({ const u32x4 g = *(const u32x4*)(P + (size_t)rowc_of(row) * NP + C_GA + col);
                   f32x4 o0, o1; o0[0] = sigmoidf_(lo_f(g.x)) * v0[0]; o0[1] = sigmoidf_(hi_f(g.x)) * v0[1]; o0[2] = sigmoidf_(lo_f(g.y)) * v0[2]; o0[3] = sigmoidf_(hi_f(g.y)) * v0[3];
                   o1[0] = sigmoidf_(lo_f(g.z)) * v1[0]; o1[1] = sigmoidf_(hi_f(g.z)) * v1[1]; o1[2] = sigmoidf_(lo_f(g.w)) * v1[2]; o1[3] = sigmoidf_(hi_f(g.w)) * v1[3];
                   float* d = M1 + (size_t)row * DM + col; *(f32x4*)d = o0; *(f32x4*)(d + 4) = o1; })
    }
};
struct EpiGate2 {
    const float* M1; bf16_t* M; const bf16_t* P;
    DEVI void operator()(const AccT& acc, const pg8::Unit& u, int wr, int wc, int fr, int fq) const {
        EPI_LOOP({ const u32x4 g = *(const u32x4*)(P + (size_t)rowc_of(row) * NP + C_GB + col);
                   const float* s = M1 + (size_t)row * DM + col; const f32x4 a0 = *(const f32x4*)s, a1 = *(const f32x4*)(s + 4);
                   u32x4 w; w.x = pk2(a0[0] + sigmoidf_(lo_f(g.x)) * v0[0], a0[1] + sigmoidf_(hi_f(g.x)) * v0[1]); w.y = pk2(a0[2] + sigmoidf_(lo_f(g.y)) * v0[2], a0[3] + sigmoidf_(hi_f(g.y)) * v0[3]);
                   w.z = pk2(a1[0] + sigmoidf_(lo_f(g.z)) * v1[0], a1[1] + sigmoidf_(hi_f(g.z)) * v1[1]); w.w = pk2(a1[2] + sigmoidf_(lo_f(g.w)) * v1[2], a1[3] + sigmoidf_(hi_f(g.w)) * v1[3]);
                   *(u32x4*)(M + (size_t)row * DM + col) = w; })
    }
};
struct EpiResid {
    const float* x; float* out; const float* mod;
    DEVI void operator()(const AccT& acc, const pg8::Unit& u, int wr, int wc, int fr, int fq) const {
        EPI_LOOP({ const int b = row >> 13; const float* gp = mod + b * 6144 + 2048 + col;
                   const f32x4 g0 = *(const f32x4*)gp, g1 = *(const f32x4*)(gp + 4);
                   const float* xs = x + (size_t)row * DM + col; float* d = out + (size_t)row * DM + col;
                   *(f32x4*)d = *(const f32x4*)xs + g0 * v0; *(f32x4*)(d + 4) = *(const f32x4*)(xs + 4) + g1 * v1; })
    }
};
struct EpiSwiglu {
    bf16_t* act; const float* b1;
    DEVI void operator()(const AccT& acc, const pg8::Unit& u, int wr, int wc, int fr, int fq) const {
        const int cc = u.pn * 128 + wc * 32 + 8 * fq; const float* bg = b1 + (size_t)u.g * 2048 + cc; const float* bl = bg + 1024;
        float g_[8], l_[8];
#pragma unroll
        for (int j = 0; j < 8; ++j) { g_[j] = bg[j]; l_[j] = bl[j]; }
#pragma unroll
        for (int ai = 0; ai < 2; ++ai)
#pragma unroll
            for (int m = 0; m < 4; ++m) {
                const int row = u.pm * 256 + ai * 128 + wr * 64 + m * 16 + fr; float o[8];
#pragma unroll
                for (int j = 0; j < 8; ++j) {
                    const float hg = acc[ai][0][m][j >> 2][j & 3] + g_[j], hl = acc[ai][1][m][j >> 2][j & 3] + l_[j];
                    const float glu = fminf(hg, 7.f), lin = fminf(fmaxf(hl, -7.f), 7.f);
                    o[j] = glu * sigmoidf_(1.702f * glu) * (lin + 1.f);
                }
                u32x4 w; w.x = pk2(o[0], o[1]); w.y = pk2(o[2], o[3]); w.z = pk2(o[4], o[5]); w.w = pk2(o[6], o[7]);
                *(u32x4*)(act + (size_t)row * 1024 + cc) = w;
            }
    }
};
struct EpiMoe2 {
    bf16_t* Y; const float* b2; const float* lgate; const LAS int* tile_s0; const LAS int* cnt;
    DEVI void operator()(const AccT& acc, const pg8::Unit& u, int wr, int wc, int fr, int fq) const {
        const int s0 = tile_s0[u.pm], n = cnt[u.g];
#pragma unroll
        for (int ai = 0; ai < 2; ++ai)
#pragma unroll
            for (int m = 0; m < 4; ++m) {
                const int rl = ai * 128 + wr * 64 + m * 16 + fr, slot = s0 + rl; const int row = u.pm * 256 + rl;
                const float gate = (slot < n) ? lgate[u.g * CAP + slot] : 0.f;
#pragma unroll
                for (int bj = 0; bj < 2; ++bj) {
                    const int col = u.pn * 256 + bj * 128 + wc * 32 + 8 * fq; const float* bp = b2 + (size_t)u.g * 1024 + col;
                    const f32x4 v0 = (acc[ai][bj][m][0] + *(const f32x4*)bp) * gate, v1 = (acc[ai][bj][m][1] + *(const f32x4*)(bp + 4)) * gate;
                    u32x4 w; w.x = pk2(v0[0], v0[1]); w.y = pk2(v0[2], v0[3]); w.z = pk2(v1[0], v1[1]); w.w = pk2(v1[2], v1[3]);
                    *(u32x4*)(Y + (size_t)row * 1024 + col) = w;
                }
            }
    }
};

namespace att {
constexpr int KVBLK = 64, LDQ = NP, LDK = NP;
constexpr float SCALE = 0.125f, THR = 8.f;
constexpr int SHM_V = KVBLK * 128 * 2, SHM_K = KVBLK * 128 * 2;
constexpr int OFF_VR = 0, OFF_KR = 4 * SHM_V;
constexpr int OFF_WS = 4 * SHM_V + 3 * SHM_K;
constexpr int OFF_E = 0;
constexpr int E_LD = 132;
constexpr int LDS_BYTES = OFF_WS + 8 * 64 * 4;
static_assert(128 * E_LD * 4 <= OFF_WS, "epilogue scratch must fit under the per-wave words");
#define KSWZ(row, colB) ((row) * 256 + ((colB) ^ (((row) & 7) << 4)))
#define SBAR() __builtin_amdgcn_sched_barrier(0)
DEVI int crow(int r, int hi) { return (r & 3) + 8 * (r >> 2) + 4 * hi; }
DEVI void partialSM(f32x16& p0, f32x16& p1, float& m_reg, float& mn, float& alpha) {
    constexpr float C = SCALE * LOG2E;
    float pmax = p0[0];
#pragma unroll
    for (int r = 1; r < 16; ++r) pmax = fmaxf(pmax, p0[r]);
#pragma unroll
    for (int r = 0; r < 16; ++r) pmax = fmaxf(pmax, p1[r]);
    { auto rr = __builtin_amdgcn_permlane32_swap(__float_as_uint(pmax), __float_as_uint(pmax), false, false);
      pmax = fmaxf(__uint_as_float(rr[0]), __uint_as_float(rr[1])); }
    if (__builtin_expect(__all(pmax - m_reg <= THR / SCALE), 1)) { mn = m_reg; alpha = 1.f; }
    else { mn = fmaxf(m_reg, pmax); alpha = __builtin_amdgcn_exp2f((m_reg - mn) * C); m_reg = mn; }
    const float mnC = -mn * C;
#pragma unroll
    for (int r = 0; r < 16; ++r) p0[r] = fmaf(p0[r], C, mnC);
#pragma unroll
    for (int r = 0; r < 16; ++r) p1[r] = fmaf(p1[r], C, mnC);
#pragma unroll
    for (int r = 0; r < 16; ++r) p0[r] = __builtin_amdgcn_exp2f(p0[r]);
}
DEVI void finishSM(f32x16& p0, f32x16& p1, float alpha, float& l_reg, bf16x8& pa0, bf16x8& pa1, bf16x8& pa2, bf16x8& pa3) {
#pragma unroll
    for (int r = 0; r < 16; ++r) p1[r] = __builtin_amdgcn_exp2f(p1[r]);
    float ps = 0;
#pragma unroll
    for (int r = 0; r < 16; ++r) ps += p0[r];
#pragma unroll
    for (int r = 0; r < 16; ++r) ps += p1[r];
    { auto rr = __builtin_amdgcn_permlane32_swap(__float_as_uint(ps), __float_as_uint(ps), false, false);
      ps = __uint_as_float(rr[0]) + __uint_as_float(rr[1]); }
    l_reg = l_reg * alpha + ps;
#define PK4(P, BASE, OUT) do { unsigned a0 = pk2a(P[BASE + 0], P[BASE + 1]), a1 = pk2a(P[BASE + 2], P[BASE + 3]);   \
    unsigned b0 = pk2a(P[BASE + 4], P[BASE + 5]), b1 = pk2a(P[BASE + 6], P[BASE + 7]);                              \
    auto r0 = __builtin_amdgcn_permlane32_swap(a0, b0, false, false); auto r1 = __builtin_amdgcn_permlane32_swap(a1, b1, false, false); \
    u32x4 w = {r0[0], r1[0], r0[1], r1[1]}; OUT = *reinterpret_cast<bf16x8*>(&w); } while (0)
    PK4(p0, 0, pa0); PK4(p0, 8, pa1); PK4(p1, 0, pa2); PK4(p1, 8, pa3);
#undef PK4
}
DEVI void qkt(f32x16& p0, f32x16& p1, const char* Ks, const bf16x8* qr, int r32, int hi, int st) {
    p0 = f32x16{}; p1 = f32x16{};
#pragma unroll
    for (int d0 = 0; d0 < 4; ++d0) { const int cb = ((st * 4 + d0) * 16 + hi * 8) * 2;
        const bf16x8 b0 = *reinterpret_cast<const bf16x8*>(Ks + KSWZ(r32, cb));
        const bf16x8 b1 = *reinterpret_cast<const bf16x8*>(Ks + KSWZ(32 + r32, cb));
        p0 = __builtin_amdgcn_mfma_f32_32x32x16_bf16(b0, qr[d0], p0, 0, 0, 0);
        p1 = __builtin_amdgcn_mfma_f32_32x32x16_bf16(b1, qr[d0], p1, 0, 0, 0); }
}
DEVI int v_st(int k, int c) { const int kk = (k & ~0xC) | ((k & 4) << 1) | ((k & 8) >> 1); return ((kk >> 3) * 4 + (c >> 5)) * 512 + ((kk & 7) * 32 + (c & 31)) * 2; }
DEVI int v_rd_base(int lane) { return ((lane & 3) << 3) | (((lane >> 2) & 3) << 6) | (((lane >> 4) & 1) << 5) | (((lane >> 5) & 1) << 8); }
constexpr int v_rd_off(int d0, int ks, int half) { return d0 * 512 + ks * 4096 + half * 2048; }
template <int OFF> DEVI s16x4 tr_read(int vb) {
    s16x4 r; asm volatile("ds_read_b64_tr_b16 %0, %1 offset:%2" : "=&v"(r) : "v"(vb), "i"(OFF) : "memory"); return r;
}
template <int D0> DEVI void pv_one(f32x16& od, int vb, bf16x8 pa0, bf16x8 pa1, bf16x8 pa2, bf16x8 pa3) {
    const s16x4 l0 = tr_read<v_rd_off(D0, 0, 0)>(vb), h0 = tr_read<v_rd_off(D0, 0, 1)>(vb), l1 = tr_read<v_rd_off(D0, 1, 0)>(vb), h1 = tr_read<v_rd_off(D0, 1, 1)>(vb);
    const s16x4 l2 = tr_read<v_rd_off(D0, 2, 0)>(vb), h2 = tr_read<v_rd_off(D0, 2, 1)>(vb), l3 = tr_read<v_rd_off(D0, 3, 0)>(vb), h3 = tr_read<v_rd_off(D0, 3, 1)>(vb);
    asm volatile("s_waitcnt lgkmcnt(0)" ::: "memory"); SBAR();
#define PK(L, H) (bf16x8){L[0], L[1], L[2], L[3], H[0], H[1], H[2], H[3]}
    od = __builtin_amdgcn_mfma_f32_32x32x16_bf16(pa0, PK(l0, h0), od, 0, 0, 0);
    od = __builtin_amdgcn_mfma_f32_32x32x16_bf16(pa1, PK(l1, h1), od, 0, 0, 0);
    od = __builtin_amdgcn_mfma_f32_32x32x16_bf16(pa2, PK(l2, h2), od, 0, 0, 0);
    od = __builtin_amdgcn_mfma_f32_32x32x16_bf16(pa3, PK(l3, h3), od, 0, 0, 0);
#undef PK
}
DEVI void pv_d0(f32x16* o, int vb, bf16x8 pa0, bf16x8 pa1, bf16x8 pa2, bf16x8 pa3) {
    pv_one<0>(o[0], vb, pa0, pa1, pa2, pa3); pv_one<1>(o[1], vb, pa0, pa1, pa2, pa3); pv_one<2>(o[2], vb, pa0, pa1, pa2, pa3); pv_one<3>(o[3], vb, pa0, pa1, pa2, pa3);
}
DEVI void attn_unit(const bf16_t* __restrict__ Qb, const bf16_t* __restrict__ Kh, const bf16_t* __restrict__ Vh, bf16_t* __restrict__ Ob, float lam, const float* __restrict__ dng, char* lds) {
    const int tid = threadIdx.x, wid = __builtin_amdgcn_readfirstlane(tid >> 6), lane = tid & 63, r32 = lane & 31, hi = lane >> 5, w4 = wid & 3, st = wid >> 2;
    char* V_lds = lds + OFF_VR; char* K_lds = lds + OFF_KR; LAS unsigned char* ldsL = (LAS unsigned char*)lds;
    float* wsf = (float*)(lds + OFF_WS) + wid * 64; float* li_l = wsf; float* al_l = wsf + 32;
    float m_reg = -1e30f, l_reg = 0; f32x16 o[4] = {}; bf16x8 qr[4];
    const bf16_t* Qw = Qb + (size_t)(w4 * 32 + r32) * LDQ + st * 64 + hi * 8;
#pragma unroll
    for (int d0 = 0; d0 < 4; ++d0) qr[d0] = *reinterpret_cast<const bf16x8*>(Qw + d0 * 16);
    unsigned kof[2], vof[2];
#pragma unroll
    for (int i = 0; i < 2; ++i) { const int q = 2 * wid + i;
        { const int row = 4 * q + (lane >> 4), colB = ((lane & 15) * 16) ^ ((row & 7) << 4); kof[i] = (unsigned)(row * LDK + colB / 2) * 2u; }
        { const int sub = 2 * q + (lane >> 5), kk = (sub >> 2) * 8 + ((lane & 31) >> 2), cc = (sub & 3) * 32 + (lane & 3) * 8;
          const int k = (kk & ~0xC) | ((kk & 4) << 1) | ((kk & 8) >> 1); vof[i] = (unsigned)(k * LDK + cc) * 2u; } }
    const int vb0 = (int)(uintptr_t)V_lds + v_rd_base(lane);
#define DMA_K(src_tile, slot) do { const char* kb_ = (const char*)Kh + (size_t)(src_tile) * (KVBLK * LDK * 2); _Pragma("unroll") for (int i_ = 0; i_ < 2; ++i_) \
        __builtin_amdgcn_global_load_lds((const unsigned*)(kb_ + kof[i_]), (LAS unsigned*)(ldsL + OFF_KR + (slot) * SHM_K + (2 * wid + i_) * 1024), 16, 0, 0); } while (0)
#define DMA_V(src_tile, slot) do { const char* vb_ = (const char*)Vh + (size_t)(src_tile) * (KVBLK * LDK * 2); _Pragma("unroll") for (int i_ = 0; i_ < 2; ++i_) \
        __builtin_amdgcn_global_load_lds((const unsigned*)(vb_ + vof[i_]), (LAS unsigned*)(ldsL + OFF_VR + (slot) * SHM_V + (2 * wid + i_) * 1024), 16, 0, 0); } while (0)
#define TILE_SYNC(n) do { asm volatile("s_waitcnt vmcnt(" #n ")" ::: "memory"); __builtin_amdgcn_s_barrier(); asm volatile("" ::: "memory"); } while (0)
#define RESC(a) do { if (__any((a) < 1.f)) { if (hi == 0) al_l[r32] = (a); asm volatile("s_waitcnt lgkmcnt(0)" ::: "memory"); \
    _Pragma("unroll") for (int d = 0; d < 4; ++d) _Pragma("unroll") for (int r = 0; r < 16; ++r) o[d][r] *= al_l[crow(r, hi)]; } } while (0)
    f32x16 pA0, pA1, pB0, pB1; float mnA, mnB, alA, alB; bf16x8 pa0, pa1, pa2, pa3; constexpr int NT = SEQ / KVBLK;
#define SEG_X(PN0, PN1, h_, PP0, PP1, alP) do { SBAR(); qkt(PN0, PN1, K_lds + ((h_) % 3) * SHM_K, qr, r32, hi, st); finishSM(PP0, PP1, alP, l_reg, pa0, pa1, pa2, pa3); SBAR(); } while (0)
#define SEG_Y(PN0, PN1, h_, mnN, alN) do { pv_d0(o, vb0 + (((h_) - 1) & 3) * SHM_V, pa0, pa1, pa2, pa3); partialSM(PN0, PN1, m_reg, mnN, alN); RESC(alN); } while (0)
#define ISSUE(h_) do { const int jk_ = (h_) + 2; DMA_K(jk_ < NT ? jk_ : NT - 1, jk_ % 3); DMA_V((h_) + 1, ((h_) + 1) & 3); } while (0)
    DMA_K(0, 0); DMA_V(0, 0); DMA_K(1, 1);
    TILE_SYNC(0);
    if (st == 0) {
        ISSUE(0); qkt(pA0, pA1, K_lds, qr, r32, hi, st); partialSM(pA0, pA1, m_reg, mnA, alA); TILE_SYNC(4);
        for (int h = 1; h + 1 < NT; h += 2) {
            SEG_X(pB0, pB1, h, pA0, pA1, alA);     ISSUE(h);     SEG_Y(pB0, pB1, h, mnB, alB);     TILE_SYNC(4);
            SEG_X(pA0, pA1, h + 1, pB0, pB1, alB); ISSUE(h + 1); SEG_Y(pA0, pA1, h + 1, mnA, alA); TILE_SYNC(4);
        }
        SEG_X(pB0, pB1, NT - 1, pA0, pA1, alA); SEG_Y(pB0, pB1, NT - 1, mnB, alB); TILE_SYNC(0);
        finishSM(pB0, pB1, alB, l_reg, pa0, pa1, pa2, pa3); SBAR();
        pv_d0(o, vb0 + ((NT - 1) & 3) * SHM_V, pa0, pa1, pa2, pa3);
    } else {
        ISSUE(0); qkt(pA0, pA1, K_lds, qr, r32, hi, st); TILE_SYNC(4);
        ISSUE(1); partialSM(pA0, pA1, m_reg, mnA, alA); SEG_X(pB0, pB1, 1, pA0, pA1, alA); TILE_SYNC(4);
        for (int h = 2; h + 3 < NT; h += 2) {
            SEG_Y(pB0, pB1, h - 1, mnB, alB); ISSUE(h);     SEG_X(pA0, pA1, h, pB0, pB1, alB);     TILE_SYNC(4);
            SEG_Y(pA0, pA1, h, mnA, alA);     ISSUE(h + 1); SEG_X(pB0, pB1, h + 1, pA0, pA1, alA); TILE_SYNC(4);
        }
        ISSUE(NT - 2); SEG_Y(pB0, pB1, NT - 3, mnB, alB); SEG_X(pA0, pA1, NT - 2, pB0, pB1, alB); TILE_SYNC(4);
        SEG_Y(pA0, pA1, NT - 2, mnA, alA); SEG_X(pB0, pB1, NT - 1, pA0, pA1, alA); TILE_SYNC(0);
        SEG_Y(pB0, pB1, NT - 1, mnB, alB);
        finishSM(pB0, pB1, alB, l_reg, pa0, pa1, pa2, pa3); SBAR();
        pv_d0(o, vb0 + ((NT - 1) & 3) * SHM_V, pa0, pa1, pa2, pa3);
    }
    asm volatile("s_waitcnt lgkmcnt(0)" ::: "memory"); __builtin_amdgcn_s_barrier(); asm volatile("" ::: "memory");
#undef SEG_X
#undef SEG_Y
#undef ISSUE
    if (hi == 0) li_l[r32] = l_reg; asm volatile("s_waitcnt lgkmcnt(0)" ::: "memory");
    float rli[16];
    const float sgn = st ? lam : 1.f;
#pragma unroll
    for (int r = 0; r < 16; ++r) rli[r] = __builtin_amdgcn_rcpf(li_l[crow(r, hi)]) * sgn;
    float* Es = (float*)(lds + OFF_E);
    if (st == 1) {
#pragma unroll
        for (int r = 0; r < 16; ++r) { const int orow = w4 * 32 + crow(r, hi);
#pragma unroll
            for (int d0 = 0; d0 < 4; ++d0) Es[orow * E_LD + d0 * 32 + r32] = o[d0][r] * rli[r]; }
    }
    __syncthreads();
    if (st == 0) {
#pragma unroll
        for (int r = 0; r < 16; ++r) { const int orow = w4 * 32 + crow(r, hi);
#pragma unroll
            for (int d0 = 0; d0 < 4; ++d0) { float* e = &Es[orow * E_LD + d0 * 32 + r32]; *e = o[d0][r] * rli[r] - *e; } }
    }
    __syncthreads();
    { const int row = tid >> 2, q = tid & 3; const float* e = &Es[row * E_LD + q * 32]; float v[32]; float ss = 0.f;
#pragma unroll
      for (int j = 0; j < 8; ++j) { const f32x4 t4 = *(const f32x4*)(e + 4 * j); v[4 * j] = t4[0]; v[4 * j + 1] = t4[1]; v[4 * j + 2] = t4[2]; v[4 * j + 3] = t4[3]; }
#pragma unroll
      for (int j = 0; j < 32; ++j) ss += v[j] * v[j];
      ss += __shfl_xor(ss, 1); ss += __shfl_xor(ss, 2);
      const float rs = __builtin_amdgcn_rsqf(ss * (1.f / 128.f) + EPS) * 0.8f;
      bf16_t* op = Ob + (size_t)row * 1024 + q * 32; const float* g = dng + q * 32;
#pragma unroll
      for (int j = 0; j < 4; ++j) { u32x4 w; w.x = pk2(v[8 * j] * rs * g[8 * j], v[8 * j + 1] * rs * g[8 * j + 1]); w.y = pk2(v[8 * j + 2] * rs * g[8 * j + 2], v[8 * j + 3] * rs * g[8 * j + 3]);
          w.z = pk2(v[8 * j + 4] * rs * g[8 * j + 4], v[8 * j + 5] * rs * g[8 * j + 5]); w.w = pk2(v[8 * j + 6] * rs * g[8 * j + 6], v[8 * j + 7] * rs * g[8 * j + 7]);
          *(u32x4*)(op + 8 * j) = w; }
    }
    __syncthreads();
#undef DMA_K
#undef DMA_V
#undef TILE_SYNC
#undef RESC
}
}

#define LDS_BAR() do { asm volatile("s_waitcnt lgkmcnt(0)" ::: "memory"); __builtin_amdgcn_s_barrier(); asm volatile("" ::: "memory"); } while (0)
namespace ret {
using att::crow;
DEVI size_t qf_index(int b, int h, int c, int w, int ks, int fq, int fr) { return (((((((size_t)(b * 4 + h) * 66 + c) * 8 + w) * 8 + ks) * 4 + fq) * 16 + fr) * 8); }
DEVI size_t ktf_index(int b, int h, int c, int w, int ks, int hh, int r32) { return (((((((size_t)(b * 4 + h) * 66 + c) * 8 + w) * 8 + ks) * 2 + hh) * 32 + r32) * 8); }
constexpr int VS_LD = 136;
constexpr int ST_LD = 264;
constexpr int TS_LD = 40;
constexpr int OFF_VS = 0, OFF_ST = 2 * 32 * VS_LD * 2, OFF_TS = OFF_ST + 2 * 32 * ST_LD * 2;
DEVI void scan_unit(int u, const bf16_t* __restrict__ QF, const bf16_t* __restrict__ KTF, const bf16_t* __restrict__ VT, bf16_t* __restrict__ OF, bf16_t* __restrict__ OB, const float* __restrict__ scal, char* lds) {
    const int b = u >> 7, h = (u >> 5) & 3, dir = (u >> 4) & 1, vs = u & 15;
    const int tid = threadIdx.x, w = __builtin_amdgcn_readfirstlane(tid >> 6), lane = tid & 63, r32 = lane & 31, hh = lane >> 5, fr = lane & 15, fq = lane >> 4;
    const float lgn = scal[dir * 4 + h];
    const float gch = __expf(lgn * 128.f);
    bf16_t* Vs = (bf16_t*)(lds + OFF_VS); bf16_t* St = (bf16_t*)(lds + OFF_ST); bf16_t* Ts = (bf16_t*)(lds + OFF_TS) + w * (16 * TS_LD);
    for (int i = tid; i < 32 * ST_LD / 2; i += 512) ((unsigned*)St)[i] = 0u;
    f32x16 S = {};
    const bf16_t* QFb = QF + qf_index(b, h, 0, w, 0, 0, 0) + lane * 8;
    const bf16_t* KTFb = KTF + ktf_index(b, h, 0, w, 0, 0, 0) + lane * 8;
    const bf16_t* VTb = VT + ((size_t)(b * 4 + h) * 512 + vs * 32) * SEQ;
    bf16_t* Odir = dir ? OB : OF;
    bf16_t* sink = (bf16_t*)((char*)OF + (WS_DUMMY - WS_OF));
    const int sv = tid >> 4, sj = (tid & 15) * 8;
    float wj[8];
#pragma unroll
    for (int e = 0; e < 8; ++e) { const int j = sj + e; wj[e] = __expf(lgn * (float)(dir ? j : 127 - j)); }
    const int itok = 16 * w + fr;
    const float qd = __expf(lgn * (float)(dir ? 128 - itok : itok + 1));
    bf16x8 kfA[8], kfB[8], qfA[8], qfB[8]; bf16x8 vA, vB;
#define CHUNK_OF(k) (dir ? ((k) == 0 ? 1 : ((k) == 1 ? 0 : 67 - (k))) : (k))
#define CLAMPK(kk) ((kk) < 66 ? (kk) : 65)
#define LOADK(KF_, kk) do { const size_t co_ = (size_t)CHUNK_OF(CLAMPK(kk)) * 32768; \
        _Pragma("unroll") for (int ks = 0; ks < 8; ++ks) KF_[ks] = *(const bf16x8*)(KTFb + co_ + ((ks + vs) & 7) * 512); } while (0)
#define LOADV(VR_, kk) do { VR_ = *(const bf16x8*)(VTb + (size_t)sv * SEQ + CHUNK_OF(CLAMPK(kk)) * 128 + sj); } while (0)
#define LOADQ(QF_, kk) do { const size_t co_ = (size_t)CHUNK_OF(CLAMPK(kk)) * 32768;     \
        _Pragma("unroll") for (int ks = 0; ks < 8; ++ks) QF_[ks] = *(const bf16x8*)(QFb + co_ + ((ks + vs) & 7) * 512); } while (0)
#define STEP(k, KF_, V_, QF_) do { \
        const int cn = CHUNK_OF(k); \
        bf16_t* Vsk = Vs + ((k) & 1) * (32 * VS_LD); const bf16_t* Stk = St + ((k) & 1) * (32 * ST_LD); bf16_t* Stn = St + (((k) + 1) & 1) * (32 * ST_LD); \
        { u32x4 vv = *reinterpret_cast<u32x4*>(&V_); u32x4 ww; \
          ww.x = pk2(lo_f(vv.x) * wj[0], hi_f(vv.x) * wj[1]); ww.y = pk2(lo_f(vv.y) * wj[2], hi_f(vv.y) * wj[3]); \
          ww.z = pk2(lo_f(vv.z) * wj[4], hi_f(vv.z) * wj[5]); ww.w = pk2(lo_f(vv.w) * wj[6], hi_f(vv.w) * wj[7]); \
          *(u32x4*)(Vsk + sv * VS_LD + sj) = ww; } \
        LOADV(V_, (k) + 2); \
        __syncthreads();     \
        _Pragma("unroll") for (int r = 0; r < 16; ++r) S[r] *= gch; \
        _Pragma("unroll") for (int ks = 0; ks < 8; ++ks) { \
            const bf16x8 vf = *(const bf16x8*)(Vsk + r32 * VS_LD + ((ks + vs) & 7) * 16 + hh * 8); \
            S = __builtin_amdgcn_mfma_f32_32x32x16_bf16(KF_[ks], vf, S, 0, 0, 0); } \
        LOADK(KF_, (k) + 2); \
        _Pragma("unroll") for (int g = 0; g < 4; ++g) { u32x2 ww; ww.x = pk2(S[4 * g], S[4 * g + 1]); ww.y = pk2(S[4 * g + 2], S[4 * g + 3]); \
            *(u32x2*)(Stn + r32 * ST_LD + 32 * w + 8 * g + 4 * hh) = ww; } \
        {                    \
            f32x4 a0 = {0.f, 0.f, 0.f, 0.f}, a1 = {0.f, 0.f, 0.f, 0.f}; \
            _Pragma("unroll") for (int ks = 0; ks < 8; ++ks) { \
                const bf16x8 s0f = *(const bf16x8*)(Stk + (fr) * ST_LD + ((ks + vs) & 7) * 32 + fq * 8); \
                const bf16x8 s1f = *(const bf16x8*)(Stk + (16 + fr) * ST_LD + ((ks + vs) & 7) * 32 + fq * 8); \
                a0 = __builtin_amdgcn_mfma_f32_16x16x32_bf16(s0f, QF_[ks], a0, 0, 0, 0); \
                a1 = __builtin_amdgcn_mfma_f32_16x16x32_bf16(s1f, QF_[ks], a1, 0, 0, 0); } \
            u32x2 w0, w1; w0.x = pk2(a0[0] * qd, a0[1] * qd); w0.y = pk2(a0[2] * qd, a0[3] * qd); w1.x = pk2(a1[0] * qd, a1[1] * qd); w1.y = pk2(a1[2] * qd, a1[3] * qd); \
            *(u32x2*)(Ts + fr * TS_LD + 4 * fq) = w0; *(u32x2*)(Ts + fr * TS_LD + 16 + 4 * fq) = w1;        \
            asm volatile("s_waitcnt lgkmcnt(0)" ::: "memory"); \
            const int tk = lane >> 2, l = (cn - 2) * 128 + 16 * w + tk; \
            const u32x4 ov = *(const u32x4*)(Ts + tk * TS_LD + (lane & 3) * 8); \
            bf16_t* op = (cn >= 2 ? Odir + (size_t)(b * LSEQ + l) * 2048 : sink + (size_t)(16 * w + tk) * 2048) + h * 512 + vs * 32 + (lane & 3) * 8; \
            *(u32x4*)op = ov; } \
        LOADQ(QF_, (k) + 2); \
    } while (0)
    LOADK(kfA, 0); LOADV(vA, 0); LOADK(kfB, 1); LOADV(vB, 1); LOADQ(qfA, 0); LOADQ(qfB, 1);
#pragma unroll 1
    for (int k2 = 0; k2 < 66; k2 += 2) {
        STEP(k2 + 0, kfA, vA, qfA);
        STEP(k2 + 1, kfB, vB, qfB);
    }
    __syncthreads();
#undef STEP
#undef LOADK
#undef LOADV
#undef LOADQ
#undef CHUNK_OF
}
constexpr int QL_LD = 264, PL_LD = 136, VL_LD = 136;
constexpr int OFF_QL = 0, OFF_KL = 128 * QL_LD * 2, OFF_PL = 0, OFF_VL = OFF_KL;
DEVI void intra_unit(int u, const bf16_t* __restrict__ P, const bf16_t* __restrict__ VT, bf16_t* __restrict__ OI, const float* __restrict__ scal, char* lds) {
    const int b = u >> 8, h = (u >> 6) & 3, lc = u & 63, s0 = (lc + 2) * 128;
    const int tid = threadIdx.x, w = __builtin_amdgcn_readfirstlane(tid >> 6), lane = tid & 63, r32 = lane & 31, hh = lane >> 5;
    const int tr = w >> 1, tc0 = 2 * (w & 1);
    bf16_t* Ql = (bf16_t*)(lds + OFF_QL); bf16_t* Kl = (bf16_t*)(lds + OFF_KL); bf16_t* Pl = (bf16_t*)(lds + OFF_PL); bf16_t* Vl = (bf16_t*)(lds + OFF_VL);
    {
        const int srow = tid >> 5, pc = (tid & 31) * 8;
        const bf16_t* qg = P + ((size_t)b * SEQ + s0 + srow) * NP + C_RQ + h * 256 + pc; const bf16_t* kg = qg + (C_RK - C_RQ);
        u32x4 qv[8], kv[8];
#pragma unroll
        for (int it = 0; it < 8; ++it) { qv[it] = *(const u32x4*)(qg + (size_t)it * 16 * NP); kv[it] = *(const u32x4*)(kg + (size_t)it * 16 * NP); }
#pragma unroll
        for (int it = 0; it < 8; ++it) { *(u32x4*)(Ql + (it * 16 + srow) * QL_LD + pc) = qv[it]; *(u32x4*)(Kl + (it * 16 + srow) * QL_LD + pc) = kv[it]; }
    }
    __syncthreads();
    f32x16 c0 = {}, c1 = {};
#pragma unroll 4
    for (int ks = 0; ks < 16; ++ks) {
        const bf16x8 a = *(const bf16x8*)(Ql + (32 * tr + r32) * QL_LD + ks * 16 + hh * 8);
        const bf16x8 b0 = *(const bf16x8*)(Kl + (32 * tc0 + r32) * QL_LD + ks * 16 + hh * 8), b1 = *(const bf16x8*)(Kl + (32 * tc0 + 32 + r32) * QL_LD + ks * 16 + hh * 8);
        c0 = __builtin_amdgcn_mfma_f32_32x32x16_bf16(a, b0, c0, 0, 0, 0);
        c1 = __builtin_amdgcn_mfma_f32_32x32x16_bf16(a, b1, c1, 0, 0, 0);
    }
    const int vrow = tid >> 4, vpc = (tid & 15) * 8;
    const bf16_t* vg = VT + ((size_t)(b * 4 + h) * 512 + vrow) * SEQ + s0 + vpc;
    u32x4 vv[4];
#pragma unroll
    for (int it = 0; it < 4; ++it) vv[it] = *(const u32x4*)(vg + (size_t)(it * 32) * SEQ);
    LDS_BAR();
    const float lf2 = scal[h] * LOG2E, lb2 = scal[4 + h] * LOG2E;
#pragma unroll
    for (int t = 0; t < 2; ++t) {
        const int j = 32 * (tc0 + t) + r32;
#pragma unroll
        for (int r = 0; r < 16; ++r) {
            const int i = 32 * tr + crow(r, hh); const float dlt = (float)(i - j);
            float dm = 0.f;
            if (j <= i) dm += __builtin_amdgcn_exp2f(dlt * lf2);
            if (j >= i) dm += __builtin_amdgcn_exp2f(-dlt * lb2);
            const float v = (t ? c1[r] : c0[r]) * dm;
            Pl[i * PL_LD + j] = (bf16_t)f2bf(v);
        }
    }
    bf16x8 pf[8];
    bf16_t* Ob = OI + ((size_t)b * LSEQ + lc * 128 + 32 * tr + r32) * 2048 + h * 512;
#pragma unroll 1
    for (int vb = 0; vb < 4; ++vb) {
        bf16_t* Vb = Vl + (vb & 1) * (128 * VL_LD);
#pragma unroll
        for (int it = 0; it < 4; ++it) *(u32x4*)(Vb + (it * 32 + vrow) * VL_LD + vpc) = vv[it];
        if (vb < 3) {
#pragma unroll
            for (int it = 0; it < 4; ++it) vv[it] = *(const u32x4*)(vg + (size_t)((vb + 1) * 128 + it * 32) * SEQ);
        }
        LDS_BAR();
        if (vb == 0) {
#pragma unroll
            for (int ks = 0; ks < 8; ++ks) pf[ks] = *(const bf16x8*)(Pl + (32 * tr + r32) * PL_LD + ks * 16 + hh * 8);
        }
#pragma unroll
        for (int t = 0; t < 2; ++t) {
            const int vt = (w & 1) * 2 + t;
            f32x16 oacc = {};
#pragma unroll
            for (int ks = 0; ks < 8; ++ks) {
                const bf16x8 a = *(const bf16x8*)(Vb + (32 * vt + r32) * VL_LD + ks * 16 + hh * 8);
                oacc = __builtin_amdgcn_mfma_f32_32x32x16_bf16(a, pf[ks], oacc, 0, 0, 0);
            }
            const int v0 = vb * 128 + vt * 32;
#pragma unroll
            for (int g = 0; g < 4; ++g) { u32x2 ww; ww.x = pk2(oacc[4 * g], oacc[4 * g + 1]); ww.y = pk2(oacc[4 * g + 2], oacc[4 * g + 3]);
                *(u32x2*)(Ob + v0 + 8 * g + 4 * hh) = ww; }
        }
    }
    __syncthreads();
}
}

constexpr int NPH = 12;
constexpr int LDS_BYTES = 160 * 1024;
constexpr int LDS_TAB = 131072;

struct Ctx {
    int tid, lane, wave, gw, NGW, G, bid;
    char* lds;
};

struct TrTile { const float* W; bf16_t* WT; int K, N, k0, n0, perm; };
DEVI int tr_orow(const TrTile& t, int n) { return t.perm ? 256 * ((n & 1023) >> 7) + 128 * (n >> 10) + (n & 127) : n; }
DEVI void tr_load(const TrTile& t, f32x4 (&v)[16], int tid) { const int wv = tid >> 6, l = tid & 63;
#pragma unroll
    for (int i = 0; i < 16; ++i) v[i] = *(const f32x4*)(t.W + (size_t)(t.k0 + 16 * wv + i) * t.N + t.n0 + 4 * l); }
DEVI void tr_to_lds(const f32x4 (&v)[16], unsigned* T, int tid) { const int wv = tid >> 6, l = tid & 63;
#pragma unroll
    for (int e = 0; e < 4; ++e) { const int n = 4 * l + e;
#pragma unroll
        for (int h = 0; h < 2; ++h) { u32x4 o; o.x = pk2(v[8 * h][e], v[8 * h + 1][e]); o.y = pk2(v[8 * h + 2][e], v[8 * h + 3][e]); o.z = pk2(v[8 * h + 4][e], v[8 * h + 5][e]); o.w = pk2(v[8 * h + 6][e], v[8 * h + 7][e]);
            *(u32x4*)(T + n * 64 + 4 * ((2 * wv + h) ^ (l & 7))) = o; } } }
DEVI void tr_store(const TrTile& t, const unsigned* T, int tid) { const int piece = tid & 15;
#pragma unroll
    for (int it = 0; it < 8; ++it) { const int n = (tid >> 4) + 32 * it;
        const u32x4 o = *(const u32x4*)(T + n * 64 + 4 * (piece ^ ((n >> 2) & 7)));
        *(u32x4*)(t.WT + (size_t)tr_orow(t, t.n0 + n) * t.K + t.k0 + piece * 8) = o; } }

DEVI void phase_prep(const Params& p, const Ctx& c) {
    unsigned char* ws = p.ws;
    constexpr int T_IN = 8 * (NP / 256), T_BR = 16 * 4, T_BD = 8 * 4, T_OUT = T_BD, T_W1 = 8 * 8, T_W2 = 8 * 4;
    int NTIL = T_IN + T_BR + T_BD + T_OUT;
    asm volatile("" : "+s"(NTIL));
    auto tile_of = [&](int it) { TrTile t; int r = it; t.perm = 0;
        if (r < T_IN) { const int nb = NP / 256; t.W = p.w_in; t.WT = (bf16_t*)(ws + WS_WIN); t.K = 1024; t.N = NP; t.k0 = (r / nb) * 128; t.n0 = (r % nb) * 256; return t; } r -= T_IN;
        if (r < T_BR) { t.W = p.w_br_ret; t.WT = (bf16_t*)(ws + WS_WBR); t.K = 2048; t.N = 1024; t.k0 = (r / 4) * 128; t.n0 = (r % 4) * 256; return t; } r -= T_BR;
        if (r < T_BD) { t.W = p.w_br_diff; t.WT = (bf16_t*)(ws + WS_WBD); t.K = 1024; t.N = 1024; t.k0 = (r / 4) * 128; t.n0 = (r % 4) * 256; return t; } r -= T_BD;
        if (r < T_OUT) { t.W = p.w_out; t.WT = (bf16_t*)(ws + WS_WOUT); t.K = 1024; t.N = 1024; t.k0 = (r / 4) * 128; t.n0 = (r % 4) * 256; return t; } r -= T_OUT;
        const int e = r / (T_W1 + T_W2); r -= e * (T_W1 + T_W2);
        if (r < T_W1) { t.W = p.w1 + (size_t)e * 1024 * 2048; t.WT = (bf16_t*)(ws + WS_W1) + (size_t)e * 2048 * 1024; t.K = 1024; t.N = 2048; t.k0 = (r / 8) * 128; t.n0 = (r % 8) * 256; t.perm = 1; return t; } r -= T_W1;
        t.W = p.w2 + (size_t)e * 1024 * 1024; t.WT = (bf16_t*)(ws + WS_W2) + (size_t)e * 1024 * 1024; t.K = 1024; t.N = 1024; t.k0 = (r / 4) * 128; t.n0 = (r % 4) * 256; return t; };
    {
        unsigned* Tl = (unsigned*)c.lds; f32x4 v[16];
        int it = c.bid; TrTile cur = tile_of(it < NTIL ? it : 0);
        if (it < NTIL) tr_load(cur, v, c.tid);
        while (it < NTIL) {
            tr_to_lds(v, Tl, c.tid);
            const int nx = it + c.G; TrTile nxt = tile_of(nx < NTIL ? nx : 0);
            if (nx < NTIL) tr_load(nxt, v, c.tid);
            LDS_BAR();
            tr_store(cur, Tl, c.tid);
            LDS_BAR();
            cur = nxt; it = nx;
        }
    }
    float* mod = (float*)(ws + WS_MOD);
    __syncthreads();
    float* sil = (float*)c.lds + 1024;
    if (c.G - 1 - c.bid < 192) { for (int i = c.tid; i < 3072; i += 512) sil[i] = siluf_(i < 2048 ? p.c[i] : p.c_ctx[i - 2048]); }
    __syncthreads();
    for (int cgp = c.G - 1 - c.bid; cgp < 192; cgp += c.G) {
        const int col = cgp * 32 + (c.lane & 31), kh = c.lane >> 5; float a0 = 0.f, a1 = 0.f, a2 = 0.f;
        for (int k0 = c.wave * 128; k0 < c.wave * 128 + 128; k0 += 64) {
            float wv[32];
#pragma unroll
            for (int i = 0; i < 32; ++i) wv[i] = p.w_mod[(size_t)(k0 + 2 * i + kh) * 6144 + col];
#pragma unroll
            for (int i = 0; i < 32; ++i) { const float* sp = sil + k0 + 2 * i + kh; a0 += sp[0] * wv[i]; a1 += sp[1024] * wv[i]; a2 += sp[2048] * wv[i]; }
        }
        a0 += __shfl_xor(a0, 32); a1 += __shfl_xor(a1, 32); a2 += __shfl_xor(a2, 32);
        float* red = (float*)c.lds;
        if (kh == 0) { red[(c.wave * 3 + 0) * 32 + c.lane] = a0; red[(c.wave * 3 + 1) * 32 + c.lane] = a1; red[(c.wave * 3 + 2) * 32 + c.lane] = a2; }
        __syncthreads();
        if (c.tid < 96) { const int v = c.tid >> 5, l = c.tid & 31; float s = 0.f;
#pragma unroll
            for (int w = 0; w < 8; ++w) s += red[(w * 3 + v) * 32 + l];
            mod[v * 6144 + cgp * 32 + l] = s + p.b_mod[cgp * 32 + l]; }
        __syncthreads();
    }
    const int gt = c.bid * 512 + c.tid;
    if (gt < 128 * 64) { const int pos = gt >> 6, i = gt & 63; const float inv = powf(10000.f, -(float)i / 64.f); float s, co; sincosf((float)pos * inv, &s, &co);
        ((float2*)(ws + WS_TABR))[gt] = make_float2(co, s); }
    else if (gt < 128 * 64 + 128 * 16) { const int q = gt - 128 * 64, pos = q >> 4, i = q & 15; const float inv = powf(10000.f, -(float)i / 16.f); float s, co; sincosf((float)pos * inv, &s, &co);
        ((float2*)(ws + WS_TABD))[q] = make_float2(co, s); }
    else if (gt < 128 * 80 + 8) { const int q = gt - 128 * 80; const float xl = p.ret_decay[q]; ((float*)(ws + WS_SCAL))[q] = -log1pf(expf(-xl)); }
    else if (gt >= 128 * 80 + 64 && gt < 128 * 80 + 128) {
        const int i = gt - (128 * 80 + 64); const float s01 = wave_sum(p.dlam[i] * p.dlam[64 + i]), s23 = wave_sum(p.dlam[128 + i] * p.dlam[192 + i]);
        if (i == 0) ((float*)(ws + WS_SCAL))[8] = expf(s01) - expf(s23) + 0.2f; }
}

constexpr int Q1_TILES = NE * 64, Q2_TILES = NE * 32;
DEVI TrTile conv_tile(const Params& p, int qsel, int t) {
    TrTile tt;
    if (qsel == 0) { const int e = t >> 6, r = t & 63; tt.W = p.w1 + (size_t)e * 1024 * 2048; tt.WT = (bf16_t*)(p.ws + WS_W1) + (size_t)e * 2048 * 1024; tt.K = 1024; tt.N = 2048; tt.k0 = (r >> 3) * 128; tt.n0 = (r & 7) * 256; tt.perm = 1; }
    else { const int e = t >> 5, r = t & 31; tt.W = p.w2 + (size_t)e * 1024 * 1024; tt.WT = (bf16_t*)(p.ws + WS_W2) + (size_t)e * 1024 * 1024; tt.K = 1024; tt.N = 1024; tt.k0 = (r >> 2) * 128; tt.n0 = (r & 3) * 256; tt.perm = 0; }
    return tt;
}
DEVI void conv_run(const Params& p, const Ctx& c, int qsel, bool peek, bool stoppable) {
    unsigned* Tl = (unsigned*)c.lds; int* qs = (int*)(c.lds + 65536);
    int* q = (int*)(p.ws + WS_Q) + 64 * qsel; const int lim = qsel ? Q2_TILES : Q1_TILES;
    __syncthreads();
    const int* flagp = (const int*)(p.ws + WS_Q) + 128; int flg = 0; bool live = true;
    int pre = lim;
    if (c.tid == 0) {
        int t0 = lim, t1 = lim;
        if ((!peek || __hip_atomic_load(q, __ATOMIC_RELAXED, __HIP_MEMORY_SCOPE_AGENT) < lim) && !(stoppable && __hip_atomic_load(flagp, __ATOMIC_RELAXED, __HIP_MEMORY_SCOPE_AGENT) != 0)) { t0 = (int)atomicInc((unsigned*)q, 0xFFFFFFFFu); t1 = (int)atomicInc((unsigned*)q, 0xFFFFFFFFu); pre = (int)atomicInc((unsigned*)q, 0xFFFFFFFFu); }
        qs[0] = t0 < lim ? t0 : -1; qs[1] = t1 < lim ? t1 : -1; }
    __syncthreads();
    int ia = __builtin_amdgcn_readfirstlane(qs[0]), ib = __builtin_amdgcn_readfirstlane(qs[1]);
    if (ia < 0) return;
    f32x4 va[16], vb[16];
    TrTile dummy; dummy.W = p.w1; dummy.WT = nullptr; dummy.K = 0; dummy.N = 0; dummy.k0 = 0; dummy.n0 = 0; dummy.perm = 0;
    TrTile ta = conv_tile(p, qsel, ia), tb = ib >= 0 ? conv_tile(p, qsel, ib) : dummy;
    tr_load(ta, va, c.tid);
    tr_load(tb, vb, c.tid);
    LDS_BAR();
#define CONV_STEP(IT, TT_, V) { tr_to_lds(V, Tl, c.tid); \
        if (c.tid == 0) { const bool ok = live && pre < lim; qs[0] = ok ? pre : -1; live = ok && flg == 0; if (live) pre = (int)atomicInc((unsigned*)q, 0xFFFFFFFFu); \
                          if (stoppable) flg = __hip_atomic_load(flagp, __ATOMIC_RELAXED, __HIP_MEMORY_SCOPE_AGENT); } \
        LDS_BAR(); \
        const int nx = __builtin_amdgcn_readfirstlane(qs[0]); const TrTile done = TT_; TT_ = nx >= 0 ? conv_tile(p, qsel, nx) : dummy; \
        tr_load(TT_, V, c.tid); \
        tr_store(done, Tl, c.tid); IT = nx; \
        LDS_BAR(); }
    CONV_STEP(ia, ta, va)
    if (ib >= 0) {
        CONV_STEP(ib, tb, vb)
        while (ia >= 0) {
            CONV_STEP(ia, ta, va)
            if (ib < 0) break;
            CONV_STEP(ib, tb, vb)
        }
    }
#undef CONV_STEP
}

DEVI void phase_hl(const Params& p, const Ctx& c) {
    const float* mod = (const float*)(p.ws + WS_MOD); bf16_t* HL = (bf16_t*)(p.ws + WS_HL);
    auto row_src = [&](int r) { const int b = r / SEQ, s = r % SEQ; return (s < CTXL ? p.ctx + ((size_t)b * CTXL + s) * DM : p.x + ((size_t)b * LSEQ + (s - CTXL)) * DM); };
    f32x4 vn[4];
    { const f32x4* xr0 = (const f32x4*)row_src(c.gw < TT ? c.gw : 0) + c.lane;
#pragma unroll
      for (int j = 0; j < 4; ++j) vn[j] = xr0[64 * j]; }
    for (int r = c.gw; r < TT; r += c.NGW) {
        const int b = r / SEQ, s = r % SEQ; const bool isctx = s < CTXL;
        const float* mv = mod + (isctx ? 2 : b) * 6144;
        f32x4 v[4]; float ss = 0.f;
#pragma unroll
        for (int j = 0; j < 4; ++j) { v[j] = vn[j]; ss += (v[j][0] * v[j][0] + v[j][1] * v[j][1]) + (v[j][2] * v[j][2] + v[j][3] * v[j][3]); }
        { const f32x4* xrn = (const f32x4*)row_src(r + c.NGW < TT ? r + c.NGW : r) + c.lane;
#pragma unroll
          for (int j = 0; j < 4; ++j) vn[j] = xrn[64 * j]; }
        const float rstd = __builtin_amdgcn_rsqf(wave_sum(ss) * (1.f / DM) + EPS);
        u32x2* o8 = (u32x2*)(HL + (size_t)r * DM) + c.lane;
#pragma unroll
        for (int j = 0; j < 4; ++j) { const int k = 4 * c.lane + 256 * j;
            const f32x4 g = *(const f32x4*)(p.norm1_g + k), sh = *(const f32x4*)(mv + k), sc = *(const f32x4*)(mv + 1024 + k);
            const f32x4 y = (v[j] * rstd * g) * (sc + 1.f) + sh; u32x2 w; w.x = pk2(y[0], y[1]); w.y = pk2(y[2], y[3]); o8[64 * j] = w; }
    }
}

DEVI void phase_post(const Params& p, const Ctx& c) {
    bf16_t* P = (bf16_t*)(p.ws + WS_P); const float2* tabR = (const float2*)(p.ws + WS_TABR); const float2* tabD = (const float2*)(p.ws + WS_TABD);
    auto ld6 = [&](int r, u32x4 (&L)[6]) { const bf16_t* pr_ = P + (size_t)r * NP; const bf16_t* q1_ = pr_ + C_RQ + (c.lane >> 3) * 128 + (c.lane & 7) * 8;
        L[0] = *(const u32x4*)q1_; L[1] = *(const u32x4*)(q1_ + 64);
        const bf16_t* d0_ = pr_ + C_DQ + (c.lane >> 2) * 64 + (c.lane & 3) * 16; L[2] = *(const u32x4*)d0_; L[3] = *(const u32x4*)(d0_ + 8);
        const bf16_t* d1_ = pr_ + C_DK + (c.lane >> 2) * 64 + (c.lane & 3) * 16; L[4] = *(const u32x4*)d1_; L[5] = *(const u32x4*)(d1_ + 8); };
    u32x4 Ln[6]; ld6(c.gw < TT ? c.gw : 0, Ln);
    for (int r = c.gw; r < TT; r += c.NGW) {
        const int s = r % SEQ; const bool lat = s >= CTXL; const int tpos = lat ? s - CTXL : 0; const int prow = tpos >> 6, pcol = tpos & 63;
        bf16_t* pr = P + (size_t)r * NP;
        u32x4 Lc[6];
#pragma unroll
        for (int i = 0; i < 6; ++i) Lc[i] = Ln[i];
        ld6(r + c.NGW < TT ? r + c.NGW : r, Ln);
        if (lat) {
            const int blk = c.lane >> 3, i8 = (c.lane & 7) * 8; const int pos = (blk & 1) ? pcol : prow;
            bf16_t* q1 = pr + C_RQ + blk * 128 + i8; const u32x4 a = Lc[0], bq = Lc[1];
            const unsigned aw[4] = {a.x, a.y, a.z, a.w}, bw[4] = {bq.x, bq.y, bq.z, bq.w}; unsigned o1[4], o2[4];
#pragma unroll
            for (int e = 0; e < 4; ++e) { const float2 t0 = tabR[pos * 64 + i8 + 2 * e], t1 = tabR[pos * 64 + i8 + 2 * e + 1];
                const float x1a = lo_f(aw[e]), x1b = hi_f(aw[e]), x2a = lo_f(bw[e]), x2b = hi_f(bw[e]);
                o1[e] = pk2((x1a * t0.x - x2a * t0.y) * 0.0625f, (x1b * t1.x - x2b * t1.y) * 0.0625f);
                o2[e] = pk2((x1a * t0.y + x2a * t0.x) * 0.0625f, (x1b * t1.y + x2b * t1.x) * 0.0625f); }
            *(u32x4*)q1 = (u32x4){o1[0], o1[1], o1[2], o1[3]}; *(u32x4*)(q1 + 64) = (u32x4){o2[0], o2[1], o2[2], o2[3]};
            {
                const int bb = r / SEQ, hq = blk >> 1, d0 = (blk & 1) * 128 + i8, cc = s >> 7, ii = s & 127;
                bf16_t* QFp = (bf16_t*)(p.ws + WS_DV);
                *(u32x4*)(QFp + ret::qf_index(bb, hq, cc, ii >> 4, d0 >> 5, (d0 >> 3) & 3, ii & 15)) = (u32x4){o1[0], o1[1], o1[2], o1[3]};
                *(u32x4*)(QFp + ret::qf_index(bb, hq, cc, ii >> 4, (d0 >> 5) + 2, (d0 >> 3) & 3, ii & 15)) = (u32x4){o2[0], o2[1], o2[2], o2[3]};
            }
        }
#pragma unroll
        for (int which = 0; which < 2; ++which) {
            if (which == 0 && !lat) continue;
            const float* gq = which ? p.dk_g : p.dq_g;
            const int q4 = c.lane & 3; bf16_t* dp = pr + (which ? C_DK : C_DQ) + (c.lane >> 2) * 64 + q4 * 16;
            const u32x4 a = which ? Lc[4] : Lc[2], bq = which ? Lc[5] : Lc[3]; const unsigned wv[8] = {a.x, a.y, a.z, a.w, bq.x, bq.y, bq.z, bq.w};
            float v[16]; float ss = 0.f;
#pragma unroll
            for (int e = 0; e < 8; ++e) { v[2 * e] = lo_f(wv[e]); v[2 * e + 1] = hi_f(wv[e]); ss += v[2 * e] * v[2 * e] + v[2 * e + 1] * v[2 * e + 1]; }
            ss += __shfl_xor(ss, 1); ss += __shfl_xor(ss, 2);
            const float rs = __builtin_amdgcn_rsqf(ss * (1.f / 64.f) + EPS);
            const int pos = (q4 & 2) ? pcol : prow; unsigned ow[8]; float y[16];
#pragma unroll
            for (int e = 0; e < 16; ++e) y[e] = v[e] * rs * gq[q4 * 16 + e];
#pragma unroll
            for (int e = 0; e < 16; ++e) { const float other = __shfl_xor(y[e], 1); const float2 t = tabD[pos * 16 + e];
                y[e] = (q4 & 1) ? (other * t.y + y[e] * t.x) : (y[e] * t.x - other * t.y); }
#pragma unroll
            for (int e = 0; e < 8; ++e) ow[e] = pk2(y[2 * e], y[2 * e + 1]);
            *(u32x4*)dp = (u32x4){ow[0], ow[1], ow[2], ow[3]}; *(u32x4*)(dp + 8) = (u32x4){ow[4], ow[5], ow[6], ow[7]};
        }
    }
    bf16_t* KT = (bf16_t*)(p.ws + WS_KT); bf16_t* VT = (bf16_t*)(p.ws + WS_VT);
    bf16_t* Tl = (bf16_t*)c.lds;
    constexpr int TLD = 72;
    constexpr int NU = NB * 132 * 24;
    const int tok = c.tid >> 3, c8 = (c.tid & 7) * 8, wsw = (c.tid & 7) << 3;
    auto unit_src = [&](int u) { const int cb = u % 24, tb = (u / 24) % 132, b = u / (24 * 132); const int colbase = cb < 8 ? C_RK + cb * 128 : C_RV + (cb - 8) * 128;
        return P + ((size_t)b * SEQ + tb * 64 + tok) * NP + colbase + c8; };
    u32x4 a, bq;
    { bf16_t* s0 = unit_src(c.bid < NU ? c.bid : NU - 1); a = *(const u32x4*)s0; bq = *(const u32x4*)(s0 + 64); }
    for (int u = c.bid; u < NU; u += c.G) {
        const int cb = u % 24, tb = (u / 24) % 132, b = u / (24 * 132);
        const int s = tb * 64 + tok; const bool isk = cb < 8;
        bf16_t* src = unit_src(u);
        u32x4 an, bn; { const int un = u + c.G; bf16_t* sn = unit_src(un < NU ? un : NU - 1); an = *(const u32x4*)sn; bn = *(const u32x4*)(sn + 64); }
        if (isk) {
            const bool lat = s >= CTXL; const int tpos = lat ? s - CTXL : 0; const int pos = (cb & 1) ? (tpos & 63) : (tpos >> 6);
            const unsigned aw[4] = {a.x, a.y, a.z, a.w}, bw[4] = {bq.x, bq.y, bq.z, bq.w}; unsigned o1[4], o2[4];
#pragma unroll
            for (int e = 0; e < 4; ++e) { const float2 t0 = tabR[pos * 64 + c8 + 2 * e], t1 = tabR[pos * 64 + c8 + 2 * e + 1];
                const float x1a = lo_f(aw[e]), x1b = hi_f(aw[e]), x2a = lo_f(bw[e]), x2b = hi_f(bw[e]);
                o1[e] = pk2(x1a * t0.x - x2a * t0.y, x1b * t1.x - x2b * t1.y);
                o2[e] = pk2(x1a * t0.y + x2a * t0.x, x1b * t1.y + x2b * t1.x); }
            a = (u32x4){o1[0], o1[1], o1[2], o1[3]}; bq = (u32x4){o2[0], o2[1], o2[2], o2[3]};
            *(u32x4*)src = a; *(u32x4*)(src + 64) = bq;
        }
        { const unsigned aw[4] = {a.x, a.y, a.z, a.w}, bw[4] = {bq.x, bq.y, bq.z, bq.w}; const int tk = tok ^ wsw;
#pragma unroll
          for (int e = 0; e < 4; ++e) { Tl[(c8 + 2 * e) * TLD + tk] = (bf16_t)(aw[e] & 0xffffu); Tl[(c8 + 2 * e + 1) * TLD + tk] = (bf16_t)(aw[e] >> 16);
              Tl[(64 + c8 + 2 * e) * TLD + tk] = (bf16_t)(bw[e] & 0xffffu); Tl[(64 + c8 + 2 * e + 1) * TLD + tk] = (bf16_t)(bw[e] >> 16); } }
        LDS_BAR();
        if (isk) {
            const int col = c.tid & 127, tp = c.tid >> 7, sw = ((col >> 3) & 7) << 3; const u32x4 r0 = *(const u32x4*)(Tl + col * TLD + ((16 * tp) ^ sw)), r1 = *(const u32x4*)(Tl + col * TLD + ((16 * tp + 8) ^ sw));
            const int hk = cb >> 1, d = (cb & 1) * 128 + col, jb = (tb & 1) * 64 + 16 * tp;
            bf16_t* dst = KT + ret::ktf_index(b, hk, tb >> 1, d >> 5, jb >> 4, 0, d & 31);
            *(u32x4*)dst = r0; *(u32x4*)(dst + 32 * 8) = r1;
        } else {
          const int col = c.tid >> 2, t4 = (c.tid & 3) * 16, sw = ((col >> 3) & 7) << 3; const u32x4 r0 = *(const u32x4*)(Tl + col * TLD + (t4 ^ sw)), r1 = *(const u32x4*)(Tl + col * TLD + ((t4 + 8) ^ sw));
          bf16_t* dst = VT + ((size_t)b * 2048 + (cb - 8) * 128 + col) * SEQ + tb * 64 + t4;
          *(u32x4*)dst = r0; *(u32x4*)(dst + 8) = r1; }
        LDS_BAR();
        a = an; bq = bn;
    }
    __syncthreads();
}

DEVI int scan_map(int u, int G) { if (G != 256) return u; const int x = u & 7, j = u >> 3; return ((x + 8 * (j >> 4)) << 4) | (j & 15); }
DEVI void phase_mix(const Params& p, const Ctx& c) {
    const bf16_t* P = (const bf16_t*)(p.ws + WS_P); const bf16_t* KT = (const bf16_t*)(p.ws + WS_KT); const bf16_t* VT = (const bf16_t*)(p.ws + WS_VT);
    const float* scal = (const float*)(p.ws + WS_SCAL);
#ifndef MK_MIX_PROBE
#define MK_MIX_PROBE 0
#endif
#ifndef MK_MIX_ONLY
#define MK_MIX_ONLY 0
#endif
    const float lam = scal[8];
    const bool attn_first = (c.G == 256) && (c.bid >= 128);
#define MIX_RET() do { for (int u = c.bid; u < 256; u += c.G) ret::scan_unit(scan_map(u & 255, c.G), (const bf16_t*)(p.ws + WS_DV), KT, VT, (bf16_t*)(p.ws + WS_OF), (bf16_t*)(p.ws + WS_OB), scal, c.lds); \
        for (int u = c.bid; u < 512; u += c.G) ret::intra_unit(u & 511, P, VT, (bf16_t*)(p.ws + WS_OI), scal, c.lds); } while (0)
    if (!attn_first) MIX_RET();
    for (int a_ = c.bid; a_ < 1024; a_ += c.G) { const int a = a_ & 1023;
        const int rr = a / c.G, wq = a % c.G; int bh, qb;
        if (c.G == 256) { const int xcd = wq & 7, j = wq >> 3; bh = xcd * 2 + (rr >> 1); qb = (rr & 1) * 32 + j; } else { bh = a >> 6; qb = a & 63; }
        const int b = bh >> 3, h = bh & 7;
        const bf16_t* Qb = P + ((size_t)b * SEQ + CTXL + qb * 128) * NP + C_DQ + h * 128;
        const bf16_t* Kh = P + ((size_t)b * SEQ) * NP + C_DK + h * 128;
        const bf16_t* Vh = P + ((size_t)b * SEQ) * NP + C_DV + h * 128;
        bf16_t* Ob = (bf16_t*)(p.ws + WS_OD) + ((size_t)b * LSEQ + qb * 128) * 1024 + h * 128;
        att::attn_unit(Qb, Kh, Vh, Ob, lam, p.dn_g, c.lds);
    }
    if (attn_first) { __syncthreads(); MIX_RET(); }
#undef MIX_RET
}

DEVI void phase_retgate(const Params& p, const Ctx& c) {
    bf16_t* OI = (bf16_t*)(p.ws + WS_OI); const bf16_t* OF = (const bf16_t*)(p.ws + WS_OF); const bf16_t* OB = (const bf16_t*)(p.ws + WS_OB); const bf16_t* P = (const bf16_t*)(p.ws + WS_P);
    for (int it = c.gw; it < T * 4; it += c.NGW) {
        const int t = it >> 2, h = it & 3; const size_t off = (size_t)t * 2048 + h * 512 + c.lane * 8;
        const u32x4 a = *(const u32x4*)(OI + off), f = *(const u32x4*)(OF + off), bb = *(const u32x4*)(OB + off);
        const u32x4 rg = *(const u32x4*)(P + (size_t)rowc_of(t) * NP + C_RG + h * 512 + c.lane * 8);
        const unsigned aw[4] = {a.x, a.y, a.z, a.w}, fw[4] = {f.x, f.y, f.z, f.w}, bw[4] = {bb.x, bb.y, bb.z, bb.w}, gw_[4] = {rg.x, rg.y, rg.z, rg.w};
        float v[8]; float ss = 0.f;
#pragma unroll
        for (int e = 0; e < 4; ++e) { v[2 * e] = lo_f(aw[e]) + lo_f(fw[e]) + lo_f(bw[e]); v[2 * e + 1] = hi_f(aw[e]) + hi_f(fw[e]) + hi_f(bw[e]); ss += v[2 * e] * v[2 * e] + v[2 * e + 1] * v[2 * e + 1]; }
        const float rs = __builtin_amdgcn_rsqf(wave_sum(ss) * (1.f / 512.f) + EPS);
        const float* g = p.ret_norm_g + h * 512 + c.lane * 8; unsigned ow[4];
#pragma unroll
        for (int e = 0; e < 4; ++e) ow[e] = pk2(v[2 * e] * rs * g[2 * e] * siluf_(lo_f(gw_[e])), v[2 * e + 1] * rs * g[2 * e + 1] * siluf_(hi_f(gw_[e])));
        *(u32x4*)(OI + off) = (u32x4){ow[0], ow[1], ow[2], ow[3]};
    }
}

DEVI void phase_route(const Params& p, const Ctx& c) {
    constexpr int RW_LD = 1028;
    float* rwT = (float*)c.lds;
    for (int i = c.tid; i < 8 * 1024; i += 512) {
        const f32x4 w4 = ((const f32x4*)p.router_w)[i]; const int k = i >> 3, e0 = (i & 7) * 4;
        rwT[(e0 + 0) * RW_LD + k] = w4[0]; rwT[(e0 + 1) * RW_LD + k] = w4[1]; rwT[(e0 + 2) * RW_LD + k] = w4[2]; rwT[(e0 + 3) * RW_LD + k] = w4[3]; }
    __syncthreads();
    const float* mod = (const float*)(p.ws + WS_MOD); bf16_t* H2 = (bf16_t*)(p.ws + WS_HL);
    int* cnt = (int*)(p.ws + WS_CNT); int* ltok = (int*)(p.ws + WS_LTOK); float* lgate = (float*)(p.ws + WS_LGATE); int* pos = (int*)(p.ws + WS_POS);
    int2* stash = (int2*)(c.lds + 135168) + c.wave * 64; int* stok = (int*)(c.lds + 135168 + 8 * 64 * 8) + c.wave * 16; int nst = 0;
    f32x4 vn[4];
    { const int t0 = c.gw < T ? c.gw : 0; const f32x4* xr0 = (const f32x4*)(p.out + (size_t)t0 * DM) + c.lane;
#pragma unroll
      for (int j = 0; j < 4; ++j) vn[j] = xr0[64 * j]; }
    for (int t = c.gw; t < T; t += c.NGW) {
        const int b = t >> 13; const float* mv = mod + b * 6144;
        f32x4 v[4]; float ss = 0.f;
#pragma unroll
        for (int j = 0; j < 4; ++j) { v[j] = vn[j]; ss += (v[j][0] * v[j][0] + v[j][1] * v[j][1]) + (v[j][2] * v[j][2] + v[j][3] * v[j][3]); }
        { const int tn = t + c.NGW < T ? t + c.NGW : t; const f32x4* xrn = (const f32x4*)(p.out + (size_t)tn * DM) + c.lane;
#pragma unroll
          for (int j = 0; j < 4; ++j) vn[j] = xrn[64 * j]; }
        const float rstd = __builtin_amdgcn_rsqf(wave_sum(ss) * (1.f / DM) + EPS);
        u32x2* o8 = (u32x2*)(H2 + (size_t)t * DM) + c.lane;
#pragma unroll
        for (int j = 0; j < 4; ++j) { const int k = 4 * c.lane + 256 * j;
            const f32x4 g = *(const f32x4*)(p.norm2_g + k), sh = *(const f32x4*)(mv + 3072 + k), sc = *(const f32x4*)(mv + 4096 + k);
            v[j] = (v[j] * rstd * g) * (sc + 1.f) + sh; u32x2 w; w.x = pk2(v[j][0], v[j][1]); w.y = pk2(v[j][2], v[j][3]); o8[64 * j] = w; }
        float a[32];
#pragma unroll
        for (int e = 0; e < 32; ++e) { float s = 0.f;
#pragma unroll
            for (int j = 0; j < 4; ++j) { const f32x4 wv = *(const f32x4*)(rwT + e * RW_LD + 4 * c.lane + 256 * j); s += (v[j][0] * wv[0] + v[j][1] * wv[1]) + (v[j][2] * wv[2] + v[j][3] * wv[3]); }
            a[e] = s; if ((e & 3) == 3) __builtin_amdgcn_sched_barrier(0); }
#define HALVE(N, OFF) _Pragma("unroll") for (int i = 0; i < (N) / 2; ++i) { const bool up = (c.lane & (OFF)) != 0; const float snd = up ? a[i] : a[i + (N) / 2]; const float rcv = __shfl_xor(snd, (OFF)); a[i] = (up ? a[i + (N) / 2] : a[i]) + rcv; }
        HALVE(32, 32) HALVE(16, 16) HALVE(8, 8) HALVE(4, 4) HALVE(2, 2)
#undef HALVE
        float logit = a[0] + __shfl_xor(a[0], 1); const int myE = c.lane >> 1; logit += p.router_b[myE];
        float tv[4]; int ti[4]; float cur = logit;
#pragma unroll
        for (int k = 0; k < 4; ++k) { float bv = cur; int bi = myE;
#pragma unroll
            for (int o = 1; o < 64; o <<= 1) { const float ov = __shfl_xor(bv, o); const int oi = __shfl_xor(bi, o); if (ov > bv || (ov == bv && oi < bi)) { bv = ov; bi = oi; } }
            tv[k] = bv; ti[k] = bi; if (myE == bi) cur = -3.0e38f; }
        const float e1 = __expf(tv[1] - tv[0]), e2 = __expf(tv[2] - tv[0]), e3 = __expf(tv[3] - tv[0]); const float inv = 1.f / (1.f + e1 + e2 + e3);
        if (c.lane < 4) { const int k = c.lane; const int e = k == 0 ? ti[0] : (k == 1 ? ti[1] : (k == 2 ? ti[2] : ti[3])); const float g = (k == 0 ? 1.f : (k == 1 ? e1 : (k == 2 ? e2 : e3))) * inv;
            stash[nst * 4 + k] = make_int2(e, __float_as_int(g)); }
        if (c.lane == 0) stok[nst] = t;
        ++nst;
        if (nst == 16 || t + c.NGW >= T) {
            asm volatile("s_waitcnt lgkmcnt(0)" ::: "memory");
            if (c.lane < nst * 4) { const int2 eg = stash[c.lane]; const int tt = stok[c.lane >> 2], e = eg.x;
                const int slot = atomicAdd(cnt + e, 1); ltok[e * CAP + slot] = tt; lgate[e * CAP + slot] = __int_as_float(eg.y); pos[tt * 4 + (c.lane & 3)] = e * CAP + slot; }
            asm volatile("s_waitcnt lgkmcnt(0)" ::: "memory");
            nst = 0; }
    }
    __syncthreads();
}

DEVI int build_tiles(const Params& p, const Ctx& c) {
    LAS int* tb = (LAS int*)(c.lds + LDS_TAB);
    const int* cnt = (const int*)(p.ws + WS_CNT);
    if (c.tid < 32) tb[576 + c.tid] = cnt[c.tid];
    __syncthreads();
    if (c.tid < 32) {
        const int e = c.tid; int base = 0, tot = 0;
        for (int j = 0; j < 32; ++j) { const int nj = (tb[576 + j] + 255) >> 8; base += j < e ? nj : 0; tot += nj; }
        const int n = (tb[576 + e] + 255) >> 8; tb[608 + e] = base;
        for (int i = 0; i < n; ++i) { tb[base + i] = e; tb[288 + base + i] = i * 256; }
        if (e == 0) tb[640] = tot; }
    __syncthreads();
    return tb[640];
}

DEVI void phase_combine(const Params& p, const Ctx& c) {
    const int NT = build_tiles(p, c); (void)NT;
    LAS int* tb = (LAS int*)(c.lds + LDS_TAB);
    const float* mod = (const float*)(p.ws + WS_MOD); const int* pos = (const int*)(p.ws + WS_POS); const bf16_t* Y = (const bf16_t*)(p.ws + WS_Y);
    for (int t = c.gw; t < T; t += c.NGW) {
        const int b = t >> 13; size_t yr[4];
#pragma unroll
        for (int k = 0; k < 4; ++k) { const int pp = pos[t * 4 + k]; const int e = pp >> 14, slot = pp & (CAP - 1); yr[k] = (size_t)(tb[608 + e] * 256 + slot) * 1024; }
        float* orow = p.out + (size_t)t * DM;
#pragma unroll
        for (int j = 0; j < 2; ++j) { const int k0 = c.lane * 8 + 512 * j; float s[8] = {0.f, 0.f, 0.f, 0.f, 0.f, 0.f, 0.f, 0.f};
#pragma unroll
            for (int k = 0; k < 4; ++k) { const u32x4 y = *(const u32x4*)(Y + yr[k] + k0); s[0] += lo_f(y.x); s[1] += hi_f(y.x); s[2] += lo_f(y.y); s[3] += hi_f(y.y); s[4] += lo_f(y.z); s[5] += hi_f(y.z); s[6] += lo_f(y.w); s[7] += hi_f(y.w); }
            const float* gp = mod + b * 6144 + 5120 + k0;
            f32x4 x0 = *(const f32x4*)(orow + k0), x1 = *(const f32x4*)(orow + k0 + 4);
            const f32x4 g0 = *(const f32x4*)gp, g1 = *(const f32x4*)(gp + 4);
            x0 += g0 * (f32x4){s[0], s[1], s[2], s[3]}; x1 += g1 * (f32x4){s[4], s[5], s[6], s[7]};
            *(f32x4*)(orow + k0) = x0; *(f32x4*)(orow + k0 + 4) = x1; }
    }
}

__global__ void __launch_bounds__(512, 2) mk_fwd(Params p) {
    extern __shared__ __attribute__((aligned(16))) unsigned char lds_raw[];
    Ctx c; c.tid = threadIdx.x; c.lane = c.tid & 63; c.wave = __builtin_amdgcn_readfirstlane(c.tid >> 6); c.G = gridDim.x; c.bid = blockIdx.x;
    c.gw = c.bid * 8 + c.wave; c.NGW = c.G * 8; c.lds = (char*)lds_raw;
    LAS unsigned char* lds = (LAS unsigned char*)lds_raw;
    unsigned char* ws = p.ws;
    const int lo = p.ph_lo, hi = p.ph_hi;
#define IN(k) (lo <= (k) && (k) < hi)
#ifndef MK_REPEAT_PHASE
#define MK_REPEAT_PHASE (-1)
#define MK_REPEAT_N 0
#endif
#define REPS(k)
    volatile LAS unsigned* bst = (volatile LAS unsigned*)(lds + LDS_BYTES - 16);
    if (c.tid < 4) bst[c.tid] = 0u;
    __syncthreads();
    if (lo == 0 && hi == NPH) {
        if (c.bid == 0) { for (int i = c.tid; i < (int)(WS_ZERO_BYTES / 4); i += 512) ((unsigned*)ws)[i] = 0u; __threadfence(); }
        cg::this_grid().sync();
    }
    XcdBarrier xbar = xcd_barrier_post((unsigned*)(ws + WS_BAR), bst);
#define SEAM(k) do { if (IN(k) && IN((k) + 1)) xcd_barrier(xbar); } while (0)
#define PH0 { phase_prep(p, c); }
#define PH1 { phase_hl(p, c); }
#define PH2 { const int ncv = pg8::conv_count((TT / 256) * (NP / 256), c.G); \
        if (c.bid < c.G - ncv) { pg8::ProbDense S; S.init(ws + WS_HL, ws + WS_WIN, TT, NP, 1024, c.G, c.bid, ncv); EpiStoreBf16 E{(bf16_t*)(ws + WS_P), NP}; pg8::gemm_phase(lds, S, E); \
            if (c.tid == 0) atomicAdd((int*)(ws + WS_Q) + 128, 1); conv_run(p, c, 0, true, false); } \
        else { conv_run(p, c, 0, false, false); conv_run(p, c, 1, false, true); } }
#define PH3 { phase_post(p, c); }
#define PH4 { phase_mix(p, c); }
#define PH5 { phase_retgate(p, c); }
#define PH6 { { pg8::ProbDense S; S.init(ws + WS_OI, ws + WS_WBR, T, 1024, 2048, c.G, c.bid); EpiGate1 E{(float*)(ws + WS_OF), (const bf16_t*)(ws + WS_P)}; pg8::gemm_phase(lds, S, E); } \
        __syncthreads(); \
        { pg8::ProbDense S; S.init(ws + WS_OD, ws + WS_WBD, T, 1024, 1024, c.G, c.bid); EpiGate2 E{(const float*)(ws + WS_OF), (bf16_t*)(ws + WS_OB), (const bf16_t*)(ws + WS_P)}; pg8::gemm_phase(lds, S, E); } }
#define PH7 { pg8::ProbDense S; S.init(ws + WS_OB, ws + WS_WOUT, T, 1024, 1024, c.G, c.bid); EpiResid E{p.x, p.out, (const float*)(ws + WS_MOD)}; pg8::gemm_phase(lds, S, E); }
#define PH8 { phase_route(p, c); }
#define PH9 { const int NT = build_tiles(p, c); LAS int* tb = (LAS int*)(c.lds + LDS_TAB); \
        const int ncv = pg8::conv_count(NT * 8, c.G); \
        if (c.bid < c.G - ncv) { pg8::ProbMoe S; S.A = (const char*)(ws + WS_HL); S.Bt = (const char*)(ws + WS_W1); S.K = 1024; S.nN = 8; S.NT = NT; S.G = c.G; S.c = c.bid; S.nconv = ncv; S.bstride = (size_t)2048 * 1024 * 2; \
            S.tile_e = tb; S.tile_s0 = tb + 288; S.cnt = tb + 576; S.ltok = (const int*)(ws + WS_LTOK); S.gather = true; \
            EpiSwiglu E{(bf16_t*)(ws + WS_ACT), p.b1}; pg8::gemm_phase(lds, S, E); } \
        conv_run(p, c, 1, c.bid < c.G - ncv, false); }
#define PH10 { const int NT = build_tiles(p, c); LAS int* tb = (LAS int*)(c.lds + LDS_TAB); \
        pg8::ProbMoe S; S.A = (const char*)(ws + WS_ACT); S.Bt = (const char*)(ws + WS_W2); S.K = 1024; S.nN = 4; S.NT = NT; S.G = c.G; S.c = c.bid; S.nconv = 0; S.bstride = (size_t)1024 * 1024 * 2; \
        S.tile_e = tb; S.tile_s0 = tb + 288; S.cnt = tb + 576; S.ltok = (const int*)(ws + WS_LTOK); S.gather = false; \
        EpiMoe2 E{(bf16_t*)(ws + WS_Y), p.b2, (const float*)(ws + WS_LGATE), tb + 288, tb + 576}; pg8::gemm_phase(lds, S, E); }
#define PH11 { phase_combine(p, c); }
#ifndef MK_DUP
#define MK_DUP (-1)
#endif
#ifndef MK_ONLY
#define MK_ONLY (-1)
#endif
#define RUN(k, BODY) do { if ((MK_ONLY < 0 || MK_ONLY == (k)) && IN(k)) { BODY if (MK_DUP == (k)) { xcd_barrier(xbar); BODY } } SEAM(k); } while (0)
    RUN(0, PH0); RUN(1, PH1); RUN(2, PH2); RUN(3, PH3);
    if (MK_DUP == 23 && IN(3)) { PH2 xcd_barrier(xbar); PH3 xcd_barrier(xbar); }
    RUN(4, PH4); RUN(5, PH5); RUN(6, PH6); RUN(7, PH7); RUN(8, PH8); RUN(9, PH9); RUN(10, PH10);
    if ((MK_ONLY < 0 || MK_ONLY == 11) && IN(11)) PH11
#undef IN
#undef SEAM
}


extern "C" void kernel_launch(void* const* d_in, const int* in_sizes, int n_in, void* d_out, int out_size, void* d_ws, size_t ws_size, hipStream_t stream) {
    static int grid = 0;
    if (grid == 0) {
        if (n_in != 24 || ws_size < WS_END) { fprintf(stderr, "kernel_launch: unexpected inputs (n_in %d, ws %zu, need %zu)\n", n_in, ws_size, (size_t)WS_END); grid = -1; return; }
        int dev = 0, cus = 0, per_cu = 0;
        (void)hipGetDevice(&dev); (void)hipDeviceGetAttribute(&cus, hipDeviceAttributeMultiprocessorCount, dev);
        if (hipFuncSetAttribute((const void*)mk_fwd, hipFuncAttributeMaxDynamicSharedMemorySize, LDS_BYTES) != hipSuccess) { fprintf(stderr, "kernel_launch: hipFuncSetAttribute failed\n"); grid = -1; return; }
        if (hipOccupancyMaxActiveBlocksPerMultiprocessor(&per_cu, (const void*)mk_fwd, 512, LDS_BYTES) != hipSuccess || per_cu < 1) { fprintf(stderr, "kernel_launch: occupancy query says %d\n", per_cu); per_cu = 1; }
        (void)hipGetLastError();
        grid = cus;
    }
    if (grid < 0) return;
#if !MK_ONE_LAUNCH
    (void)hipMemsetAsync((char*)d_ws, 0, WS_ZERO_BYTES, stream);
#endif
    Params p{};
    const float** pp = (const float**)&p;
    for (int i = 0; i < 24; ++i) pp[i] = (const float*)d_in[i];
    p.out = (float*)d_out; p.ws = (unsigned char*)d_ws;
#if MK_ONE_LAUNCH
    p.ph_lo = 0; p.ph_hi = NPH;
    void* args[] = {&p};
    hipError_t e = hipLaunchCooperativeKernel((const void*)mk_fwd, dim3(grid), dim3(512), args, LDS_BYTES, stream);
    if (e != hipSuccess) fprintf(stderr, "cooperative launch failed: %s (grid %d)\n", hipGetErrorString(e), grid);
#else
#ifndef MK_LAST_PHASE
#define MK_LAST_PHASE (NPH - 1)
#endif
    for (int ph = 0; ph <= MK_LAST_PHASE; ++ph) {
        p.ph_lo = ph; p.ph_hi = ph + 1;
        hipLaunchKernelGGL(mk_fwd, dim3(grid), dim3(512), LDS_BYTES, stream, p);
    }

#endif
}
```

```cpp
#include <hip/hip_runtime.h>
#include <hip/hip_cooperative_groups.h>
#include <cstdio>
#include <cstdint>
namespace cg = cooperative_groups;

#ifndef MK_ONE_LAUNCH
#define MK_ONE_LAUNCH 1
#endif

#define DEVI __device__ __forceinline__
#define LAS __attribute__((address_space(3)))
typedef unsigned short bf16_t;
typedef short bf16x8 __attribute__((ext_vector_type(8)));
typedef short s16x4 __attribute__((ext_vector_type(4)));
typedef float f32x4 __attribute__((ext_vector_type(4)));
typedef float f32x16 __attribute__((ext_vector_type(16)));
typedef unsigned u32x4 __attribute__((ext_vector_type(4)));
typedef unsigned u32x2 __attribute__((ext_vector_type(2)));

constexpr int NB = 2, LSEQ = 8192, CTXL = 256, SEQ = LSEQ + CTXL;
constexpr int T = NB * LSEQ;
constexpr int TT = NB * SEQ;
constexpr int DM = 1024, NP = 11264;
constexpr int C_RQ = 0, C_RK = 1024, C_RV = 2048, C_RG = 4096, C_DQ = 6144, C_DK = 7168, C_DV = 8192, C_GA = 9216, C_GB = 10240;
constexpr int NE = 32, CAP = 16384, MAXTILES = 288;
constexpr float EPS = 1e-6f;
constexpr float LOG2E = 1.4426950408889634f;

constexpr size_t al256(size_t x) { return (x + 255) / 256 * 256; }
constexpr size_t WS_CNT = 0;
constexpr size_t WS_Q = 1024;
constexpr size_t WS_BAR = 4096;
constexpr size_t WS_ZERO_BYTES = 4096 + 16384;
constexpr size_t WS_MOD = WS_ZERO_BYTES;
constexpr size_t WS_SCAL = al256(WS_MOD + 3 * 6144 * 4);
constexpr size_t WS_TABR = WS_SCAL + 256;
constexpr size_t WS_TABD = WS_TABR + 128 * 64 * 8;
constexpr size_t WS_WIN = al256(WS_TABD + 128 * 16 * 8);
constexpr size_t WS_WBR = WS_WIN + (size_t)NP * DM * 2;
constexpr size_t WS_WBD = WS_WBR + (size_t)1024 * 2048 * 2;
constexpr size_t WS_WOUT = WS_WBD + (size_t)1024 * 1024 * 2;
constexpr size_t WS_W1 = WS_WOUT + (size_t)1024 * 1024 * 2;
constexpr size_t WS_W2 = WS_W1 + (size_t)NE * 2048 * 1024 * 2;
constexpr size_t WS_HL = WS_W2 + (size_t)NE * 1024 * 1024 * 2;
constexpr size_t WS_P = WS_HL + (size_t)TT * DM * 2;
constexpr size_t WS_KT = WS_P + (size_t)TT * NP * 2;
constexpr size_t WS_VT = WS_KT + (size_t)NB * 1024 * SEQ * 2;
constexpr size_t WS_OI = WS_VT + (size_t)NB * 2048 * SEQ * 2;
constexpr size_t WS_OF = WS_OI + (size_t)T * 2048 * 2;
constexpr size_t WS_OB = WS_OF + (size_t)T * 2048 * 2;
constexpr size_t WS_OD = WS_OB + (size_t)T * 2048 * 2;
constexpr size_t WS_LTOK = WS_OD + (size_t)T * 1024 * 2;
constexpr size_t WS_LGATE = WS_LTOK + (size_t)NE * CAP * 4;
constexpr size_t WS_POS = WS_LGATE + (size_t)NE * CAP * 4;
constexpr size_t WS_DV = WS_POS + (size_t)T * 4 * 4;
constexpr size_t WS_DUMMY = WS_DV + (size_t)NB * 8 * SEQ * 128 * 2;
constexpr size_t WS_END = WS_DUMMY + (size_t)128 * 2048 * 2;
constexpr size_t WS_ACT = WS_P;
constexpr size_t WS_Y = WS_P + (size_t)MAXTILES * 256 * 1024 * 2;
static_assert(WS_Y + (size_t)MAXTILES * 256 * 1024 * 2 <= WS_KT, "act/y overlay must fit in P");
static_assert(WS_END <= ((size_t)1 << 30), "workspace must fit 1 GiB");

struct Params {
    const float *x, *c, *ctx, *c_ctx, *norm1_g, *norm2_g, *w_mod, *b_mod, *w_in, *ret_decay, *ret_norm_g, *dq_g, *dk_g, *dlam, *dn_g,
        *w_br_ret, *w_br_diff, *w_out, *router_w, *router_b, *w1, *b1, *w2, *b2;
    float* out; unsigned char* ws;
    int ph_lo, ph_hi;
};

DEVI float bf2f(unsigned u) { return __uint_as_float(u << 16); }
DEVI unsigned f2bf(float f) { unsigned u = __float_as_uint(f); return (u + 0x7fffu + ((u >> 16) & 1u)) >> 16; }
typedef __bf16 bf16x2_t __attribute__((ext_vector_type(2)));
typedef float f32x2_t __attribute__((ext_vector_type(2)));
DEVI unsigned pk2(float lo, float hi) { const f32x2_t v = {lo, hi}; const bf16x2_t b = __builtin_convertvector(v, bf16x2_t); return __builtin_bit_cast(unsigned, b); }
DEVI unsigned pk2a(float lo, float hi) { unsigned r; asm volatile("v_cvt_pk_bf16_f32 %0, %1, %2" : "=v"(r) : "v"(lo), "v"(hi)); return r; }
DEVI float lo_f(unsigned w) { return __uint_as_float(w << 16); }
DEVI float hi_f(unsigned w) { return __uint_as_float(w & 0xffff0000u); }
DEVI float wave_sum(float v) {
#pragma unroll
    for (int o = 1; o < 64; o <<= 1) v += __shfl_xor(v, o);
    return v;
}
DEVI int lane_id_fresh() { int l; asm volatile("v_mbcnt_lo_u32_b32 %0, -1, 0\n\tv_mbcnt_hi_u32_b32 %0, -1, %0" : "=v"(l)); return l; }
DEVI float sigmoidf_(float x) { return __builtin_amdgcn_rcpf(1.f + __builtin_amdgcn_exp2f(-x * LOG2E)); }
DEVI float siluf_(float x) { return x * sigmoidf_(x); }
#define LDS_WAIT() asm volatile("s_waitcnt lgkmcnt(0)" ::: "memory")
#define VM_WAIT() asm volatile("s_waitcnt vmcnt(0)" ::: "memory")


#define XB_TMO      128
#define XB_XCNT(j)  (256  + 64 * (j))
#define XB_XSUB(j)  (1280 + 64 * (j))
#define XB_XGEN(j)  (2304 + 64 * (j))
#define XB_TOP      3328
#define XB_TOPGEN   3392
#define XCD_BAR_WORDS 3456
#define XB_SPIN_CAP (1u << 18)
DEVI unsigned xb_ld(unsigned* p)              { return __hip_atomic_load(p, __ATOMIC_RELAXED, __HIP_MEMORY_SCOPE_AGENT); }
DEVI unsigned xb_add(unsigned* p, unsigned v) { return __hip_atomic_fetch_add(p, v, __ATOMIC_RELAXED, __HIP_MEMORY_SCOPE_AGENT); }
DEVI unsigned xb_xcc_id() { return (unsigned)__builtin_amdgcn_s_getreg((3 << 11) | 20) & 0xFu; }
#define XB_SPIN(cond, bar) do { unsigned _sp = 0; while (cond) { __builtin_amdgcn_s_sleep(1); \
    if ((++_sp & 255u) == 0u) { if (xb_ld(&(bar)[XB_TMO])) break; if (_sp > XB_SPIN_CAP) { atomicAdd(&(bar)[XB_TMO], 1u); break; } } } } while (0)
struct XcdBarrier { unsigned* bar; unsigned x; volatile LAS unsigned* st; };
DEVI XcdBarrier xcd_barrier_post(unsigned* bar, volatile LAS unsigned* st) {
    XcdBarrier b; b.bar = bar; b.x = xb_xcc_id(); b.st = st;
    if (threadIdx.x == 0) (void)xb_add(&bar[XB_XCNT(b.x)], 1u);
    return b;
}
DEVI void xcd_barrier_complete(unsigned* bar, unsigned x, unsigned& nloc, unsigned& nx) {
    const unsigned G = gridDim.x * gridDim.y * gridDim.z;
    unsigned sum, cnt, mine, sp = 0u;
    for (;;) {
        sum = 0u; cnt = 0u; mine = 0u;
#pragma unroll
        for (unsigned j = 0; j < 16; ++j) { const unsigned c = xb_ld(&bar[XB_XCNT(j)]); sum += c; cnt += (c > 0u) ? 1u : 0u; mine = (j == x) ? c : mine; }
        if (sum == G) break;
        __builtin_amdgcn_s_sleep(1);
        if ((++sp & 255u) == 0u) { if (xb_ld(&bar[XB_TMO])) break; if (sp > XB_SPIN_CAP) { atomicAdd(&bar[XB_TMO], 1u); break; } }
    }
    nloc = mine > 0u ? mine : 1u; nx = cnt > 0u ? cnt : 1u;
}
DEVI void xcd_barrier(const XcdBarrier& b) {
    asm volatile("s_waitcnt vmcnt(0)" ::: "memory");
    __syncthreads();
    if (threadIdx.x == 0) {
        unsigned* bar = b.bar;
        __builtin_amdgcn_s_waitcnt(0);
        unsigned nloc = b.st[0], nx = b.st[1];
        if (nloc == 0u) { xcd_barrier_complete(bar, b.x, nloc, nx); b.st[0] = nloc; b.st[1] = nx; }
        const unsigned old = xb_add(&bar[XB_XSUB(b.x)], 1u);
        const unsigned gen = old / nloc;
        if (old + 1u == (gen + 1u) * nloc) {
            __builtin_amdgcn_fence(__ATOMIC_RELEASE, "agent");
            asm volatile("s_waitcnt vmcnt(0)" ::: "memory");
            const unsigned og = xb_add(&bar[XB_TOP], 1u);
            const unsigned tg = og / nx;
            if (og + 1u == (tg + 1u) * nx) xb_add(&bar[XB_TOPGEN], 1u);
            else XB_SPIN(xb_ld(&bar[XB_TOPGEN]) == tg, bar);
            __builtin_amdgcn_fence(__ATOMIC_ACQUIRE, "agent");
            xb_add(&bar[XB_XGEN(b.x)], 1u);
            asm volatile("s_waitcnt vmcnt(0)" ::: "memory");
        } else {
            XB_SPIN(xb_ld(&bar[XB_XGEN(b.x)]) == gen, bar);
            __builtin_amdgcn_fence(__ATOMIC_ACQUIRE, "agent");
            asm volatile("s_waitcnt vmcnt(0)" ::: "memory");
        }
    }
    __syncthreads();
}

namespace pg8 {
constexpr int BM = 256, BK = 64, HALF = 128, HTB = HALF * BK * 2, STAGE_BYTES = 8 * HTB, NXCD = 8, WGM = 8;
__host__ __device__ __forceinline__ int lds_byte(int r, int c) { const int st = (r >> 4) * 2 + (c >> 5), rr = r & 15, cc = c & 31, ob = rr * 64 + cc * 2; return st * 1024 + (ob ^ (((ob >> 9) & 1) << 5)); }
__host__ __device__ __forceinline__ void stage_rc(int b, int& R, int& C) { const int st = b / 1024, sb = b % 1024, swz = sb ^ (((sb >> 9) & 1) << 5); R = (st >> 1) * 16 + swz / 64; C = (st & 1) * 32 + (swz % 64) / 2; }
__host__ __device__ __forceinline__ int perm32(int rho) { const int n = rho >> 4, i = rho & 15; return 8 * (i >> 2) + 4 * n + (i & 3); }
struct Unit { int pm, pn, g; };

DEVI int conv_count(int units, int G) { const int Rf = units / G, rem = units - Rf * G; return rem ? (G - rem) / (Rf + 1) : 0; }
DEVI bool adopt(int units, int G, int c, int nconv, int i, long& L) {
    const int Rf = units / G, rem = units - Rf * G;
    if (i > Rf) return false;
    if (i == Rf && c >= rem) { const int j = c - rem; if (j >= nconv * Rf) return false; L = (long)(j / nconv) * G + (G - nconv) + (j % nconv); }
    return true;
}
struct ProbDense {
    const char* A; const char* Bt; int K, nM, nN, nwg, G, c, nconv;
    DEVI void init(const void* A_, const void* Bt_, int M, int N, int K_, int G_, int c_, int nconv_ = 0) { A = (const char*)A_; Bt = (const char*)Bt_; K = K_; nM = M / BM; nN = N / BM; nwg = nM * nN; G = G_; c = c_; nconv = nconv_; }
    DEVI bool next(int i, Unit& u) const {
        long L = (long)i * G + c;
        if (nconv) { if (!adopt(nwg, G, c, nconv, i, L)) return false; }
        if (L >= nwg) return false;
        int wgid = (int)L; { const int q = nwg / NXCD, r = nwg % NXCD, xcd = wgid % NXCD, off = wgid / NXCD; wgid = (xcd < r ? xcd * (q + 1) : r * (q + 1) + (xcd - r) * q) + off; }
        const int nig = WGM * nN, gid = wgid / nig, fm = gid * WGM, gsz = (nM - fm) < WGM ? (nM - fm) : WGM;
        u.pm = fm + ((wgid % nig) % gsz); u.pn = (wgid % nig) / gsz; u.g = 0; return true;
    }
    DEVI void a_offs(const Unit& u, const int (&R)[2], const int (&C)[2], unsigned (&va)[2][2]) const {
#pragma unroll
        for (int h = 0; h < 2; ++h)
#pragma unroll
            for (int i = 0; i < 2; ++i) va[h][i] = (unsigned)(((u.pm * BM + h * HALF + R[i]) * K + C[i]) * 2);
    }
    DEVI const char* b_base(const Unit& u) const { return Bt + (size_t)u.pn * BM * K * 2; }
};

struct ProbMoe {
    const char* A; const char* Bt; int K, nN, NT, G, c, nconv; size_t bstride;
    const LAS int* tile_e; const LAS int* tile_s0; const LAS int* cnt; const int* ltok; bool gather;
    DEVI bool next(int i, Unit& u) const {
        long Ll = (long)i * G + c;
        if (nconv) { if (!adopt(NT * nN, G, c, nconv, i, Ll)) return false; }
        const int L = (int)Ll; const int tile = L / nN; if (tile >= NT) return false;
        u.pm = tile; u.pn = L % nN; u.g = tile_e[tile]; return true;
    }
    DEVI void a_offs(const Unit& u, const int (&R)[2], const int (&C)[2], unsigned (&va)[2][2]) const {
        const int s0 = tile_s0[u.pm], n = cnt[u.g];
#pragma unroll
        for (int h = 0; h < 2; ++h)
#pragma unroll
            for (int i = 0; i < 2; ++i) {
                int row;
                if (gather) { const int slot = s0 + h * HALF + R[i]; row = (slot < n) ? ltok[u.g * CAP + slot] : 0; }
                else row = u.pm * BM + h * HALF + R[i];
                va[h][i] = (unsigned)((row * K + C[i]) * 2);
            }
    }
    DEVI const char* b_base(const Unit& u) const { return Bt + (size_t)u.g * bstride + (size_t)u.pn * BM * K * 2; }
};

template <class Prob, class Epi>
DEVI void gemm_phase(LAS unsigned char* lds, const Prob& S, const Epi& E) {
    const int tid = threadIdx.x, wid = __builtin_amdgcn_readfirstlane(tid >> 6), lane = tid & 63, wr = wid >> 2, wc = wid & 3, fr = lane & 15, fq = lane >> 4;
    const int K = S.K, nt = K / BK;
    int Rs[2], Cs[2]; unsigned voffB[2];
#pragma unroll
    for (int i = 0; i < 2; ++i) { int R, C; stage_rc(tid * 16 + i * 8192, R, C); Rs[i] = R; Cs[i] = C; const int Rb = (R & ~31) + perm32(R & 31); voffB[i] = (unsigned)(Rb * K + C) * 2u; }
    const size_t kstep = (size_t)(BK * 2);
    const size_t hstep = (size_t)HALF * K * 2;
    const unsigned ldsw = (unsigned)wid * 1024u;
    const int aoff = lds_byte(wr * 64 + fr, fq * 8), boff = lds_byte(wc * 32 + fr, fq * 8);
#define PG8_SA(b, h) (((b) * 2 + (h)) * HTB)
#define PG8_SB(b, h) ((4 + (b) * 2 + (h)) * HTB)
#define PG8_STAGE(bufoff, gbase, voff) do { _Pragma("unroll") for (int _i = 0; _i < 2; ++_i) \
        __builtin_amdgcn_global_load_lds((const unsigned*)((const char*)(gbase) + (voff)[_i]), (LAS unsigned*)(lds + (bufoff) + ldsw + _i * 8192), 16, 0, 0); } while (0)
#define PG8_LDA(dst, b, h) do { _Pragma("unroll") for (int m = 0; m < 4; ++m) _Pragma("unroll") for (int k = 0; k < 2; ++k) dst[m][k] = *(const LAS bf16x8*)(lds + PG8_SA(b, h) + aoff + m * 2048 + k * 1024); } while (0)
#define PG8_LDB(dst, b, h) do { _Pragma("unroll") for (int n = 0; n < 2; ++n) _Pragma("unroll") for (int k = 0; k < 2; ++k) dst[n][k] = *(const LAS bf16x8*)(lds + PG8_SB(b, h) + boff + n * 2048 + k * 1024); } while (0)
#define PG8_MMA(ai, bj, At, Bt) do { __builtin_amdgcn_s_setprio(1); _Pragma("unroll") for (int m = 0; m < 4; ++m) _Pragma("unroll") for (int n = 0; n < 2; ++n) _Pragma("unroll") for (int k = 0; k < 2; ++k) \
        acc[ai][bj][m][n] = __builtin_amdgcn_mfma_f32_16x16x32_bf16(Bt[n][k], At[m][k], acc[ai][bj][m][n], 0, 0, 0); __builtin_amdgcn_s_setprio(0); } while (0)
#define PG8_WAIT_V(n) asm volatile("s_waitcnt vmcnt(" #n ")" ::: "memory")
#define PG8_WAIT_L(n) asm volatile("s_waitcnt lgkmcnt(" #n ")" ::: "memory")
#define PG8_BAR __builtin_amdgcn_s_barrier()
#define PG8_SCHED __builtin_amdgcn_sched_barrier(0)
    Unit cur, nxt; int ui = 0;
    if (!S.next(0, cur)) return;
    f32x4 acc[2][2][4][2];
#pragma unroll
    for (int a = 0; a < 2; ++a)
#pragma unroll
        for (int b = 0; b < 2; ++b)
#pragma unroll
            for (int m = 0; m < 4; ++m)
#pragma unroll
                for (int n = 0; n < 2; ++n) acc[a][b][m][n] = (f32x4){0.f, 0.f, 0.f, 0.f};
    bf16x8 At[4][2], B0[2][2], B1[2][2];
    unsigned va[2][2], nva[2][2];
    S.a_offs(cur, Rs, Cs, va);
    const char* cB = S.b_base(cur);
    const char* A0 = S.A;
    PG8_STAGE(PG8_SB(0, 0), cB, voffB); PG8_STAGE(PG8_SB(0, 1), cB + hstep, voffB); PG8_STAGE(PG8_SA(0, 0), A0, va[0]); PG8_STAGE(PG8_SA(0, 1), A0, va[1]);
    if (wr == 1) PG8_BAR;
    PG8_WAIT_V(2); PG8_BAR;
    PG8_STAGE(PG8_SB(1, 0), cB + kstep, voffB); PG8_STAGE(PG8_SA(1, 0), A0 + kstep, va[0]); PG8_STAGE(PG8_SB(1, 1), cB + hstep + kstep, voffB);
    PG8_WAIT_V(6); PG8_BAR;
    for (;;) {
        const bool has_next = S.next(ui + 1, nxt);
        const char* nB = cB;
#pragma unroll
        for (int h = 0; h < 2; ++h)
#pragma unroll
            for (int i = 0; i < 2; ++i) nva[h][i] = va[h][i];
        if (has_next) { S.a_offs(nxt, Rs, Cs, nva); nB = S.b_base(nxt); }
        for (int t = 0; t < nt; t += 2) {
            const bool last = (t == nt - 2);
            const char* a1 = A0 + (size_t)(t + 1) * kstep;
            const char* a2 = last ? A0 : A0 + (size_t)(t + 2) * kstep; const char* b2 = last ? nB : cB + (size_t)(t + 2) * kstep;
            const char* a3 = a2 + kstep; const char* b3 = b2 + kstep;
            unsigned v2[2][2];
#pragma unroll
            for (int h = 0; h < 2; ++h)
#pragma unroll
                for (int i = 0; i < 2; ++i) v2[h][i] = last ? nva[h][i] : va[h][i];
            PG8_LDB(B0, 0, 0); PG8_LDB(B1, 0, 1); PG8_SCHED; PG8_LDA(At, 0, 0); PG8_STAGE(PG8_SA(1, 1), a1, va[1]);
            PG8_WAIT_V(8); PG8_WAIT_L(0); PG8_BAR; PG8_MMA(0, 0, At, B0); PG8_MMA(0, 1, At, B1); PG8_BAR; PG8_SCHED;
            PG8_LDA(At, 0, 1); PG8_STAGE(PG8_SB(0, 0), b2, voffB); PG8_STAGE(PG8_SB(0, 1), b2 + hstep, voffB); PG8_STAGE(PG8_SA(0, 0), a2, v2[0]);
            PG8_WAIT_V(8); PG8_WAIT_L(0); PG8_BAR; PG8_MMA(1, 0, At, B0); PG8_MMA(1, 1, At, B1); PG8_BAR; PG8_SCHED;
            PG8_LDB(B0, 1, 0); PG8_LDB(B1, 1, 1); PG8_SCHED; PG8_LDA(At, 1, 0); PG8_STAGE(PG8_SA(0, 1), a2, v2[1]);
            PG8_WAIT_V(8); PG8_WAIT_L(0); PG8_BAR; PG8_MMA(0, 0, At, B0); PG8_MMA(0, 1, At, B1); PG8_BAR; PG8_SCHED;
            PG8_LDA(At, 1, 1); PG8_STAGE(PG8_SB(1, 0), b3, voffB); PG8_STAGE(PG8_SB(1, 1), b3 + hstep, voffB); PG8_STAGE(PG8_SA(1, 0), a3, v2[0]);
            PG8_WAIT_V(8); PG8_WAIT_L(0); PG8_BAR; PG8_MMA(1, 0, At, B0); PG8_MMA(1, 1, At, B1); PG8_BAR; PG8_SCHED;
        }
        if (wr == 0) PG8_BAR;
        E(acc, cur, wr, wc, fr, fq);
        if (!has_next) break;
#pragma unroll
        for (int a = 0; a < 2; ++a)
#pragma unroll
            for (int b = 0; b < 2; ++b)
#pragma unroll
                for (int m = 0; m < 4; ++m)
#pragma unroll
                    for (int n = 0; n < 2; ++n) acc[a][b][m][n] = (f32x4){0.f, 0.f, 0.f, 0.f};
        cur = nxt; cB = nB; ++ui;
#pragma unroll
        for (int h = 0; h < 2; ++h)
#pragma unroll
            for (int i = 0; i < 2; ++i) va[h][i] = nva[h][i];
        if (wr == 1) PG8_BAR;
    }
    PG8_WAIT_V(0);
    PG8_BAR;
#undef PG8_SA
#undef PG8_SB
#undef PG8_STAGE
#undef PG8_LDA
#undef PG8_LDB
#undef PG8_MMA
#undef PG8_WAIT_V
#undef PG8_WAIT_L
#undef PG8_BAR
#undef PG8_SCHED
}
}

typedef f32x4 AccT[2][2][4][2];
#define EPI_LOOP(...) _Pragma("unroll") for (int ai = 0; ai < 2; ++ai) _Pragma("unroll") for (int m = 0; m < 4; ++m) { const int row = u.pm * 256 + ai * 128 + wr * 64 + m * 16 + fr; \
    _Pragma("unroll") for (int bj = 0; bj < 2; ++bj) { const int col = u.pn * 256 + bj * 128 + wc * 32 + 8 * fq; const f32x4 v0 = acc[ai][bj][m][0], v1 = acc[ai][bj][m][1]; __VA_ARGS__ } }

struct EpiStoreBf16 {
    bf16_t* O; int ldc;
    DEVI void operator()(const AccT& acc, const pg8::Unit& u, int wr, int wc, int fr, int fq) const {
        EPI_LOOP({ u32x4 w; w.x = pk2(v0[0], v0[1]); w.y = pk2(v0[2], v0[3]); w.z = pk2(v1[0], v1[1]); w.w = pk2(v1[2], v1[3]);
                   *(u32x4*)(O + (size_t)row * ldc + col) = w; })
    }
};
DEVI int rowc_of(int t) { return (t >> 13) * SEQ + CTXL + (t & 8191); }
struct EpiGate1 {
    float* M1; const bf16_t* P;
    DEVI void operator()(const AccT& acc, const pg8::Unit& u, int wr, int wc, int fr, int fq) const {
        EPI_LOOP({ const u32x4 g = *(const u32x4*)(P + (size_t)rowc_of(row) * NP + C_GA + col);
                   f32x4 o0, o1; o0[0] = sigmoidf_(lo_f(g.x)) * v0[0]; o0[1] = sigmoidf_(hi_f(g.x)) * v0[1]; o0[2] = sigmoidf_(lo_f(g.y)) * v0[2]; o0[3] = sigmoidf_(hi_f(g.y)) * v0[3];
                   o1[0] = sigmoidf_(lo_f(g.z)) * v1[0]; o1[1] = sigmoidf_(hi_f(g.z)) * v1[1]; o1[2] = sigmoidf_(lo_f(g.w)) * v1[2]; o1[3] = sigmoidf_(hi_f(g.w)) * v1[3];
                   float* d = M1 + (size_t)row * DM + col; *(f32x4*)d = o0; *(f32x4*)(d + 4) = o1; })
    }
};
struct EpiGate2 {
    const float* M1; bf16_t* M; const bf16_t* P;
    DEVI void operator()(const AccT& acc, const pg8::Unit& u, int wr, int wc, int fr, int fq) const {
        EPI_LOOP({ const u32x4 g = *(const u32x4*)(P + (size_t)rowc_of(row) * NP + C_GB + col);
                   const float* s = M1 + (size_t)row * DM + col; const f32x4 a0 = *(const f32x4*)s, a1 = *(const f32x4*)(s + 4);
                   u32x4 w; w.x = pk2(a0[0] + sigmoidf_(lo_f(g.x)) * v0[0], a0[1] + sigmoidf_(hi_f(g.x)) * v0[1]); w.y = pk2(a0[2] + sigmoidf_(lo_f(g.y)) * v0[2], a0[3] + sigmoidf_(hi_f(g.y)) * v0[3]);
                   w.z = pk2(a1[0] + sigmoidf_(lo_f(g.z)) * v1[0], a1[1] + sigmoidf_(hi_f(g.z)) * v1[1]); w.w = pk2(a1[2] + sigmoidf_(lo_f(g.w)) * v1[2], a1[3] + sigmoidf_(hi_f(g.w)) * v1[3]);
                   *(u32x4*)(M + (size_t)row * DM + col) = w; })
    }
};
struct EpiResid {
    const float* x; float* out; const float* mod;
    DEVI void operator()(const AccT& acc, const pg8::Unit& u, int wr, int wc, int fr, int fq) const {
        EPI_LOOP({ const int b = row >> 13; const float* gp = mod + b * 6144 + 2048 + col;
                   const f32x4 g0 = *(const f32x4*)gp, g1 = *(const f32x4*)(gp + 4);
                   const float* xs = x + (size_t)row * DM + col; float* d = out + (size_t)row * DM + col;
                   *(f32x4*)d = *(const f32x4*)xs + g0 * v0; *(f32x4*)(d + 4) = *(const f32x4*)(xs + 4) + g1 * v1; })
    }
};
struct EpiSwiglu {
    bf16_t* act; const float* b1;
    DEVI void operator()(const AccT& acc, const pg8::Unit& u, int wr, int wc, int fr, int fq) const {
        const int cc = u.pn * 128 + wc * 32 + 8 * fq; const float* bg = b1 + (size_t)u.g * 2048 + cc; const float* bl = bg + 1024;
        float g_[8], l_[8];
#pragma unroll
        for (int j = 0; j < 8; ++j) { g_[j] = bg[j]; l_[j] = bl[j]; }
#pragma unroll
        for (int ai = 0; ai < 2; ++ai)
#pragma unroll
            for (int m = 0; m < 4; ++m) {
                const int row = u.pm * 256 + ai * 128 + wr * 64 + m * 16 + fr; float o[8];
#pragma unroll
                for (int j = 0; j < 8; ++j) {
                    const float hg = acc[ai][0][m][j >> 2][j & 3] + g_[j], hl = acc[ai][1][m][j >> 2][j & 3] + l_[j];
                    const float glu = fminf(hg, 7.f), lin = fminf(fmaxf(hl, -7.f), 7.f);
                    o[j] = glu * sigmoidf_(1.702f * glu) * (lin + 1.f);
                }
                u32x4 w; w.x = pk2(o[0], o[1]); w.y = pk2(o[2], o[3]); w.z = pk2(o[4], o[5]); w.w = pk2(o[6], o[7]);
                *(u32x4*)(act + (size_t)row * 1024 + cc) = w;
            }
    }
};
struct EpiMoe2 {
    bf16_t* Y; const float* b2; const float* lgate; const LAS int* tile_s0; const LAS int* cnt;
    DEVI void operator()(const AccT& acc, const pg8::Unit& u, int wr, int wc, int fr, int fq) const {
        const int s0 = tile_s0[u.pm], n = cnt[u.g];
#pragma unroll
        for (int ai = 0; ai < 2; ++ai)
#pragma unroll
            for (int m = 0; m < 4; ++m) {
                const int rl = ai * 128 + wr * 64 + m * 16 + fr, slot = s0 + rl; const int row = u.pm * 256 + rl;
                const float gate = (slot < n) ? lgate[u.g * CAP + slot] : 0.f;
#pragma unroll
                for (int bj = 0; bj < 2; ++bj) {
                    const int col = u.pn * 256 + bj * 128 + wc * 32 + 8 * fq; const float* bp = b2 + (size_t)u.g * 1024 + col;
                    const f32x4 v0 = (acc[ai][bj][m][0] + *(const f32x4*)bp) * gate, v1 = (acc[ai][bj][m][1] + *(const f32x4*)(bp + 4)) * gate;
                    u32x4 w; w.x = pk2(v0[0], v0[1]); w.y = pk2(v0[2], v0[3]); w.z = pk2(v1[0], v1[1]); w.w = pk2(v1[2], v1[3]);
                    *(u32x4*)(Y + (size_t)row * 1024 + col) = w;
                }
            }
    }
};

namespace att {
constexpr int KVBLK = 64, LDQ = NP, LDK = NP;
constexpr float SCALE = 0.125f, THR = 8.f;
constexpr int SHM_V = KVBLK * 128 * 2, SHM_K = KVBLK * 128 * 2;
constexpr int OFF_VR = 0, OFF_KR = 4 * SHM_V;
constexpr int OFF_WS = 4 * SHM_V + 3 * SHM_K;
constexpr int OFF_E = 0;
constexpr int E_LD = 132;
constexpr int LDS_BYTES = OFF_WS + 8 * 64 * 4;
static_assert(128 * E_LD * 4 <= OFF_WS, "epilogue scratch must fit under the per-wave words");
#define KSWZ(row, colB) ((row) * 256 + ((colB) ^ (((row) & 7) << 4)))
#define SBAR() __builtin_amdgcn_sched_barrier(0)
DEVI int crow(int r, int hi) { return (r & 3) + 8 * (r >> 2) + 4 * hi; }
DEVI void partialSM(f32x16& p0, f32x16& p1, float& m_reg, float& mn, float& alpha) {
    constexpr float C = SCALE * LOG2E;
    float pmax = p0[0];
#pragma unroll
    for (int r = 1; r < 16; ++r) pmax = fmaxf(pmax, p0[r]);
#pragma unroll
    for (int r = 0; r < 16; ++r) pmax = fmaxf(pmax, p1[r]);
    { auto rr = __builtin_amdgcn_permlane32_swap(__float_as_uint(pmax), __float_as_uint(pmax), false, false);
      pmax = fmaxf(__uint_as_float(rr[0]), __uint_as_float(rr[1])); }
    if (__builtin_expect(__all(pmax - m_reg <= THR / SCALE), 1)) { mn = m_reg; alpha = 1.f; }
    else { mn = fmaxf(m_reg, pmax); alpha = __builtin_amdgcn_exp2f((m_reg - mn) * C); m_reg = mn; }
    const float mnC = -mn * C;
#pragma unroll
    for (int r = 0; r < 16; ++r) p0[r] = fmaf(p0[r], C, mnC);
#pragma unroll
    for (int r = 0; r < 16; ++r) p1[r] = fmaf(p1[r], C, mnC);
#pragma unroll
    for (int r = 0; r < 16; ++r) p0[r] = __builtin_amdgcn_exp2f(p0[r]);
}
DEVI void finishSM(f32x16& p0, f32x16& p1, float alpha, float& l_reg, bf16x8& pa0, bf16x8& pa1, bf16x8& pa2, bf16x8& pa3) {
#pragma unroll
    for (int r = 0; r < 16; ++r) p1[r] = __builtin_amdgcn_exp2f(p1[r]);
    float ps = 0;
#pragma unroll
    for (int r = 0; r < 16; ++r) ps += p0[r];
#pragma unroll
    for (int r = 0; r < 16; ++r) ps += p1[r];
    { auto rr = __builtin_amdgcn_permlane32_swap(__float_as_uint(ps), __float_as_uint(ps), false, false);
      ps = __uint_as_float(rr[0]) + __uint_as_float(rr[1]); }
    l_reg = l_reg * alpha + ps;
#define PK4(P, BASE, OUT) do { unsigned a0 = pk2a(P[BASE + 0], P[BASE + 1]), a1 = pk2a(P[BASE + 2], P[BASE + 3]);   \
    unsigned b0 = pk2a(P[BASE + 4], P[BASE + 5]), b1 = pk2a(P[BASE + 6], P[BASE + 7]);                              \
    auto r0 = __builtin_amdgcn_permlane32_swap(a0, b0, false, false); auto r1 = __builtin_amdgcn_permlane32_swap(a1, b1, false, false); \
    u32x4 w = {r0[0], r1[0], r0[1], r1[1]}; OUT = *reinterpret_cast<bf16x8*>(&w); } while (0)
    PK4(p0, 0, pa0); PK4(p0, 8, pa1); PK4(p1, 0, pa2); PK4(p1, 8, pa3);
#undef PK4
}
DEVI void qkt(f32x16& p0, f32x16& p1, const char* Ks, const bf16x8* qr, int r32, int hi, int st) {
    p0 = f32x16{}; p1 = f32x16{};
#pragma unroll
    for (int d0 = 0; d0 < 4; ++d0) { const int cb = ((st * 4 + d0) * 16 + hi * 8) * 2;
        const bf16x8 b0 = *reinterpret_cast<const bf16x8*>(Ks + KSWZ(r32, cb));
        const bf16x8 b1 = *reinterpret_cast<const bf16x8*>(Ks + KSWZ(32 + r32, cb));
        p0 = __builtin_amdgcn_mfma_f32_32x32x16_bf16(b0, qr[d0], p0, 0, 0, 0);
        p1 = __builtin_amdgcn_mfma_f32_32x32x16_bf16(b1, qr[d0], p1, 0, 0, 0); }
}
DEVI int v_st(int k, int c) { const int kk = (k & ~0xC) | ((k & 4) << 1) | ((k & 8) >> 1); return ((kk >> 3) * 4 + (c >> 5)) * 512 + ((kk & 7) * 32 + (c & 31)) * 2; }
DEVI int v_rd_base(int lane) { return ((lane & 3) << 3) | (((lane >> 2) & 3) << 6) | (((lane >> 4) & 1) << 5) | (((lane >> 5) & 1) << 8); }
constexpr int v_rd_off(int d0, int ks, int half) { return d0 * 512 + ks * 4096 + half * 2048; }
template <int OFF> DEVI s16x4 tr_read(int vb) {
    s16x4 r; asm volatile("ds_read_b64_tr_b16 %0, %1 offset:%2" : "=&v"(r) : "v"(vb), "i"(OFF) : "memory"); return r;
}
template <int D0> DEVI void pv_one(f32x16& od, int vb, bf16x8 pa0, bf16x8 pa1, bf16x8 pa2, bf16x8 pa3) {
    const s16x4 l0 = tr_read<v_rd_off(D0, 0, 0)>(vb), h0 = tr_read<v_rd_off(D0, 0, 1)>(vb), l1 = tr_read<v_rd_off(D0, 1, 0)>(vb), h1 = tr_read<v_rd_off(D0, 1, 1)>(vb);
    const s16x4 l2 = tr_read<v_rd_off(D0, 2, 0)>(vb), h2 = tr_read<v_rd_off(D0, 2, 1)>(vb), l3 = tr_read<v_rd_off(D0, 3, 0)>(vb), h3 = tr_read<v_rd_off(D0, 3, 1)>(vb);
    asm volatile("s_waitcnt lgkmcnt(0)" ::: "memory"); SBAR();
#define PK(L, H) (bf16x8){L[0], L[1], L[2], L[3], H[0], H[1], H[2], H[3]}
    od = __builtin_amdgcn_mfma_f32_32x32x16_bf16(pa0, PK(l0, h0), od, 0, 0, 0);
    od = __builtin_amdgcn_mfma_f32_32x32x16_bf16(pa1, PK(l1, h1), od, 0, 0, 0);
    od = __builtin_amdgcn_mfma_f32_32x32x16_bf16(pa2, PK(l2, h2), od, 0, 0, 0);
    od = __builtin_amdgcn_mfma_f32_32x32x16_bf16(pa3, PK(l3, h3), od, 0, 0, 0);
#undef PK
}
DEVI void pv_d0(f32x16* o, int vb, bf16x8 pa0, bf16x8 pa1, bf16x8 pa2, bf16x8 pa3) {
    pv_one<0>(o[0], vb, pa0, pa1, pa2, pa3); pv_one<1>(o[1], vb, pa0, pa1, pa2, pa3); pv_one<2>(o[2], vb, pa0, pa1, pa2, pa3); pv_one<3>(o[3], vb, pa0, pa1, pa2, pa3);
}
DEVI void attn_unit(const bf16_t* __restrict__ Qb, const bf16_t* __restrict__ Kh, const bf16_t* __restrict__ Vh, bf16_t* __restrict__ Ob, float lam, const float* __restrict__ dng, char* lds) {
    const int tid = threadIdx.x, wid = __builtin_amdgcn_readfirstlane(tid >> 6), lane = tid & 63, r32 = lane & 31, hi = lane >> 5, w4 = wid & 3, st = wid >> 2;
    char* V_lds = lds + OFF_VR; char* K_lds = lds + OFF_KR; LAS unsigned char* ldsL = (LAS unsigned char*)lds;
    float* wsf = (float*)(lds + OFF_WS) + wid * 64; float* li_l = wsf; float* al_l = wsf + 32;
    float m_reg = -1e30f, l_reg = 0; f32x16 o[4] = {}; bf16x8 qr[4];
    const bf16_t* Qw = Qb + (size_t)(w4 * 32 + r32) * LDQ + st * 64 + hi * 8;
#pragma unroll
    for (int d0 = 0; d0 < 4; ++d0) qr[d0] = *reinterpret_cast<const bf16x8*>(Qw + d0 * 16);
    unsigned kof[2], vof[2];
#pragma unroll
    for (int i = 0; i < 2; ++i) { const int q = 2 * wid + i;
        { const int row = 4 * q + (lane >> 4), colB = ((lane & 15) * 16) ^ ((row & 7) << 4); kof[i] = (unsigned)(row * LDK + colB / 2) * 2u; }
        { const int sub = 2 * q + (lane >> 5), kk = (sub >> 2) * 8 + ((lane & 31) >> 2), cc = (sub & 3) * 32 + (lane & 3) * 8;
          const int k = (kk & ~0xC) | ((kk & 4) << 1) | ((kk & 8) >> 1); vof[i] = (unsigned)(k * LDK + cc) * 2u; } }
    const int vb0 = (int)(uintptr_t)V_lds + v_rd_base(lane);
#define DMA_K(src_tile, slot) do { const char* kb_ = (const char*)Kh + (size_t)(src_tile) * (KVBLK * LDK * 2); _Pragma("unroll") for (int i_ = 0; i_ < 2; ++i_) \
        __builtin_amdgcn_global_load_lds((const unsigned*)(kb_ + kof[i_]), (LAS unsigned*)(ldsL + OFF_KR + (slot) * SHM_K + (2 * wid + i_) * 1024), 16, 0, 0); } while (0)
#define DMA_V(src_tile, slot) do { const char* vb_ = (const char*)Vh + (size_t)(src_tile) * (KVBLK * LDK * 2); _Pragma("unroll") for (int i_ = 0; i_ < 2; ++i_) \
        __builtin_amdgcn_global_load_lds((const unsigned*)(vb_ + vof[i_]), (LAS unsigned*)(ldsL + OFF_VR + (slot) * SHM_V + (2 * wid + i_) * 1024), 16, 0, 0); } while (0)
#define TILE_SYNC(n) do { asm volatile("s_waitcnt vmcnt(" #n ")" ::: "memory"); __builtin_amdgcn_s_barrier(); asm volatile("" ::: "memory"); } while (0)
#define RESC(a) do { if (__any((a) < 1.f)) { if (hi == 0) al_l[r32] = (a); asm volatile("s_waitcnt lgkmcnt(0)" ::: "memory"); \
    _Pragma("unroll") for (int d = 0; d < 4; ++d) _Pragma("unroll") for (int r = 0; r < 16; ++r) o[d][r] *= al_l[crow(r, hi)]; } } while (0)
    f32x16 pA0, pA1, pB0, pB1; float mnA, mnB, alA, alB; bf16x8 pa0, pa1, pa2, pa3; constexpr int NT = SEQ / KVBLK;
#define SEG_X(PN0, PN1, h_, PP0, PP1, alP) do { SBAR(); qkt(PN0, PN1, K_lds + ((h_) % 3) * SHM_K, qr, r32, hi, st); finishSM(PP0, PP1, alP, l_reg, pa0, pa1, pa2, pa3); SBAR(); } while (0)
#define SEG_Y(PN0, PN1, h_, mnN, alN) do { pv_d0(o, vb0 + (((h_) - 1) & 3) * SHM_V, pa0, pa1, pa2, pa3); partialSM(PN0, PN1, m_reg, mnN, alN); RESC(alN); } while (0)
#define ISSUE(h_) do { const int jk_ = (h_) + 2; DMA_K(jk_ < NT ? jk_ : NT - 1, jk_ % 3); DMA_V((h_) + 1, ((h_) + 1) & 3); } while (0)
    DMA_K(0, 0); DMA_V(0, 0); DMA_K(1, 1);
    TILE_SYNC(0);
    if (st == 0) {
        ISSUE(0); qkt(pA0, pA1, K_lds, qr, r32, hi, st); partialSM(pA0, pA1, m_reg, mnA, alA); TILE_SYNC(4);
        for (int h = 1; h + 1 < NT; h += 2) {
            SEG_X(pB0, pB1, h, pA0, pA1, alA);     ISSUE(h);     SEG_Y(pB0, pB1, h, mnB, alB);     TILE_SYNC(4);
            SEG_X(pA0, pA1, h + 1, pB0, pB1, alB); ISSUE(h + 1); SEG_Y(pA0, pA1, h + 1, mnA, alA); TILE_SYNC(4);
        }
        SEG_X(pB0, pB1, NT - 1, pA0, pA1, alA); SEG_Y(pB0, pB1, NT - 1, mnB, alB); TILE_SYNC(0);
        finishSM(pB0, pB1, alB, l_reg, pa0, pa1, pa2, pa3); SBAR();
        pv_d0(o, vb0 + ((NT - 1) & 3) * SHM_V, pa0, pa1, pa2, pa3);
    } else {
        ISSUE(0); qkt(pA0, pA1, K_lds, qr, r32, hi, st); TILE_SYNC(4);
        ISSUE(1); partialSM(pA0, pA1, m_reg, mnA, alA); SEG_X(pB0, pB1, 1, pA0, pA1, alA); TILE_SYNC(4);
        for (int h = 2; h + 3 < NT; h += 2) {
            SEG_Y(pB0, pB1, h - 1, mnB, alB); ISSUE(h);     SEG_X(pA0, pA1, h, pB0, pB1, alB);     TILE_SYNC(4);
            SEG_Y(pA0, pA1, h, mnA, alA);     ISSUE(h + 1); SEG_X(pB0, pB1, h + 1, pA0, pA1, alA); TILE_SYNC(4);
        }
        ISSUE(NT - 2); SEG_Y(pB0, pB1, NT - 3, mnB, alB); SEG_X(pA0, pA1, NT - 2, pB0, pB1, alB); TILE_SYNC(4);
        SEG_Y(pA0, pA1, NT - 2, mnA, alA); SEG_X(pB0, pB1, NT - 1, pA0, pA1, alA); TILE_SYNC(0);
        SEG_Y(pB0, pB1, NT - 1, mnB, alB);
        finishSM(pB0, pB1, alB, l_reg, pa0, pa1, pa2, pa3); SBAR();
        pv_d0(o, vb0 + ((NT - 1) & 3) * SHM_V, pa0, pa1, pa2, pa3);
    }
    asm volatile("s_waitcnt lgkmcnt(0)" ::: "memory"); __builtin_amdgcn_s_barrier(); asm volatile("" ::: "memory");
#undef SEG_X
#undef SEG_Y
#undef ISSUE
    if (hi == 0) li_l[r32] = l_reg; asm volatile("s_waitcnt lgkmcnt(0)" ::: "memory");
    float rli[16];
    const float sgn = st ? lam : 1.f;
#pragma unroll
    for (int r = 0; r < 16; ++r) rli[r] = __builtin_amdgcn_rcpf(li_l[crow(r, hi)]) * sgn;
    float* Es = (float*)(lds + OFF_E);
    if (st == 1) {
#pragma unroll
        for (int r = 0; r < 16; ++r) { const int orow = w4 * 32 + crow(r, hi);
#pragma unroll
            for (int d0 = 0; d0 < 4; ++d0) Es[orow * E_LD + d0 * 32 + r32] = o[d0][r] * rli[r]; }
    }
    __syncthreads();
    if (st == 0) {
#pragma unroll
        for (int r = 0; r < 16; ++r) { const int orow = w4 * 32 + crow(r, hi);
#pragma unroll
            for (int d0 = 0; d0 < 4; ++d0) { float* e = &Es[orow * E_LD + d0 * 32 + r32]; *e = o[d0][r] * rli[r] - *e; } }
    }
    __syncthreads();
    { const int row = tid >> 2, q = tid & 3; const float* e = &Es[row * E_LD + q * 32]; float v[32]; float ss = 0.f;
#pragma unroll
      for (int j = 0; j < 8; ++j) { const f32x4 t4 = *(const f32x4*)(e + 4 * j); v[4 * j] = t4[0]; v[4 * j + 1] = t4[1]; v[4 * j + 2] = t4[2]; v[4 * j + 3] = t4[3]; }
#pragma unroll
      for (int j = 0; j < 32; ++j) ss += v[j] * v[j];
      ss += __shfl_xor(ss, 1); ss += __shfl_xor(ss, 2);
      const float rs = __builtin_amdgcn_rsqf(ss * (1.f / 128.f) + EPS) * 0.8f;
      bf16_t* op = Ob + (size_t)row * 1024 + q * 32; const float* g = dng + q * 32;
#pragma unroll
      for (int j = 0; j < 4; ++j) { u32x4 w; w.x = pk2(v[8 * j] * rs * g[8 * j], v[8 * j + 1] * rs * g[8 * j + 1]); w.y = pk2(v[8 * j + 2] * rs * g[8 * j + 2], v[8 * j + 3] * rs * g[8 * j + 3]);
          w.z = pk2(v[8 * j + 4] * rs * g[8 * j + 4], v[8 * j + 5] * rs * g[8 * j + 5]); w.w = pk2(v[8 * j + 6] * rs * g[8 * j + 6], v[8 * j + 7] * rs * g[8 * j + 7]);
          *(u32x4*)(op + 8 * j) = w; }
    }
    __syncthreads();
#undef DMA_K
#undef DMA_V
#undef TILE_SYNC
#undef RESC
}
}

#define LDS_BAR() do { asm volatile("s_waitcnt lgkmcnt(0)" ::: "memory"); __builtin_amdgcn_s_barrier(); asm volatile("" ::: "memory"); } while (0)
namespace ret {
using att::crow;
DEVI size_t qf_index(int b, int h, int c, int w, int ks, int fq, int fr) { return (((((((size_t)(b * 4 + h) * 66 + c) * 8 + w) * 8 + ks) * 4 + fq) * 16 + fr) * 8); }
DEVI size_t ktf_index(int b, int h, int c, int w, int ks, int hh, int r32) { return (((((((size_t)(b * 4 + h) * 66 + c) * 8 + w) * 8 + ks) * 2 + hh) * 32 + r32) * 8); }
constexpr int VS_LD = 136;
constexpr int ST_LD = 264;
constexpr int TS_LD = 40;
constexpr int OFF_VS = 0, OFF_ST = 2 * 32 * VS_LD * 2, OFF_TS = OFF_ST + 2 * 32 * ST_LD * 2;
DEVI void scan_unit(int u, const bf16_t* __restrict__ QF, const bf16_t* __restrict__ KTF, const bf16_t* __restrict__ VT, bf16_t* __restrict__ OF, bf16_t* __restrict__ OB, const float* __restrict__ scal, char* lds) {
    const int b = u >> 7, h = (u >> 5) & 3, dir = (u >> 4) & 1, vs = u & 15;
    const int tid = threadIdx.x, w = __builtin_amdgcn_readfirstlane(tid >> 6), lane = tid & 63, r32 = lane & 31, hh = lane >> 5, fr = lane & 15, fq = lane >> 4;
    const float lgn = scal[dir * 4 + h];
    const float gch = __expf(lgn * 128.f);
    bf16_t* Vs = (bf16_t*)(lds + OFF_VS); bf16_t* St = (bf16_t*)(lds + OFF_ST); bf16_t* Ts = (bf16_t*)(lds + OFF_TS) + w * (16 * TS_LD);
    for (int i = tid; i < 32 * ST_LD / 2; i += 512) ((unsigned*)St)[i] = 0u;
    f32x16 S = {};
    const bf16_t* QFb = QF + qf_index(b, h, 0, w, 0, 0, 0) + lane * 8;
    const bf16_t* KTFb = KTF + ktf_index(b, h, 0, w, 0, 0, 0) + lane * 8;
    const bf16_t* VTb = VT + ((size_t)(b * 4 + h) * 512 + vs * 32) * SEQ;
    bf16_t* Odir = dir ? OB : OF;
    bf16_t* sink = (bf16_t*)((char*)OF + (WS_DUMMY - WS_OF));
    const int sv = tid >> 4, sj = (tid & 15) * 8;
    float wj[8];
#pragma unroll
    for (int e = 0; e < 8; ++e) { const int j = sj + e; wj[e] = __expf(lgn * (float)(dir ? j : 127 - j)); }
    const int itok = 16 * w + fr;
    const float qd = __expf(lgn * (float)(dir ? 128 - itok : itok + 1));
    bf16x8 kfA[8], kfB[8], qfA[8], qfB[8]; bf16x8 vA, vB;
#define CHUNK_OF(k) (dir ? ((k) == 0 ? 1 : ((k) == 1 ? 0 : 67 - (k))) : (k))
#define CLAMPK(kk) ((kk) < 66 ? (kk) : 65)
#define LOADK(KF_, kk) do { const size_t co_ = (size_t)CHUNK_OF(CLAMPK(kk)) * 32768; \
        _Pragma("unroll") for (int ks = 0; ks < 8; ++ks) KF_[ks] = *(const bf16x8*)(KTFb + co_ + ((ks + vs) & 7) * 512); } while (0)
#define LOADV(VR_, kk) do { VR_ = *(const bf16x8*)(VTb + (size_t)sv * SEQ + CHUNK_OF(CLAMPK(kk)) * 128 + sj); } while (0)
#define LOADQ(QF_, kk) do { const size_t co_ = (size_t)CHUNK_OF(CLAMPK(kk)) * 32768;     \
        _Pragma("unroll") for (int ks = 0; ks < 8; ++ks) QF_[ks] = *(const bf16x8*)(QFb + co_ + ((ks + vs) & 7) * 512); } while (0)
#define STEP(k, KF_, V_, QF_) do { \
        const int cn = CHUNK_OF(k); \
        bf16_t* Vsk = Vs + ((k) & 1) * (32 * VS_LD); const bf16_t* Stk = St + ((k) & 1) * (32 * ST_LD); bf16_t* Stn = St + (((k) + 1) & 1) * (32 * ST_LD); \
        { u32x4 vv = *reinterpret_cast<u32x4*>(&V_); u32x4 ww; \
          ww.x = pk2(lo_f(vv.x) * wj[0], hi_f(vv.x) * wj[1]); ww.y = pk2(lo_f(vv.y) * wj[2], hi_f(vv.y) * wj[3]); \
          ww.z = pk2(lo_f(vv.z) * wj[4], hi_f(vv.z) * wj[5]); ww.w = pk2(lo_f(vv.w) * wj[6], hi_f(vv.w) * wj[7]); \
          *(u32x4*)(Vsk + sv * VS_LD + sj) = ww; } \
        LOADV(V_, (k) + 2); \
        __syncthreads();     \
        _Pragma("unroll") for (int r = 0; r < 16; ++r) S[r] *= gch; \
        _Pragma("unroll") for (int ks = 0; ks < 8; ++ks) { \
            const bf16x8 vf = *(const bf16x8*)(Vsk + r32 * VS_LD + ((ks + vs) & 7) * 16 + hh * 8); \
            S = __builtin_amdgcn_mfma_f32_32x32x16_bf16(KF_[ks], vf, S, 0, 0, 0); } \
        LOADK(KF_, (k) + 2); \
        _Pragma("unroll") for (int g = 0; g < 4; ++g) { u32x2 ww; ww.x = pk2(S[4 * g], S[4 * g + 1]); ww.y = pk2(S[4 * g + 2], S[4 * g + 3]); \
            *(u32x2*)(Stn + r32 * ST_LD + 32 * w + 8 * g + 4 * hh) = ww; } \
        {                    \
            f32x4 a0 = {0.f, 0.f, 0.f, 0.f}, a1 = {0.f, 0.f, 0.f, 0.f}; \
            _Pragma("unroll") for (int ks = 0; ks < 8; ++ks) { \
                const bf16x8 s0f = *(const bf16x8*)(Stk + (fr) * ST_LD + ((ks + vs) & 7) * 32 + fq * 8); \
                const bf16x8 s1f = *(const bf16x8*)(Stk + (16 + fr) * ST_LD + ((ks + vs) & 7) * 32 + fq * 8); \
                a0 = __builtin_amdgcn_mfma_f32_16x16x32_bf16(s0f, QF_[ks], a0, 0, 0, 0); \
                a1 = __builtin_amdgcn_mfma_f32_16x16x32_bf16(s1f, QF_[ks], a1, 0, 0, 0); } \
            u32x2 w0, w1; w0.x = pk2(a0[0] * qd, a0[1] * qd); w0.y = pk2(a0[2] * qd, a0[3] * qd); w1.x = pk2(a1[0] * qd, a1[1] * qd); w1.y = pk2(a1[2] * qd, a1[3] * qd); \
            *(u32x2*)(Ts + fr * TS_LD + 4 * fq) = w0; *(u32x2*)(Ts + fr * TS_LD + 16 + 4 * fq) = w1;        \
            asm volatile("s_waitcnt lgkmcnt(0)" ::: "memory"); \
            const int tk = lane >> 2, l = (cn - 2) * 128 + 16 * w + tk; \
            const u32x4 ov = *(const u32x4*)(Ts + tk * TS_LD + (lane & 3) * 8); \
            bf16_t* op = (cn >= 2 ? Odir + (size_t)(b * LSEQ + l) * 2048 : sink + (size_t)(16 * w + tk) * 2048) + h * 512 + vs * 32 + (lane & 3) * 8; \
            *(u32x4*)op = ov; } \
        LOADQ(QF_, (k) + 2); \
    } while (0)
    LOADK(kfA, 0); LOADV(vA, 0); LOADK(kfB, 1); LOADV(vB, 1); LOADQ(qfA, 0); LOADQ(qfB, 1);
#pragma unroll 1
    for (int k2 = 0; k2 < 66; k2 += 2) {
        STEP(k2 + 0, kfA, vA, qfA);
        STEP(k2 + 1, kfB, vB, qfB);
    }
    __syncthreads();
#undef STEP
#undef LOADK
#undef LOADV
#undef LOADQ
#undef CHUNK_OF
}
constexpr int QL_LD = 264, PL_LD = 136, VL_LD = 136;
constexpr int OFF_QL = 0, OFF_KL = 128 * QL_LD * 2, OFF_PL = 0, OFF_VL = OFF_KL;
DEVI void intra_unit(int u, const bf16_t* __restrict__ P, const bf16_t* __restrict__ VT, bf16_t* __restrict__ OI, const float* __restrict__ scal, char* lds) {
    const int b = u >> 8, h = (u >> 6) & 3, lc = u & 63, s0 = (lc + 2) * 128;
    const int tid = threadIdx.x, w = __builtin_amdgcn_readfirstlane(tid >> 6), lane = tid & 63, r32 = lane & 31, hh = lane >> 5;
    const int tr = w >> 1, tc0 = 2 * (w & 1);
    bf16_t* Ql = (bf16_t*)(lds + OFF_QL); bf16_t* Kl = (bf16_t*)(lds + OFF_KL); bf16_t* Pl = (bf16_t*)(lds + OFF_PL); bf16_t* Vl = (bf16_t*)(lds + OFF_VL);
    {
        const int srow = tid >> 5, pc = (tid & 31) * 8;
        const bf16_t* qg = P + ((size_t)b * SEQ + s0 + srow) * NP + C_RQ + h * 256 + pc; const bf16_t* kg = qg + (C_RK - C_RQ);
        u32x4 qv[8], kv[8];
#pragma unroll
        for (int it = 0; it < 8; ++it) { qv[it] = *(const u32x4*)(qg + (size_t)it * 16 * NP); kv[it] = *(const u32x4*)(kg + (size_t)it * 16 * NP); }
#pragma unroll
        for (int it = 0; it < 8; ++it) { *(u32x4*)(Ql + (it * 16 + srow) * QL_LD + pc) = qv[it]; *(u32x4*)(Kl + (it * 16 + srow) * QL_LD + pc) = kv[it]; }
    }
    __syncthreads();
    f32x16 c0 = {}, c1 = {};
#pragma unroll 4
    for (int ks = 0; ks < 16; ++ks) {
        const bf16x8 a = *(const bf16x8*)(Ql + (32 * tr + r32) * QL_LD + ks * 16 + hh * 8);
        const bf16x8 b0 = *(const bf16x8*)(Kl + (32 * tc0 + r32) * QL_LD + ks * 16 + hh * 8), b1 = *(const bf16x8*)(Kl + (32 * tc0 + 32 + r32) * QL_LD + ks * 16 + hh * 8);
        c0 = __builtin_amdgcn_mfma_f32_32x32x16_bf16(a, b0, c0, 0, 0, 0);
        c1 = __builtin_amdgcn_mfma_f32_32x32x16_bf16(a, b1, c1, 0, 0, 0);
    }
    const int vrow = tid >> 4, vpc = (tid & 15) * 8;
    const bf16_t* vg = VT + ((size_t)(b * 4 + h) * 512 + vrow) * SEQ + s0 + vpc;
    u32x4 vv[4];
#pragma unroll
    for (int it = 0; it < 4; ++it) vv[it] = *(const u32x4*)(vg + (size_t)(it * 32) * SEQ);
    LDS_BAR();
    const float lf2 = scal[h] * LOG2E, lb2 = scal[4 + h] * LOG2E;
#pragma unroll
    for (int t = 0; t < 2; ++t) {
        const int j = 32 * (tc0 + t) + r32;
#pragma unroll
        for (int r = 0; r < 16; ++r) {
            const int i = 32 * tr + crow(r, hh); const float dlt = (float)(i - j);
            float dm = 0.f;
            if (j <= i) dm += __builtin_amdgcn_exp2f(dlt * lf2);
            if (j >= i) dm += __builtin_amdgcn_exp2f(-dlt * lb2);
            const float v = (t ? c1[r] : c0[r]) * dm;
            Pl[i * PL_LD + j] = (bf16_t)f2bf(v);
        }
    }
    bf16x8 pf[8];
    bf16_t* Ob = OI + ((size_t)b * LSEQ + lc * 128 + 32 * tr + r32) * 2048 + h * 512;
#pragma unroll 1
    for (int vb = 0; vb < 4; ++vb) {
        bf16_t* Vb = Vl + (vb & 1) * (128 * VL_LD);
#pragma unroll
        for (int it = 0; it < 4; ++it) *(u32x4*)(Vb + (it * 32 + vrow) * VL_LD + vpc) = vv[it];
        if (vb < 3) {
#pragma unroll
            for (int it = 0; it < 4; ++it) vv[it] = *(const u32x4*)(vg + (size_t)((vb + 1) * 128 + it * 32) * SEQ);
        }
        LDS_BAR();
        if (vb == 0) {
#pragma unroll
            for (int ks = 0; ks < 8; ++ks) pf[ks] = *(const bf16x8*)(Pl + (32 * tr + r32) * PL_LD + ks * 16 + hh * 8);
        }
#pragma unroll
        for (int t = 0; t < 2; ++t) {
            const int vt = (w & 1) * 2 + t;
            f32x16 oacc = {};
#pragma unroll
            for (int ks = 0; ks < 8; ++ks) {
                const bf16x8 a = *(const bf16x8*)(Vb + (32 * vt + r32) * VL_LD + ks * 16 + hh * 8);
                oacc = __builtin_amdgcn_mfma_f32_32x32x16_bf16(a, pf[ks], oacc, 0, 0, 0);
            }
            const int v0 = vb * 128 + vt * 32;
#pragma unroll
            for (int g = 0; g < 4; ++g) { u32x2 ww; ww.x = pk2(oacc[4 * g], oacc[4 * g + 1]); ww.y = pk2(oacc[4 * g + 2], oacc[4 * g + 3]);
                *(u32x2*)(Ob + v0 + 8 * g + 4 * hh) = ww; }
        }
    }
    __syncthreads();
}
}

constexpr int NPH = 12;
constexpr int LDS_BYTES = 160 * 1024;
constexpr int LDS_TAB = 131072;

struct Ctx {
    int tid, lane, wave, gw, NGW, G, bid;
    char* lds;
};

struct TrTile { const float* W; bf16_t* WT; int K, N, k0, n0, perm; };
DEVI int tr_orow(const TrTile& t, int n) { return t.perm ? 256 * ((n & 1023) >> 7) + 128 * (n >> 10) + (n & 127) : n; }
DEVI void tr_load(const TrTile& t, f32x4 (&v)[16], int tid) { const int wv = tid >> 6, l = tid & 63;
#pragma unroll
    for (int i = 0; i < 16; ++i) v[i] = *(const f32x4*)(t.W + (size_t)(t.k0 + 16 * wv + i) * t.N + t.n0 + 4 * l); }
DEVI void tr_to_lds(const f32x4 (&v)[16], unsigned* T, int tid) { const int wv = tid >> 6, l = tid & 63;
#pragma unroll
    for (int e = 0; e < 4; ++e) { const int n = 4 * l + e;
#pragma unroll
        for (int h = 0; h < 2; ++h) { u32x4 o; o.x = pk2(v[8 * h][e], v[8 * h + 1][e]); o.y = pk2(v[8 * h + 2][e], v[8 * h + 3][e]); o.z = pk2(v[8 * h + 4][e], v[8 * h + 5][e]); o.w = pk2(v[8 * h + 6][e], v[8 * h + 7][e]);
            *(u32x4*)(T + n * 64 + 4 * ((2 * wv + h) ^ (l & 7))) = o; } } }
DEVI void tr_store(const TrTile& t, const unsigned* T, int tid) { const int piece = tid & 15;
#pragma unroll
    for (int it = 0; it < 8; ++it) { const int n = (tid >> 4) + 32 * it;
        const u32x4 o = *(const u32x4*)(T + n * 64 + 4 * (piece ^ ((n >> 2) & 7)));
        *(u32x4*)(t.WT + (size_t)tr_orow(t, t.n0 + n) * t.K + t.k0 + piece * 8) = o; } }

DEVI void phase_prep(const Params& p, const Ctx& c) {
    unsigned char* ws = p.ws;
    constexpr int T_IN = 8 * (NP / 256), T_BR = 16 * 4, T_BD = 8 * 4, T_OUT = T_BD, T_W1 = 8 * 8, T_W2 = 8 * 4;
    int NTIL = T_IN + T_BR + T_BD + T_OUT;
    asm volatile("" : "+s"(NTIL));
    auto tile_of = [&](int it) { TrTile t; int r = it; t.perm = 0;
        if (r < T_IN) { const int nb = NP / 256; t.W = p.w_in; t.WT = (bf16_t*)(ws + WS_WIN); t.K = 1024; t.N = NP; t.k0 = (r / nb) * 128; t.n0 = (r % nb) * 256; return t; } r -= T_IN;
        if (r < T_BR) { t.W = p.w_br_ret; t.WT = (bf16_t*)(ws + WS_WBR); t.K = 2048; t.N = 1024; t.k0 = (r / 4) * 128; t.n0 = (r % 4) * 256; return t; } r -= T_BR;
        if (r < T_BD) { t.W = p.w_br_diff; t.WT = (bf16_t*)(ws + WS_WBD); t.K = 1024; t.N = 1024; t.k0 = (r / 4) * 128; t.n0 = (r % 4) * 256; return t; } r -= T_BD;
        if (r < T_OUT) { t.W = p.w_out; t.WT = (bf16_t*)(ws + WS_WOUT); t.K = 1024; t.N = 1024; t.k0 = (r / 4) * 128; t.n0 = (r % 4) * 256; return t; } r -= T_OUT;
        const int e = r / (T_W1 + T_W2); r -= e * (T_W1 + T_W2);
        if (r < T_W1) { t.W = p.w1 + (size_t)e * 1024 * 2048; t.WT = (bf16_t*)(ws + WS_W1) + (size_t)e * 2048 * 1024; t.K = 1024; t.N = 2048; t.k0 = (r / 8) * 128; t.n0 = (r % 8) * 256; t.perm = 1; return t; } r -= T_W1;
        t.W = p.w2 + (size_t)e * 1024 * 1024; t.WT = (bf16_t*)(ws + WS_W2) + (size_t)e * 1024 * 1024; t.K = 1024; t.N = 1024; t.k0 = (r / 4) * 128; t.n0 = (r % 4) * 256; return t; };
    {
        unsigned* Tl = (unsigned*)c.lds; f32x4 v[16];
        int it = c.bid; TrTile cur = tile_of(it < NTIL ? it : 0);
        if (it < NTIL) tr_load(cur, v, c.tid);
        while (it < NTIL) {
            tr_to_lds(v, Tl, c.tid);
            const int nx = it + c.G; TrTile nxt = tile_of(nx < NTIL ? nx : 0);
            if (nx < NTIL) tr_load(nxt, v, c.tid);
            LDS_BAR();
            tr_store(cur, Tl, c.tid);
            LDS_BAR();
            cur = nxt; it = nx;
        }
    }
    float* mod = (float*)(ws + WS_MOD);
    __syncthreads();
    float* sil = (float*)c.lds + 1024;
    if (c.G - 1 - c.bid < 192) { for (int i = c.tid; i < 3072; i += 512) sil[i] = siluf_(i < 2048 ? p.c[i] : p.c_ctx[i - 2048]); }
    __syncthreads();
    for (int cgp = c.G - 1 - c.bid; cgp < 192; cgp += c.G) {
        const int col = cgp * 32 + (c.lane & 31), kh = c.lane >> 5; float a0 = 0.f, a1 = 0.f, a2 = 0.f;
        for (int k0 = c.wave * 128; k0 < c.wave * 128 + 128; k0 += 64) {
            float wv[32];
#pragma unroll
            for (int i = 0; i < 32; ++i) wv[i] = p.w_mod[(size_t)(k0 + 2 * i + kh) * 6144 + col];
#pragma unroll
            for (int i = 0; i < 32; ++i) { const float* sp = sil + k0 + 2 * i + kh; a0 += sp[0] * wv[i]; a1 += sp[1024] * wv[i]; a2 += sp[2048] * wv[i]; }
        }
        a0 += __shfl_xor(a0, 32); a1 += __shfl_xor(a1, 32); a2 += __shfl_xor(a2, 32);
        float* red = (float*)c.lds;
        if (kh == 0) { red[(c.wave * 3 + 0) * 32 + c.lane] = a0; red[(c.wave * 3 + 1) * 32 + c.lane] = a1; red[(c.wave * 3 + 2) * 32 + c.lane] = a2; }
        __syncthreads();
        if (c.tid < 96) { const int v = c.tid >> 5, l = c.tid & 31; float s = 0.f;
#pragma unroll
            for (int w = 0; w < 8; ++w) s += red[(w * 3 + v) * 32 + l];
            mod[v * 6144 + cgp * 32 + l] = s + p.b_mod[cgp * 32 + l]; }
        __syncthreads();
    }
    const int gt = c.bid * 512 + c.tid;
    if (gt < 128 * 64) { const int pos = gt >> 6, i = gt & 63; const float inv = powf(10000.f, -(float)i / 64.f); float s, co; sincosf((float)pos * inv, &s, &co);
        ((float2*)(ws + WS_TABR))[gt] = make_float2(co, s); }
    else if (gt < 128 * 64 + 128 * 16) { const int q = gt - 128 * 64, pos = q >> 4, i = q & 15; const float inv = powf(10000.f, -(float)i / 16.f); float s, co; sincosf((float)pos * inv, &s, &co);
        ((float2*)(ws + WS_TABD))[q] = make_float2(co, s); }
    else if (gt < 128 * 80 + 8) { const int q = gt - 128 * 80; const float xl = p.ret_decay[q]; ((float*)(ws + WS_SCAL))[q] = -log1pf(expf(-xl)); }
    else if (gt >= 128 * 80 + 64 && gt < 128 * 80 + 128) {
        const int i = gt - (128 * 80 + 64); const float s01 = wave_sum(p.dlam[i] * p.dlam[64 + i]), s23 = wave_sum(p.dlam[128 + i] * p.dlam[192 + i]);
        if (i == 0) ((float*)(ws + WS_SCAL))[8] = expf(s01) - expf(s23) + 0.2f; }
}

constexpr int Q1_TILES = NE * 64, Q2_TILES = NE * 32;
DEVI TrTile conv_tile(const Params& p, int qsel, int t) {
    TrTile tt;
    if (qsel == 0) { const int e = t >> 6, r = t & 63; tt.W = p.w1 + (size_t)e * 1024 * 2048; tt.WT = (bf16_t*)(p.ws + WS_W1) + (size_t)e * 2048 * 1024; tt.K = 1024; tt.N = 2048; tt.k0 = (r >> 3) * 128; tt.n0 = (r & 7) * 256; tt.perm = 1; }
    else { const int e = t >> 5, r = t & 31; tt.W = p.w2 + (size_t)e * 1024 * 1024; tt.WT = (bf16_t*)(p.ws + WS_W2) + (size_t)e * 1024 * 1024; tt.K = 1024; tt.N = 1024; tt.k0 = (r >> 2) * 128; tt.n0 = (r & 3) * 256; tt.perm = 0; }
    return tt;
}
DEVI void conv_run(const Params& p, const Ctx& c, int qsel, bool peek, bool stoppable) {
    unsigned* Tl = (unsigned*)c.lds; int* qs = (int*)(c.lds + 65536);
    int* q = (int*)(p.ws + WS_Q) + 64 * qsel; const int lim = qsel ? Q2_TILES : Q1_TILES;
    __syncthreads();
    const int* flagp = (const int*)(p.ws + WS_Q) + 128; int flg = 0; bool live = true;
    int pre = lim;
    if (c.tid == 0) {
        int t0 = lim, t1 = lim;
        if ((!peek || __hip_atomic_load(q, __ATOMIC_RELAXED, __HIP_MEMORY_SCOPE_AGENT) < lim) && !(stoppable && __hip_atomic_load(flagp, __ATOMIC_RELAXED, __HIP_MEMORY_SCOPE_AGENT) != 0)) { t0 = (int)atomicInc((unsigned*)q, 0xFFFFFFFFu); t1 = (int)atomicInc((unsigned*)q, 0xFFFFFFFFu); pre = (int)atomicInc((unsigned*)q, 0xFFFFFFFFu); }
        qs[0] = t0 < lim ? t0 : -1; qs[1] = t1 < lim ? t1 : -1; }
    __syncthreads();
    int ia = __builtin_amdgcn_readfirstlane(qs[0]), ib = __builtin_amdgcn_readfirstlane(qs[1]);
    if (ia < 0) return;
    f32x4 va[16], vb[16];
    TrTile dummy; dummy.W = p.w1; dummy.WT = nullptr; dummy.K = 0; dummy.N = 0; dummy.k0 = 0; dummy.n0 = 0; dummy.perm = 0;
    TrTile ta = conv_tile(p, qsel, ia), tb = ib >= 0 ? conv_tile(p, qsel, ib) : dummy;
    tr_load(ta, va, c.tid);
    tr_load(tb, vb, c.tid);
    LDS_BAR();
#define CONV_STEP(IT, TT_, V) { tr_to_lds(V, Tl, c.tid); \
        if (c.tid == 0) { const bool ok = live && pre < lim; qs[0] = ok ? pre : -1; live = ok && flg == 0; if (live) pre = (int)atomicInc((unsigned*)q, 0xFFFFFFFFu); \
                          if (stoppable) flg = __hip_atomic_load(flagp, __ATOMIC_RELAXED, __HIP_MEMORY_SCOPE_AGENT); } \
        LDS_BAR(); \
        const int nx = __builtin_amdgcn_readfirstlane(qs[0]); const TrTile done = TT_; TT_ = nx >= 0 ? conv_tile(p, qsel, nx) : dummy; \
        tr_load(TT_, V, c.tid); \
        tr_store(done, Tl, c.tid); IT = nx; \
        LDS_BAR(); }
    CONV_STEP(ia, ta, va)
    if (ib >= 0) {
        CONV_STEP(ib, tb, vb)
        while (ia >= 0) {
            CONV_STEP(ia, ta, va)
            if (ib < 0) break;
            CONV_STEP(ib, tb, vb)
        }
    }
#undef CONV_STEP
}

DEVI void phase_hl(const Params& p, const Ctx& c) {
    const float* mod = (const float*)(p.ws + WS_MOD); bf16_t* HL = (bf16_t*)(p.ws + WS_HL);
    for (int r = c.gw; r < TT; r += c.NGW) {
        const int b = r / SEQ, s = r % SEQ; const bool isctx = s < CTXL;
        const float* src = isctx ? p.ctx + ((size_t)b * CTXL + s) * DM : p.x + ((size_t)b * LSEQ + (s - CTXL)) * DM;
        const float* mv = mod + (isctx ? 2 : b) * 6144;
        const f32x4* xr = (const f32x4*)src + c.lane; f32x4 v[4]; float ss = 0.f;
#pragma unroll
        for (int j = 0; j < 4; ++j) { v[j] = xr[64 * j]; ss += (v[j][0] * v[j][0] + v[j][1] * v[j][1]) + (v[j][2] * v[j][2] + v[j][3] * v[j][3]); }
        const float rstd = __builtin_amdgcn_rsqf(wave_sum(ss) * (1.f / DM) + EPS);
        u32x2* o8 = (u32x2*)(HL + (size_t)r * DM) + c.lane;
#pragma unroll
        for (int j = 0; j < 4; ++j) { const int k = 4 * c.lane + 256 * j;
            const f32x4 g = *(const f32x4*)(p.norm1_g + k), sh = *(const f32x4*)(mv + k), sc = *(const f32x4*)(mv + 1024 + k);
            const f32x4 y = (v[j] * rstd * g) * (sc + 1.f) + sh; u32x2 w; w.x = pk2(y[0], y[1]); w.y = pk2(y[2], y[3]); o8[64 * j] = w; }
    }
}

DEVI void phase_post(const Params& p, const Ctx& c) {
    bf16_t* P = (bf16_t*)(p.ws + WS_P); const float2* tabR = (const float2*)(p.ws + WS_TABR); const float2* tabD = (const float2*)(p.ws + WS_TABD);
    for (int r = c.gw; r < TT; r += c.NGW) {
        const int s = r % SEQ; const bool lat = s >= CTXL; const int tpos = lat ? s - CTXL : 0; const int prow = tpos >> 6, pcol = tpos & 63;
        bf16_t* pr = P + (size_t)r * NP;
        if (lat) {
            const int blk = c.lane >> 3, i8 = (c.lane & 7) * 8; const int pos = (blk & 1) ? pcol : prow;
            bf16_t* q1 = pr + C_RQ + blk * 128 + i8; const u32x4 a = *(const u32x4*)q1, bq = *(const u32x4*)(q1 + 64);
            const unsigned aw[4] = {a.x, a.y, a.z, a.w}, bw[4] = {bq.x, bq.y, bq.z, bq.w}; unsigned o1[4], o2[4];
#pragma unroll
            for (int e = 0; e < 4; ++e) { const float2 t0 = tabR[pos * 64 + i8 + 2 * e], t1 = tabR[pos * 64 + i8 + 2 * e + 1];
                const float x1a = lo_f(aw[e]), x1b = hi_f(aw[e]), x2a = lo_f(bw[e]), x2b = hi_f(bw[e]);
                o1[e] = pk2((x1a * t0.x - x2a * t0.y) * 0.0625f, (x1b * t1.x - x2b * t1.y) * 0.0625f);
                o2[e] = pk2((x1a * t0.y + x2a * t0.x) * 0.0625f, (x1b * t1.y + x2b * t1.x) * 0.0625f); }
            *(u32x4*)q1 = (u32x4){o1[0], o1[1], o1[2], o1[3]}; *(u32x4*)(q1 + 64) = (u32x4){o2[0], o2[1], o2[2], o2[3]};
            {
                const int bb = r / SEQ, hq = blk >> 1, d0 = (blk & 1) * 128 + i8, cc = s >> 7, ii = s & 127;
                bf16_t* QFp = (bf16_t*)(p.ws + WS_DV);
                *(u32x4*)(QFp + ret::qf_index(bb, hq, cc, ii >> 4, d0 >> 5, (d0 >> 3) & 3, ii & 15)) = (u32x4){o1[0], o1[1], o1[2], o1[3]};
                *(u32x4*)(QFp + ret::qf_index(bb, hq, cc, ii >> 4, (d0 >> 5) + 2, (d0 >> 3) & 3, ii & 15)) = (u32x4){o2[0], o2[1], o2[2], o2[3]};
            }
        }
#pragma unroll
        for (int which = 0; which < 2; ++which) {
            if (which == 0 && !lat) continue;
            const float* gq = which ? p.dk_g : p.dq_g;
            const int q4 = c.lane & 3; bf16_t* dp = pr + (which ? C_DK : C_DQ) + (c.lane >> 2) * 64 + q4 * 16;
            const u32x4 a = *(const u32x4*)dp, bq = *(const u32x4*)(dp + 8); const unsigned wv[8] = {a.x, a.y, a.z, a.w, bq.x, bq.y, bq.z, bq.w};
            float v[16]; float ss = 0.f;
#pragma unroll
            for (int e = 0; e < 8; ++e) { v[2 * e] = lo_f(wv[e]); v[2 * e + 1] = hi_f(wv[e]); ss += v[2 * e] * v[2 * e] + v[2 * e + 1] * v[2 * e + 1]; }
            ss += __shfl_xor(ss, 1); ss += __shfl_xor(ss, 2);
            const float rs = __builtin_amdgcn_rsqf(ss * (1.f / 64.f) + EPS);
            const int pos = (q4 & 2) ? pcol : prow; unsigned ow[8]; float y[16];
#pragma unroll
            for (int e = 0; e < 16; ++e) y[e] = v[e] * rs * gq[q4 * 16 + e];
#pragma unroll
            for (int e = 0; e < 16; ++e) { const float other = __shfl_xor(y[e], 1); const float2 t = tabD[pos * 16 + e];
                y[e] = (q4 & 1) ? (other * t.y + y[e] * t.x) : (y[e] * t.x - other * t.y); }
#pragma unroll
            for (int e = 0; e < 8; ++e) ow[e] = pk2(y[2 * e], y[2 * e + 1]);
            *(u32x4*)dp = (u32x4){ow[0], ow[1], ow[2], ow[3]}; *(u32x4*)(dp + 8) = (u32x4){ow[4], ow[5], ow[6], ow[7]};
        }
    }
    bf16_t* KT = (bf16_t*)(p.ws + WS_KT); bf16_t* VT = (bf16_t*)(p.ws + WS_VT);
    bf16_t* Tl = (bf16_t*)c.lds;
    constexpr int TLD = 72;
    constexpr int NU = NB * 132 * 24;
    const int tok = c.tid >> 3, c8 = (c.tid & 7) * 8, wsw = (c.tid & 7) << 3;
    auto unit_src = [&](int u) { const int cb = u % 24, tb = (u / 24) % 132, b = u / (24 * 132); const int colbase = cb < 8 ? C_RK + cb * 128 : C_RV + (cb - 8) * 128;
        return P + ((size_t)b * SEQ + tb * 64 + tok) * NP + colbase + c8; };
    u32x4 a, bq;
    { bf16_t* s0 = unit_src(c.bid < NU ? c.bid : NU - 1); a = *(const u32x4*)s0; bq = *(const u32x4*)(s0 + 64); }
    for (int u = c.bid; u < NU; u += c.G) {
        const int cb = u % 24, tb = (u / 24) % 132, b = u / (24 * 132);
        const int s = tb * 64 + tok; const bool isk = cb < 8;
        bf16_t* src = unit_src(u);
        u32x4 an, bn; { const int un = u + c.G; bf16_t* sn = unit_src(un < NU ? un : NU - 1); an = *(const u32x4*)sn; bn = *(const u32x4*)(sn + 64); }
        if (isk) {
            const bool lat = s >= CTXL; const int tpos = lat ? s - CTXL : 0; const int pos = (cb & 1) ? (tpos & 63) : (tpos >> 6);
            const unsigned aw[4] = {a.x, a.y, a.z, a.w}, bw[4] = {bq.x, bq.y, bq.z, bq.w}; unsigned o1[4], o2[4];
#pragma unroll
            for (int e = 0; e < 4; ++e) { const float2 t0 = tabR[pos * 64 + c8 + 2 * e], t1 = tabR[pos * 64 + c8 + 2 * e + 1];
                const float x1a = lo_f(aw[e]), x1b = hi_f(aw[e]), x2a = lo_f(bw[e]), x2b = hi_f(bw[e]);
                o1[e] = pk2(x1a * t0.x - x2a * t0.y, x1b * t1.x - x2b * t1.y);
                o2[e] = pk2(x1a * t0.y + x2a * t0.x, x1b * t1.y + x2b * t1.x); }
            a = (u32x4){o1[0], o1[1], o1[2], o1[3]}; bq = (u32x4){o2[0], o2[1], o2[2], o2[3]};
            *(u32x4*)src = a; *(u32x4*)(src + 64) = bq;
        }
        { const unsigned aw[4] = {a.x, a.y, a.z, a.w}, bw[4] = {bq.x, bq.y, bq.z, bq.w}; const int tk = tok ^ wsw;
#pragma unroll
          for (int e = 0; e < 4; ++e) { Tl[(c8 + 2 * e) * TLD + tk] = (bf16_t)(aw[e] & 0xffffu); Tl[(c8 + 2 * e + 1) * TLD + tk] = (bf16_t)(aw[e] >> 16);
              Tl[(64 + c8 + 2 * e) * TLD + tk] = (bf16_t)(bw[e] & 0xffffu); Tl[(64 + c8 + 2 * e + 1) * TLD + tk] = (bf16_t)(bw[e] >> 16); } }
        LDS_BAR();
        if (isk) {
            const int col = c.tid & 127, tp = c.tid >> 7, sw = ((col >> 3) & 7) << 3; const u32x4 r0 = *(const u32x4*)(Tl + col * TLD + ((16 * tp) ^ sw)), r1 = *(const u32x4*)(Tl + col * TLD + ((16 * tp + 8) ^ sw));
            const int hk = cb >> 1, d = (cb & 1) * 128 + col, jb = (tb & 1) * 64 + 16 * tp;
            bf16_t* dst = KT + ret::ktf_index(b, hk, tb >> 1, d >> 5, jb >> 4, 0, d & 31);
            *(u32x4*)dst = r0; *(u32x4*)(dst + 32 * 8) = r1;
        } else {
          const int col = c.tid >> 2, t4 = (c.tid & 3) * 16, sw = ((col >> 3) & 7) << 3; const u32x4 r0 = *(const u32x4*)(Tl + col * TLD + (t4 ^ sw)), r1 = *(const u32x4*)(Tl + col * TLD + ((t4 + 8) ^ sw));
          bf16_t* dst = VT + ((size_t)b * 2048 + (cb - 8) * 128 + col) * SEQ + tb * 64 + t4;
          *(u32x4*)dst = r0; *(u32x4*)(dst + 8) = r1; }
        LDS_BAR();
        a = an; bq = bn;
    }
    __syncthreads();
}

DEVI int scan_map(int u, int G) { if (G != 256) return u; const int x = u & 7, j = u >> 3; return ((x + 8 * (j >> 4)) << 4) | (j & 15); }
DEVI void phase_mix(const Params& p, const Ctx& c) {
    const bf16_t* P = (const bf16_t*)(p.ws + WS_P); const bf16_t* KT = (const bf16_t*)(p.ws + WS_KT); const bf16_t* VT = (const bf16_t*)(p.ws + WS_VT);
    const float* scal = (const float*)(p.ws + WS_SCAL);
#ifndef MK_MIX_PROBE
#define MK_MIX_PROBE 0
#endif
#ifndef MK_MIX_ONLY
#define MK_MIX_ONLY 0
#endif
    const float lam = scal[8];
    const bool attn_first = (c.G == 256) && (c.bid >= 128);
#define MIX_RET() do { for (int u = c.bid; u < 256; u += c.G) ret::scan_unit(scan_map(u & 255, c.G), (const bf16_t*)(p.ws + WS_DV), KT, VT, (bf16_t*)(p.ws + WS_OF), (bf16_t*)(p.ws + WS_OB), scal, c.lds); \
        for (int u = c.bid; u < 512; u += c.G) ret::intra_unit(u & 511, P, VT, (bf16_t*)(p.ws + WS_OI), scal, c.lds); } while (0)
    if (!attn_first) MIX_RET();
    for (int a_ = c.bid; a_ < 1024; a_ += c.G) { const int a = a_ & 1023;
        const int rr = a / c.G, wq = a % c.G; int bh, qb;
        if (c.G == 256) { const int xcd = wq & 7, j = wq >> 3; bh = xcd * 2 + (rr >> 1); qb = (rr & 1) * 32 + j; } else { bh = a >> 6; qb = a & 63; }
        const int b = bh >> 3, h = bh & 7;
        const bf16_t* Qb = P + ((size_t)b * SEQ + CTXL + qb * 128) * NP + C_DQ + h * 128;
        const bf16_t* Kh = P + ((size_t)b * SEQ) * NP + C_DK + h * 128;
        const bf16_t* Vh = P + ((size_t)b * SEQ) * NP + C_DV + h * 128;
        bf16_t* Ob = (bf16_t*)(p.ws + WS_OD) + ((size_t)b * LSEQ + qb * 128) * 1024 + h * 128;
        att::attn_unit(Qb, Kh, Vh, Ob, lam, p.dn_g, c.lds);
    }
    if (attn_first) { __syncthreads(); MIX_RET(); }
#undef MIX_RET
}

DEVI void phase_retgate(const Params& p, const Ctx& c) {
    bf16_t* OI = (bf16_t*)(p.ws + WS_OI); const bf16_t* OF = (const bf16_t*)(p.ws + WS_OF); const bf16_t* OB = (const bf16_t*)(p.ws + WS_OB); const bf16_t* P = (const bf16_t*)(p.ws + WS_P);
    for (int it = c.gw; it < T * 4; it += c.NGW) {
        const int t = it >> 2, h = it & 3; const size_t off = (size_t)t * 2048 + h * 512 + c.lane * 8;
        const u32x4 a = *(const u32x4*)(OI + off), f = *(const u32x4*)(OF + off), bb = *(const u32x4*)(OB + off);
        const u32x4 rg = *(const u32x4*)(P + (size_t)rowc_of(t) * NP + C_RG + h * 512 + c.lane * 8);
        const unsigned aw[4] = {a.x, a.y, a.z, a.w}, fw[4] = {f.x, f.y, f.z, f.w}, bw[4] = {bb.x, bb.y, bb.z, bb.w}, gw_[4] = {rg.x, rg.y, rg.z, rg.w};
        float v[8]; float ss = 0.f;
#pragma unroll
        for (int e = 0; e < 4; ++e) { v[2 * e] = lo_f(aw[e]) + lo_f(fw[e]) + lo_f(bw[e]); v[2 * e + 1] = hi_f(aw[e]) + hi_f(fw[e]) + hi_f(bw[e]); ss += v[2 * e] * v[2 * e] + v[2 * e + 1] * v[2 * e + 1]; }
        const float rs = __builtin_amdgcn_rsqf(wave_sum(ss) * (1.f / 512.f) + EPS);
        const float* g = p.ret_norm_g + h * 512 + c.lane * 8; unsigned ow[4];
#pragma unroll
        for (int e = 0; e < 4; ++e) ow[e] = pk2(v[2 * e] * rs * g[2 * e] * siluf_(lo_f(gw_[e])), v[2 * e + 1] * rs * g[2 * e + 1] * siluf_(hi_f(gw_[e])));
        *(u32x4*)(OI + off) = (u32x4){ow[0], ow[1], ow[2], ow[3]};
    }
}

DEVI void phase_route(const Params& p, const Ctx& c) {
    constexpr int RW_LD = 1028;
    float* rwT = (float*)c.lds;
    for (int i = c.tid; i < 8 * 1024; i += 512) {
        const f32x4 w4 = ((const f32x4*)p.router_w)[i]; const int k = i >> 3, e0 = (i & 7) * 4;
        rwT[(e0 + 0) * RW_LD + k] = w4[0]; rwT[(e0 + 1) * RW_LD + k] = w4[1]; rwT[(e0 + 2) * RW_LD + k] = w4[2]; rwT[(e0 + 3) * RW_LD + k] = w4[3]; }
    __syncthreads();
    const float* mod = (const float*)(p.ws + WS_MOD); bf16_t* H2 = (bf16_t*)(p.ws + WS_HL);
    int* cnt = (int*)(p.ws + WS_CNT); int* ltok = (int*)(p.ws + WS_LTOK); float* lgate = (float*)(p.ws + WS_LGATE); int* pos = (int*)(p.ws + WS_POS);
    int2* stash = (int2*)(c.lds + 135168) + c.wave * 64; int* stok = (int*)(c.lds + 135168 + 8 * 64 * 8) + c.wave * 16; int nst = 0;
    for (int t = c.gw; t < T; t += c.NGW) {
        const int b = t >> 13; const float* mv = mod + b * 6144;
        const f32x4* xr = (const f32x4*)(p.out + (size_t)t * DM) + c.lane; f32x4 v[4]; float ss = 0.f;
#pragma unroll
        for (int j = 0; j < 4; ++j) { v[j] = xr[64 * j]; ss += (v[j][0] * v[j][0] + v[j][1] * v[j][1]) + (v[j][2] * v[j][2] + v[j][3] * v[j][3]); }
        const float rstd = __builtin_amdgcn_rsqf(wave_sum(ss) * (1.f / DM) + EPS);
        u32x2* o8 = (u32x2*)(H2 + (size_t)t * DM) + c.lane;
#pragma unroll
        for (int j = 0; j < 4; ++j) { const int k = 4 * c.lane + 256 * j;
            const f32x4 g = *(const f32x4*)(p.norm2_g + k), sh = *(const f32x4*)(mv + 3072 + k), sc = *(const f32x4*)(mv + 4096 + k);
            v[j] = (v[j] * rstd * g) * (sc + 1.f) + sh; u32x2 w; w.x = pk2(v[j][0], v[j][1]); w.y = pk2(v[j][2], v[j][3]); o8[64 * j] = w; }
        float a[32];
#pragma unroll
        for (int e = 0; e < 32; ++e) { float s = 0.f;
#pragma unroll
            for (int j = 0; j < 4; ++j) { const f32x4 wv = *(const f32x4*)(rwT + e * RW_LD + 4 * c.lane + 256 * j); s += (v[j][0] * wv[0] + v[j][1] * wv[1]) + (v[j][2] * wv[2] + v[j][3] * wv[3]); }
            a[e] = s; if ((e & 3) == 3) __builtin_amdgcn_sched_barrier(0); }
#define HALVE(N, OFF) _Pragma("unroll") for (int i = 0; i < (N) / 2; ++i) { const bool up = (c.lane & (OFF)) != 0; const float snd = up ? a[i] : a[i + (N) / 2]; const float rcv = __shfl_xor(snd, (OFF)); a[i] = (up ? a[i + (N) / 2] : a[i]) + rcv; }
        HALVE(32, 32) HALVE(16, 16) HALVE(8, 8) HALVE(4, 4) HALVE(2, 2)
#undef HALVE
        float logit = a[0] + __shfl_xor(a[0], 1); const int myE = c.lane >> 1; logit += p.router_b[myE];
        float tv[4]; int ti[4]; float cur = logit;
#pragma unroll
        for (int k = 0; k < 4; ++k) { float bv = cur; int bi = myE;
#pragma unroll
            for (int o = 1; o < 64; o <<= 1) { const float ov = __shfl_xor(bv, o); const int oi = __shfl_xor(bi, o); if (ov > bv || (ov == bv && oi < bi)) { bv = ov; bi = oi; } }
            tv[k] = bv; ti[k] = bi; if (myE == bi) cur = -3.0e38f; }
        const float e1 = __expf(tv[1] - tv[0]), e2 = __expf(tv[2] - tv[0]), e3 = __expf(tv[3] - tv[0]); const float inv = 1.f / (1.f + e1 + e2 + e3);
        if (c.lane < 4) { const int k = c.lane; const int e = k == 0 ? ti[0] : (k == 1 ? ti[1] : (k == 2 ? ti[2] : ti[3])); const float g = (k == 0 ? 1.f : (k == 1 ? e1 : (k == 2 ? e2 : e3))) * inv;
            stash[nst * 4 + k] = make_int2(e, __float_as_int(g)); }
        if (c.lane == 0) stok[nst] = t;
        ++nst;
        if (nst == 16 || t + c.NGW >= T) {
            asm volatile("s_waitcnt lgkmcnt(0)" ::: "memory");
            if (c.lane < nst * 4) { const int2 eg = stash[c.lane]; const int tt = stok[c.lane >> 2], e = eg.x;
                const int slot = atomicAdd(cnt + e, 1); ltok[e * CAP + slot] = tt; lgate[e * CAP + slot] = __int_as_float(eg.y); pos[tt * 4 + (c.lane & 3)] = e * CAP + slot; }
            asm volatile("s_waitcnt lgkmcnt(0)" ::: "memory");
            nst = 0; }
    }
    __syncthreads();
}

DEVI int build_tiles(const Params& p, const Ctx& c) {
    LAS int* tb = (LAS int*)(c.lds + LDS_TAB);
    const int* cnt = (const int*)(p.ws + WS_CNT);
    if (c.tid < 32) tb[576 + c.tid] = cnt[c.tid];
    __syncthreads();
    if (c.tid < 32) {
        const int e = c.tid; int base = 0, tot = 0;
        for (int j = 0; j < 32; ++j) { const int nj = (tb[576 + j] + 255) >> 8; base += j < e ? nj : 0; tot += nj; }
        const int n = (tb[576 + e] + 255) >> 8; tb[608 + e] = base;
        for (int i = 0; i < n; ++i) { tb[base + i] = e; tb[288 + base + i] = i * 256; }
        if (e == 0) tb[640] = tot; }
    __syncthreads();
    return tb[640];
}

DEVI void phase_combine(const Params& p, const Ctx& c) {
    const int NT = build_tiles(p, c); (void)NT;
    LAS int* tb = (LAS int*)(c.lds + LDS_TAB);
    const float* mod = (const float*)(p.ws + WS_MOD); const int* pos = (const int*)(p.ws + WS_POS); const bf16_t* Y = (const bf16_t*)(p.ws + WS_Y);
    for (int t = c.gw; t < T; t += c.NGW) {
        const int b = t >> 13; size_t yr[4];
#pragma unroll
        for (int k = 0; k < 4; ++k) { const int pp = pos[t * 4 + k]; const int e = pp >> 14, slot = pp & (CAP - 1); yr[k] = (size_t)(tb[608 + e] * 256 + slot) * 1024; }
        float* orow = p.out + (size_t)t * DM;
#pragma unroll
        for (int j = 0; j < 2; ++j) { const int k0 = c.lane * 8 + 512 * j; float s[8] = {0.f, 0.f, 0.f, 0.f, 0.f, 0.f, 0.f, 0.f};
#pragma unroll
            for (int k = 0; k < 4; ++k) { const u32x4 y = *(const u32x4*)(Y + yr[k] + k0); s[0] += lo_f(y.x); s[1] += hi_f(y.x); s[2] += lo_f(y.y); s[3] += hi_f(y.y); s[4] += lo_f(y.z); s[5] += hi_f(y.z); s[6] += lo_f(y.w); s[7] += hi_f(y.w); }
            const float* gp = mod + b * 6144 + 5120 + k0;
            f32x4 x0 = *(const f32x4*)(orow + k0), x1 = *(const f32x4*)(orow + k0 + 4);
            const f32x4 g0 = *(const f32x4*)gp, g1 = *(const f32x4*)(gp + 4);
            x0 += g0 * (f32x4){s[0], s[1], s[2], s[3]}; x1 += g1 * (f32x4){s[4], s[5], s[6], s[7]};
            *(f32x4*)(orow + k0) = x0; *(f32x4*)(orow + k0 + 4) = x1; }
    }
}

__global__ void __launch_bounds__(512, 2) mk_fwd(Params p) {
    extern __shared__ __attribute__((aligned(16))) unsigned char lds_raw[];
    Ctx c; c.tid = threadIdx.x; c.lane = c.tid & 63; c.wave = __builtin_amdgcn_readfirstlane(c.tid >> 6); c.G = gridDim.x; c.bid = blockIdx.x;
    c.gw = c.bid * 8 + c.wave; c.NGW = c.G * 8; c.lds = (char*)lds_raw;
    LAS unsigned char* lds = (LAS unsigned char*)lds_raw;
    unsigned char* ws = p.ws;
    const int lo = p.ph_lo, hi = p.ph_hi;
#define IN(k) (lo <= (k) && (k) < hi)
#ifndef MK_REPEAT_PHASE
#define MK_REPEAT_PHASE (-1)
#define MK_REPEAT_N 0
#endif
#define REPS(k)
    volatile LAS unsigned* bst = (volatile LAS unsigned*)(lds + LDS_BYTES - 16);
    if (c.tid < 4) bst[c.tid] = 0u;
    __syncthreads();
    if (lo == 0 && hi == NPH) {
        { const int i = c.bid * 512 + c.tid; if (i < (int)(WS_ZERO_BYTES / 4)) { ((unsigned*)ws)[i] = 0u; __threadfence(); } }
        cg::this_grid().sync();
    }
    XcdBarrier xbar = xcd_barrier_post((unsigned*)(ws + WS_BAR), bst);
#define SEAM(k) do { if (IN(k) && IN((k) + 1)) xcd_barrier(xbar); } while (0)
#define PH0 { phase_prep(p, c); }
#define PH1 { phase_hl(p, c); }
#define PH2 { const int ncv = pg8::conv_count((TT / 256) * (NP / 256), c.G); \
        if (c.bid < c.G - ncv) { pg8::ProbDense S; S.init(ws + WS_HL, ws + WS_WIN, TT, NP, 1024, c.G, c.bid, ncv); EpiStoreBf16 E{(bf16_t*)(ws + WS_P), NP}; pg8::gemm_phase(lds, S, E); \
            if (c.tid == 0) atomicAdd((int*)(ws + WS_Q) + 128, 1); conv_run(p, c, 0, true, false); } \
        else { conv_run(p, c, 0, false, false); conv_run(p, c, 1, false, true); } }
#define PH3 { phase_post(p, c); }
#define PH4 { phase_mix(p, c); }
#define PH5 { phase_retgate(p, c); }
#define PH6 { { pg8::ProbDense S; S.init(ws + WS_OI, ws + WS_WBR, T, 1024, 2048, c.G, c.bid); EpiGate1 E{(float*)(ws + WS_OF), (const bf16_t*)(ws + WS_P)}; pg8::gemm_phase(lds, S, E); } \
        __syncthreads(); \
        { pg8::ProbDense S; S.init(ws + WS_OD, ws + WS_WBD, T, 1024, 1024, c.G, c.bid); EpiGate2 E{(const float*)(ws + WS_OF), (bf16_t*)(ws + WS_OB), (const bf16_t*)(ws + WS_P)}; pg8::gemm_phase(lds, S, E); } }
#define PH7 { pg8::ProbDense S; S.init(ws + WS_OB, ws + WS_WOUT, T, 1024, 1024, c.G, c.bid); EpiResid E{p.x, p.out, (const float*)(ws + WS_MOD)}; pg8::gemm_phase(lds, S, E); }
#define PH8 { phase_route(p, c); }
#define PH9 { const int NT = build_tiles(p, c); LAS int* tb = (LAS int*)(c.lds + LDS_TAB); \
        const int ncv = pg8::conv_count(NT * 8, c.G); \
        if (c.bid < c.G - ncv) { pg8::ProbMoe S; S.A = (const char*)(ws + WS_HL); S.Bt = (const char*)(ws + WS_W1); S.K = 1024; S.nN = 8; S.NT = NT; S.G = c.G; S.c = c.bid; S.nconv = ncv; S.bstride = (size_t)2048 * 1024 * 2; \
            S.tile_e = tb; S.tile_s0 = tb + 288; S.cnt = tb + 576; S.ltok = (const int*)(ws + WS_LTOK); S.gather = true; \
            EpiSwiglu E{(bf16_t*)(ws + WS_ACT), p.b1}; pg8::gemm_phase(lds, S, E); } \
        conv_run(p, c, 1, c.bid < c.G - ncv, false); }
#define PH10 { const int NT = build_tiles(p, c); LAS int* tb = (LAS int*)(c.lds + LDS_TAB); \
        pg8::ProbMoe S; S.A = (const char*)(ws + WS_ACT); S.Bt = (const char*)(ws + WS_W2); S.K = 1024; S.nN = 4; S.NT = NT; S.G = c.G; S.c = c.bid; S.nconv = 0; S.bstride = (size_t)1024 * 1024 * 2; \
        S.tile_e = tb; S.tile_s0 = tb + 288; S.cnt = tb + 576; S.ltok = (const int*)(ws + WS_LTOK); S.gather = false; \
        EpiMoe2 E{(bf16_t*)(ws + WS_Y), p.b2, (const float*)(ws + WS_LGATE), tb + 288, tb + 576}; pg8::gemm_phase(lds, S, E); }
#define PH11 { phase_combine(p, c); }
#ifndef MK_DUP
#define MK_DUP (-1)
#endif
#ifndef MK_ONLY
#define MK_ONLY (-1)
#endif
#define RUN(k, BODY) do { if ((MK_ONLY < 0 || MK_ONLY == (k)) && IN(k)) { BODY if (MK_DUP == (k)) { xcd_barrier(xbar); BODY } } SEAM(k); } while (0)
    RUN(0, PH0); RUN(1, PH1); RUN(2, PH2); RUN(3, PH3);
    if (MK_DUP == 23 && IN(3)) { PH2 xcd_barrier(xbar); PH3 xcd_barrier(xbar); }
    RUN(4, PH4); RUN(5, PH5); RUN(6, PH6); RUN(7, PH7); RUN(8, PH8); RUN(9, PH9); RUN(10, PH10);
    if ((MK_ONLY < 0 || MK_ONLY == 11) && IN(11)) PH11
#undef IN
#undef SEAM
}


extern "C" void kernel_launch(void* const* d_in, const int* in_sizes, int n_in, void* d_out, int out_size, void* d_ws, size_t ws_size, hipStream_t stream) {
    static int grid = 0;
    if (grid == 0) {
        if (n_in != 24 || ws_size < WS_END) { fprintf(stderr, "kernel_launch: unexpected inputs (n_in %d, ws %zu, need %zu)\n", n_in, ws_size, (size_t)WS_END); grid = -1; return; }
        int dev = 0, cus = 0, per_cu = 0;
        (void)hipGetDevice(&dev); (void)hipDeviceGetAttribute(&cus, hipDeviceAttributeMultiprocessorCount, dev);
        if (hipFuncSetAttribute((const void*)mk_fwd, hipFuncAttributeMaxDynamicSharedMemorySize, LDS_BYTES) != hipSuccess) { fprintf(stderr, "kernel_launch: hipFuncSetAttribute failed\n"); grid = -1; return; }
        if (hipOccupancyMaxActiveBlocksPerMultiprocessor(&per_cu, (const void*)mk_fwd, 512, LDS_BYTES) != hipSuccess || per_cu < 1) { fprintf(stderr, "kernel_launch: occupancy query says %d\n", per_cu); per_cu = 1; }
        (void)hipGetLastError();
        grid = cus;
    }
    if (grid < 0) return;
#if !MK_ONE_LAUNCH
    (void)hipMemsetAsync((char*)d_ws, 0, WS_ZERO_BYTES, stream);
#endif
    Params p{};
    const float** pp = (const float**)&p;
    for (int i = 0; i < 24; ++i) pp[i] = (const float*)d_in[i];
    p.out = (float*)d_out; p.ws = (unsigned char*)d_ws;
#if MK_ONE_LAUNCH
    p.ph_lo = 0; p.ph_hi = NPH;
    void* args[] = {&p};
    hipError_t e = hipLaunchCooperativeKernel((const void*)mk_fwd, dim3(grid), dim3(512), args, LDS_BYTES, stream);
    if (e != hipSuccess) fprintf(stderr, "cooperative launch failed: %s (grid %d)\n", hipGetErrorString(e), grid);
#else
#ifndef MK_LAST_PHASE
#define MK_LAST_PHASE (NPH - 1)
#endif
    for (int ph = 0; ph <= MK_LAST_PHASE; ++ph) {
        p.ph_lo = ph; p.ph_hi = ph + 1;
        hipLaunchKernelGGL(mk_fwd, dim3(grid), dim3(512), LDS_BYTES, stream, p);
    }

#endif
}
```

```cpp
#include <hip/hip_runtime.h>
#include <hip/hip_cooperative_groups.h>
#include <cstdio>
#include <cstdint>
namespace cg = cooperative_groups;

#ifndef MK_ONE_LAUNCH
#define MK_ONE_LAUNCH 1
#endif

#define DEVI __device__ __forceinline__
#define LAS __attribute__((address_space(3)))
typedef unsigned short bf16_t;
typedef short bf16x8 __attribute__((ext_vector_type(8)));
typedef short s16x4 __attribute__((ext_vector_type(4)));
typedef float f32x4 __attribute__((ext_vector_type(4)));
typedef float f32x16 __attribute__((ext_vector_type(16)));
typedef unsigned u32x4 __attribute__((ext_vector_type(4)));
typedef unsigned u32x2 __attribute__((ext_vector_type(2)));

constexpr int NB = 2, LSEQ = 8192, CTXL = 256, SEQ = LSEQ + CTXL;
constexpr int T = NB * LSEQ;
constexpr int TT = NB * SEQ;
constexpr int DM = 1024, NP = 11264;
constexpr int C_RQ = 0, C_RK = 1024, C_RV = 2048, C_RG = 4096, C_DQ = 6144, C_DK = 7168, C_DV = 8192, C_GA = 9216, C_GB = 10240;
constexpr int NE = 32, CAP = 16384, MAXTILES = 288;
constexpr float EPS = 1e-6f;
constexpr float LOG2E = 1.4426950408889634f;

constexpr size_t al256(size_t x) { return (x + 255) / 256 * 256; }
constexpr size_t WS_CNT = 0;
constexpr size_t WS_Q = 1024;
constexpr size_t WS_BAR = 4096;
constexpr size_t WS_ZERO_BYTES = 4096 + 16384;
constexpr size_t WS_MOD = WS_ZERO_BYTES;
constexpr size_t WS_SCAL = al256(WS_MOD + 3 * 6144 * 4);
constexpr size_t WS_TABR = WS_SCAL + 256;
constexpr size_t WS_TABD = WS_TABR + 128 * 64 * 8;
constexpr size_t WS_WIN = al256(WS_TABD + 128 * 16 * 8);
constexpr size_t WS_WBR = WS_WIN + (size_t)NP * DM * 2;
constexpr size_t WS_WBD = WS_WBR + (size_t)1024 * 2048 * 2;
constexpr size_t WS_WOUT = WS_WBD + (size_t)1024 * 1024 * 2;
constexpr size_t WS_W1 = WS_WOUT + (size_t)1024 * 1024 * 2;
constexpr size_t WS_W2 = WS_W1 + (size_t)NE * 2048 * 1024 * 2;
constexpr size_t WS_HL = WS_W2 + (size_t)NE * 1024 * 1024 * 2;
constexpr size_t WS_P = WS_HL + (size_t)TT * DM * 2;
constexpr size_t WS_KT = WS_P + (size_t)TT * NP * 2;
constexpr size_t WS_VT = WS_KT + (size_t)NB * 1024 * SEQ * 2;
constexpr size_t WS_OI = WS_VT + (size_t)NB * 2048 * SEQ * 2;
constexpr size_t WS_OF = WS_OI + (size_t)T * 2048 * 2;
constexpr size_t WS_OB = WS_OF + (size_t)T * 2048 * 2;
constexpr size_t WS_OD = WS_OB + (size_t)T * 2048 * 2;
constexpr size_t WS_LTOK = WS_OD + (size_t)T * 1024 * 2;
constexpr size_t WS_LGATE = WS_LTOK + (size_t)NE * CAP * 4;
constexpr size_t WS_POS = WS_LGATE + (size_t)NE * CAP * 4;
constexpr size_t WS_DV = WS_POS + (size_t)T * 4 * 4;
constexpr size_t WS_DUMMY = WS_DV + (size_t)NB * 8 * SEQ * 128 * 2;
constexpr size_t WS_END = WS_DUMMY + (size_t)128 * 2048 * 2;
constexpr size_t WS_ACT = WS_P;
constexpr size_t WS_Y = WS_P + (size_t)MAXTILES * 256 * 1024 * 2;
static_assert(WS_Y + (size_t)MAXTILES * 256 * 1024 * 2 <= WS_KT, "act/y overlay must fit in P");
static_assert(WS_END <= ((size_t)1 << 30), "workspace must fit 1 GiB");

struct Params {
    const float *x, *c, *ctx, *c_ctx, *norm1_g, *norm2_g, *w_mod, *b_mod, *w_in, *ret_decay, *ret_norm_g, *dq_g, *dk_g, *dlam, *dn_g,
        *w_br_ret, *w_br_diff, *w_out, *router_w, *router_b, *w1, *b1, *w2, *b2;
    float* out; unsigned char* ws;
    int ph_lo, ph_hi;
};

DEVI float bf2f(unsigned u) { return __uint_as_float(u << 16); }
DEVI unsigned f2bf(float f) { unsigned u = __float_as_uint(f); return (u + 0x7fffu + ((u >> 16) & 1u)) >> 16; }
typedef __bf16 bf16x2_t __attribute__((ext_vector_type(2)));
typedef float f32x2_t __attribute__((ext_vector_type(2)));
DEVI unsigned pk2(float lo, float hi) { const f32x2_t v = {lo, hi}; const bf16x2_t b = __builtin_convertvector(v, bf16x2_t); return __builtin_bit_cast(unsigned, b); }
DEVI unsigned pk2a(float lo, float hi) { unsigned r; asm volatile("v_cvt_pk_bf16_f32 %0, %1, %2" : "=v"(r) : "v"(lo), "v"(hi)); return r; }
DEVI float lo_f(unsigned w) { return __uint_as_float(w << 16); }
DEVI float hi_f(unsigned w) { return __uint_as_float(w & 0xffff0000u); }
DEVI float wave_sum(float v) {
#pragma unroll
    for (int o = 1; o < 64; o <<= 1) v += __shfl_xor(v, o);
    return v;
}
DEVI int lane_id_fresh() { int l; asm volatile("v_mbcnt_lo_u32_b32 %0, -1, 0\n\tv_mbcnt_hi_u32_b32 %0, -1, %0" : "=v"(l)); return l; }
DEVI float sigmoidf_(float x) { return __builtin_amdgcn_rcpf(1.f + __builtin_amdgcn_exp2f(-x * LOG2E)); }
DEVI float siluf_(float x) { return x * sigmoidf_(x); }
#define LDS_WAIT() asm volatile("s_waitcnt lgkmcnt(0)" ::: "memory")
#define VM_WAIT() asm volatile("s_waitcnt vmcnt(0)" ::: "memory")


#define XB_TMO      128
#define XB_XCNT(j)  (256  + 64 * (j))
#define XB_XSUB(j)  (1280 + 64 * (j))
#define XB_XGEN(j)  (2304 + 64 * (j))
#define XB_TOP      3328
#define XB_TOPGEN   3392
#define XCD_BAR_WORDS 3456
#define XB_SPIN_CAP (1u << 18)
DEVI unsigned xb_ld(unsigned* p)              { return __hip_atomic_load(p, __ATOMIC_RELAXED, __HIP_MEMORY_SCOPE_AGENT); }
DEVI unsigned xb_add(unsigned* p, unsigned v) { return __hip_atomic_fetch_add(p, v, __ATOMIC_RELAXED, __HIP_MEMORY_SCOPE_AGENT); }
DEVI unsigned xb_xcc_id() { return (unsigned)__builtin_amdgcn_s_getreg((3 << 11) | 20) & 0xFu; }
#define XB_SPIN(cond, bar) do { unsigned _sp = 0; while (cond) { __builtin_amdgcn_s_sleep(1); \
    if ((++_sp & 255u) == 0u) { if (xb_ld(&(bar)[XB_TMO])) break; if (_sp > XB_SPIN_CAP) { atomicAdd(&(bar)[XB_TMO], 1u); break; } } } } while (0)
struct XcdBarrier { unsigned* bar; unsigned x; volatile LAS unsigned* st; };
DEVI XcdBarrier xcd_barrier_post(unsigned* bar, volatile LAS unsigned* st) {
    XcdBarrier b; b.bar = bar; b.x = xb_xcc_id(); b.st = st;
    if (threadIdx.x == 0) (void)xb_add(&bar[XB_XCNT(b.x)], 1u);
    return b;
}
DEVI void xcd_barrier_complete(unsigned* bar, unsigned x, unsigned& nloc, unsigned& nx) {
    const unsigned G = gridDim.x * gridDim.y * gridDim.z;
    unsigned sum, cnt, mine, sp = 0u;
    for (;;) {
        sum = 0u; cnt = 0u; mine = 0u;
#pragma unroll
        for (unsigned j = 0; j < 16; ++j) { const unsigned c = xb_ld(&bar[XB_XCNT(j)]); sum += c; cnt += (c > 0u) ? 1u : 0u; mine = (j == x) ? c : mine; }
        if (sum == G) break;
        __builtin_amdgcn_s_sleep(1);
        if ((++sp & 255u) == 0u) { if (xb_ld(&bar[XB_TMO])) break; if (sp > XB_SPIN_CAP) { atomicAdd(&bar[XB_TMO], 1u); break; } }
    }
    nloc = mine > 0u ? mine : 1u; nx = cnt > 0u ? cnt : 1u;
}
DEVI void xcd_barrier(const XcdBarrier& b) {
    asm volatile("s_waitcnt vmcnt(0)" ::: "memory");
    __syncthreads();
    if (threadIdx.x == 0) {
        unsigned* bar = b.bar;
        __builtin_amdgcn_s_waitcnt(0);
        unsigned nloc = b.st[0], nx = b.st[1];
        if (nloc == 0u) { xcd_barrier_complete(bar, b.x, nloc, nx); b.st[0] = nloc; b.st[1] = nx; }
        const unsigned old = xb_add(&bar[XB_XSUB(b.x)], 1u);
        const unsigned gen = old / nloc;
        if (old + 1u == (gen + 1u) * nloc) {
            __builtin_amdgcn_fence(__ATOMIC_RELEASE, "agent");
            asm volatile("s_waitcnt vmcnt(0)" ::: "memory");
            const unsigned og = xb_add(&bar[XB_TOP], 1u);
            const unsigned tg = og / nx;
            if (og + 1u == (tg + 1u) * nx) xb_add(&bar[XB_TOPGEN], 1u);
            else XB_SPIN(xb_ld(&bar[XB_TOPGEN]) == tg, bar);
            __builtin_amdgcn_fence(__ATOMIC_ACQUIRE, "agent");
            xb_add(&bar[XB_XGEN(b.x)], 1u);
            asm volatile("s_waitcnt vmcnt(0)" ::: "memory");
        } else {
            XB_SPIN(xb_ld(&bar[XB_XGEN(b.x)]) == gen, bar);
            __builtin_amdgcn_fence(__ATOMIC_ACQUIRE, "agent");
            asm volatile("s_waitcnt vmcnt(0)" ::: "memory");
        }
    }
    __syncthreads();
}

namespace pg8 {
constexpr int BM = 256, BK = 64, HALF = 128, HTB = HALF * BK * 2, STAGE_BYTES = 8 * HTB, NXCD = 8, WGM = 8;
__host__ __device__ __forceinline__ int lds_byte(int r, int c) { const int st = (r >> 4) * 2 + (c >> 5), rr = r & 15, cc = c & 31, ob = rr * 64 + cc * 2; return st * 1024 + (ob ^ (((ob >> 9) & 1) << 5)); }
__host__ __device__ __forceinline__ void stage_rc(int b, int& R, int& C) { const int st = b / 1024, sb = b % 1024, swz = sb ^ (((sb >> 9) & 1) << 5); R = (st >> 1) * 16 + swz / 64; C = (st & 1) * 32 + (swz % 64) / 2; }
__host__ __device__ __forceinline__ int perm32(int rho) { const int n = rho >> 4, i = rho & 15; return 8 * (i >> 2) + 4 * n + (i & 3); }
struct Unit { int pm, pn, g; };

DEVI int conv_count(int units, int G) { const int Rf = units / G, rem = units - Rf * G; return rem ? (G - rem) / (Rf + 1) : 0; }
DEVI bool adopt(int units, int G, int c, int nconv, int i, long& L) {
    const int Rf = units / G, rem = units - Rf * G;
    if (i > Rf) return false;
    if (i == Rf && c >= rem) { const int j = c - rem; if (j >= nconv * Rf) return false; L = (long)(j / nconv) * G + (G - nconv) + (j % nconv); }
    return true;
}
struct ProbDense {
    const char* A; const char* Bt; int K, nM, nN, nwg, G, c, nconv;
    DEVI void init(const void* A_, const void* Bt_, int M, int N, int K_, int G_, int c_, int nconv_ = 0) { A = (const char*)A_; Bt = (const char*)Bt_; K = K_; nM = M / BM; nN = N / BM; nwg = nM * nN; G = G_; c = c_; nconv = nconv_; }
    DEVI bool next(int i, Unit& u) const {
        long L = (long)i * G + c;
        if (nconv) { if (!adopt(nwg, G, c, nconv, i, L)) return false; }
        if (L >= nwg) return false;
        int wgid = (int)L; { const int q = nwg / NXCD, r = nwg % NXCD, xcd = wgid % NXCD, off = wgid / NXCD; wgid = (xcd < r ? xcd * (q + 1) : r * (q + 1) + (xcd - r) * q) + off; }
        const int nig = WGM * nN, gid = wgid / nig, fm = gid * WGM, gsz = (nM - fm) < WGM ? (nM - fm) : WGM;
        u.pm = fm + ((wgid % nig) % gsz); u.pn = (wgid % nig) / gsz; u.g = 0; return true;
    }
    DEVI void a_offs(const Unit& u, const int (&R)[2], const int (&C)[2], unsigned (&va)[2][2]) const {
#pragma unroll
        for (int h = 0; h < 2; ++h)
#pragma unroll
            for (int i = 0; i < 2; ++i) va[h][i] = (unsigned)(((u.pm * BM + h * HALF + R[i]) * K + C[i]) * 2);
    }
    DEVI const char* b_base(const Unit& u) const { return Bt + (size_t)u.pn * BM * K * 2; }
};

struct ProbMoe {
    const char* A; const char* Bt; int K, nN, NT, G, c, nconv; size_t bstride;
    const LAS int* tile_e; const LAS int* tile_s0; const LAS int* cnt; const int* ltok; bool gather;
    DEVI bool next(int i, Unit& u) const {
        long Ll = (long)i * G + c;
        if (nconv) { if (!adopt(NT * nN, G, c, nconv, i, Ll)) return false; }
        const int L = (int)Ll; const int tile = L / nN; if (tile >= NT) return false;
        u.pm = tile; u.pn = L % nN; u.g = tile_e[tile]; return true;
    }
    DEVI void a_offs(const Unit& u, const int (&R)[2], const int (&C)[2], unsigned (&va)[2][2]) const {
        const int s0 = tile_s0[u.pm], n = cnt[u.g];
#pragma unroll
        for (int h = 0; h < 2; ++h)
#pragma unroll
            for (int i = 0; i < 2; ++i) {
                int row;
                if (gather) { const int slot = s0 + h * HALF + R[i]; row = (slot < n) ? ltok[u.g * CAP + slot] : 0; }
                else row = u.pm * BM + h * HALF + R[i];
                va[h][i] = (unsigned)((row * K + C[i]) * 2);
            }
    }
    DEVI const char* b_base(const Unit& u) const { return Bt + (size_t)u.g * bstride + (size_t)u.pn * BM * K * 2; }
};

template <class Prob, class Epi>
DEVI void gemm_phase(LAS unsigned char* lds, const Prob& S, const Epi& E) {
    const int tid = threadIdx.x, wid = __builtin_amdgcn_readfirstlane(tid >> 6), lane = tid & 63, wr = wid >> 2, wc = wid & 3, fr = lane & 15, fq = lane >> 4;
    const int K = S.K, nt = K / BK;
    int Rs[2], Cs[2]; unsigned voffB[2];
#pragma unroll
    for (int i = 0; i < 2; ++i) { int R, C; stage_rc(tid * 16 + i * 8192, R, C); Rs[i] = R; Cs[i] = C; const int Rb = (R & ~31) + perm32(R & 31); voffB[i] = (unsigned)(Rb * K + C) * 2u; }
    const size_t kstep = (size_t)(BK * 2);
    const size_t hstep = (size_t)HALF * K * 2;
    const unsigned ldsw = (unsigned)wid * 1024u;
    const int aoff = lds_byte(wr * 64 + fr, fq * 8), boff = lds_byte(wc * 32 + fr, fq * 8);
#define PG8_SA(b, h) (((b) * 2 + (h)) * HTB)
#define PG8_SB(b, h) ((4 + (b) * 2 + (h)) * HTB)
#define PG8_STAGE(bufoff, gbase, voff) do { _Pragma("unroll") for (int _i = 0; _i < 2; ++_i) \
        __builtin_amdgcn_global_load_lds((const unsigned*)((const char*)(gbase) + (voff)[_i]), (LAS unsigned*)(lds + (bufoff) + ldsw + _i * 8192), 16, 0, 0); } while (0)
#define PG8_LDA(dst, b, h) do { _Pragma("unroll") for (int m = 0; m < 4; ++m) _Pragma("unroll") for (int k = 0; k < 2; ++k) dst[m][k] = *(const LAS bf16x8*)(lds + PG8_SA(b, h) + aoff + m * 2048 + k * 1024); } while (0)
#define PG8_LDB(dst, b, h) do { _Pragma("unroll") for (int n = 0; n < 2; ++n) _Pragma("unroll") for (int k = 0; k < 2; ++k) dst[n][k] = *(const LAS bf16x8*)(lds + PG8_SB(b, h) + boff + n * 2048 + k * 1024); } while (0)
#define PG8_MMA(ai, bj, At, Bt) do { __builtin_amdgcn_s_setprio(1); _Pragma("unroll") for (int m = 0; m < 4; ++m) _Pragma("unroll") for (int n = 0; n < 2; ++n) _Pragma("unroll") for (int k = 0; k < 2; ++k) \
        acc[ai][bj][m][n] = __builtin_amdgcn_mfma_f32_16x16x32_bf16(Bt[n][k], At[m][k], acc[ai][bj][m][n], 0, 0, 0); __builtin_amdgcn_s_setprio(0); } while (0)
#define PG8_WAIT_V(n) asm volatile("s_waitcnt vmcnt(" #n ")" ::: "memory")
#define PG8_WAIT_L(n) asm volatile("s_waitcnt lgkmcnt(" #n ")" ::: "memory")
#define PG8_BAR __builtin_amdgcn_s_barrier()
#define PG8_SCHED __builtin_amdgcn_sched_barrier(0)
    Unit cur, nxt; int ui = 0;
    if (!S.next(0, cur)) return;
    f32x4 acc[2][2][4][2];
#pragma unroll
    for (int a = 0; a < 2; ++a)
#pragma unroll
        for (int b = 0; b < 2; ++b)
#pragma unroll
            for (int m = 0; m < 4; ++m)
#pragma unroll
                for (int n = 0; n < 2; ++n) acc[a][b][m][n] = (f32x4){0.f, 0.f, 0.f, 0.f};
    bf16x8 At[4][2], B0[2][2], B1[2][2];
    unsigned va[2][2], nva[2][2];
    S.a_offs(cur, Rs, Cs, va);
    const char* cB = S.b_base(cur);
    const char* A0 = S.A;
    PG8_STAGE(PG8_SB(0, 0), cB, voffB); PG8_STAGE(PG8_SB(0, 1), cB + hstep, voffB); PG8_STAGE(PG8_SA(0, 0), A0, va[0]); PG8_STAGE(PG8_SA(0, 1), A0, va[1]);
    if (wr == 1) PG8_BAR;
    PG8_WAIT_V(2); PG8_BAR;
    PG8_STAGE(PG8_SB(1, 0), cB + kstep, voffB); PG8_STAGE(PG8_SA(1, 0), A0 + kstep, va[0]); PG8_STAGE(PG8_SB(1, 1), cB + hstep + kstep, voffB);
    PG8_WAIT_V(6); PG8_BAR;
    for (;;) {
        const bool has_next = S.next(ui + 1, nxt);
        const char* nB = cB;
#pragma unroll
        for (int h = 0; h < 2; ++h)
#pragma unroll
            for (int i = 0; i < 2; ++i) nva[h][i] = va[h][i];
        if (has_next) { S.a_offs(nxt, Rs, Cs, nva); nB = S.b_base(nxt); }
        for (int t = 0; t < nt; t += 2) {
            const bool last = (t == nt - 2);
            const char* a1 = A0 + (size_t)(t + 1) * kstep;
            const char* a2 = last ? A0 : A0 + (size_t)(t + 2) * kstep; const char* b2 = last ? nB : cB + (size_t)(t + 2) * kstep;
            const char* a3 = a2 + kstep; const char* b3 = b2 + kstep;
            unsigned v2[2][2];
#pragma unroll
            for (int h = 0; h < 2; ++h)
#pragma unroll
                for (int i = 0; i < 2; ++i) v2[h][i] = last ? nva[h][i] : va[h][i];
            PG8_LDB(B0, 0, 0); PG8_LDB(B1, 0, 1); PG8_SCHED; PG8_LDA(At, 0, 0); PG8_STAGE(PG8_SA(1, 1), a1, va[1]);
            PG8_WAIT_V(8); PG8_WAIT_L(0); PG8_BAR; PG8_MMA(0, 0, At, B0); PG8_MMA(0, 1, At, B1); PG8_BAR; PG8_SCHED;
            PG8_LDA(At, 0, 1); PG8_STAGE(PG8_SB(0, 0), b2, voffB); PG8_STAGE(PG8_SB(0, 1), b2 + hstep, voffB); PG8_STAGE(PG8_SA(0, 0), a2, v2[0]);
            PG8_WAIT_V(8); PG8_WAIT_L(0); PG8_BAR; PG8_MMA(1, 0, At, B0); PG8_MMA(1, 1, At, B1); PG8_BAR; PG8_SCHED;
            PG8_LDB(B0, 1, 0); PG8_LDB(B1, 1, 1); PG8_SCHED; PG8_LDA(At, 1, 0); PG8_STAGE(PG8_SA(0, 1), a2, v2[1]);
            PG8_WAIT_V(8); PG8_WAIT_L(0); PG8_BAR; PG8_MMA(0, 0, At, B0); PG8_MMA(0, 1, At, B1); PG8_BAR; PG8_SCHED;
            PG8_LDA(At, 1, 1); PG8_STAGE(PG8_SB(1, 0), b3, voffB); PG8_STAGE(PG8_SB(1, 1), b3 + hstep, voffB); PG8_STAGE(PG8_SA(1, 0), a3, v2[0]);
            PG8_WAIT_V(8); PG8_WAIT_L(0); PG8_BAR; PG8_MMA(1, 0, At, B0); PG8_MMA(1, 1, At, B1); PG8_BAR; PG8_SCHED;
        }
        if (wr == 0) PG8_BAR;
        E(acc, cur, wr, wc, fr, fq);
        if (!has_next) break;
#pragma unroll
        for (int a = 0; a < 2; ++a)
#pragma unroll
            for (int b = 0; b < 2; ++b)
#pragma unroll
                for (int m = 0; m < 4; ++m)
#pragma unroll
                    for (int n = 0; n < 2; ++n) acc[a][b][m][n] = (f32x4){0.f, 0.f, 0.f, 0.f};
        cur = nxt; cB = nB; ++ui;
#pragma unroll
        for (int h = 0; h < 2; ++h)
#pragma unroll
            for (int i = 0; i < 2; ++i) va[h][i] = nva[h][i];
        if (wr == 1) PG8_BAR;
    }
    PG8_WAIT_V(0);
    PG8_BAR;
#undef PG8_SA
#undef PG8_SB
#undef PG8_STAGE
#undef PG8_LDA
#undef PG8_LDB
#undef PG8_MMA
#undef PG8_WAIT_V
#undef PG8_WAIT_L
#undef PG8_BAR
#undef PG8_SCHED
}
}

typedef f32x4 AccT[2][2][4][2];
#define EPI_LOOP(...) _Pragma("unroll") for (int ai = 0; ai < 2; ++ai) _Pragma("unroll") for (int m = 0; m < 4; ++m) { const int row = u.pm * 256 + ai * 128 + wr * 64 + m * 16 + fr; \
    _Pragma("unroll") for (int bj = 0; bj < 2; ++bj) { const int col = u.pn * 256 + bj * 128 + wc * 32 + 8 * fq; const f32x4 v0 = acc[ai][bj][m][0], v1 = acc[ai][bj][m][1]; __VA_ARGS__ } }

struct EpiStoreBf16 {
    bf16_t* O; int ldc;
    DEVI void operator()(const AccT& acc, const pg8::Unit& u, int wr, int wc, int fr, int fq) const {
        EPI_LOOP({ u32x4 w; w.x = pk2(v0[0], v0[1]); w.y = pk2(v0[2], v0[3]); w.z = pk2(v1[0], v1[1]); w.w = pk2(v1[2], v1[3]);
                   *(u32x4*)(O + (size_t)row * ldc + col) = w; })
    }
};
DEVI int rowc_of(int t) { return (t >> 13) * SEQ + CTXL + (t & 8191); }
struct EpiGate1 {
    float* M1; const bf16_t* P;
    DEVI void operator()(const AccT& acc, const pg8::Unit& u, int wr, int wc, int fr, int fq) const {
        EPI_LOOP({ const u32x4 g = *(const u32x4*)(P + (size_t)rowc_of(row) * NP + C_GA + col);
                   f32x4 o0, o1; o0[0] = sigmoidf_(lo_f(g.x)) * v0[0]; o0[1] = sigmoidf_(hi_f(g.x)) * v0[1]; o0[2] = sigmoidf_(lo_f(g.y)) * v0[2]; o0[3] = sigmoidf_(hi_f(g.y)) * v0[3];
                   o1[0] = sigmoidf_(lo_f(g.z)) * v1[0]; o1[1] = sigmoidf_(hi_f(g.z)) * v1[1]; o1[2] = sigmoidf_(lo_f(g.w)) * v1[2]; o1[3] = sigmoidf_(hi_f(g.w)) * v1[3];
                   float* d = M1 + (size_t)row * DM + col; *(f32x4*)d = o0; *(f32x4*)(d + 4) = o1; })
    }
};
struct EpiGate2 {
    const float* M1; bf16_t* M; const bf16_t* P;
    DEVI void operator()(const AccT& acc, const pg8::Unit& u, int wr, int wc, int fr, int fq) const {
        EPI_LOOP({ const u32x4 g = *(const u32x4*)(P + (size_t)rowc_of(row) * NP + C_GB + col);
                   const float* s = M1 + (size_t)row * DM + col; const f32x4 a0 = *(const f32x4*)s, a1 = *(const f32x4*)(s + 4);
                   u32x4 w; w.x = pk2(a0[0] + sigmoidf_(lo_f(g.x)) * v0[0], a0[1] + sigmoidf_(hi_f(g.x)) * v0[1]); w.y = pk2(a0[2] + sigmoidf_(lo_f(g.y)) * v0[2], a0[3] + sigmoidf_(hi_f(g.y)) * v0[3]);
                   w.z = pk2(a1[0] + sigmoidf_(lo_f(g.z)) * v1[0], a1[1] + sigmoidf_(hi_f(g.z)) * v1[1]); w.w = pk2(a1[2] + sigmoidf_(lo_f(g.w)) * v1[2], a1[3] + sigmoidf_(hi_f(g.w)) * v1[3]);
                   *(u32x4*)(M + (size_t)row * DM + col) = w; })
    }
};
struct EpiResid {
    const float* x; float* out; const float* mod;
    DEVI void operator()(const AccT& acc, const pg8::Unit& u, int wr, int wc, int fr, int fq) const {
        EPI_LOOP({ const int b = row >> 13; const float* gp = mod + b * 6144 + 2048 + col;
                   const f32x4 g0 = *(const f32x4*)gp, g1 = *(const f32x4*)(gp + 4);
                   const float* xs = x + (size_t)row * DM + col; float* d = out + (size_t)row * DM + col;
                   *(f32x4*)d = *(const f32x4*)xs + g0 * v0; *(f32x4*)(d + 4) = *(const f32x4*)(xs + 4) + g1 * v1; })
    }
};
struct EpiSwiglu {
    bf16_t* act; const float* b1;
    DEVI void operator()(const AccT& acc, const pg8::Unit& u, int wr, int wc, int fr, int fq) const {
        const int cc = u.pn * 128 + wc * 32 + 8 * fq; const float* bg = b1 + (size_t)u.g * 2048 + cc; const float* bl = bg + 1024;
        float g_[8], l_[8];
#pragma unroll
        for (int j = 0; j < 8; ++j) { g_[j] = bg[j]; l_[j] = bl[j]; }
#pragma unroll
        for (int ai = 0; ai < 2; ++ai)
#pragma unroll
            for (int m = 0; m < 4; ++m) {
                const int row = u.pm * 256 + ai * 128 + wr * 64 + m * 16 + fr; float o[8];
#pragma unroll
                for (int j = 0; j < 8; ++j) {
                    const float hg = acc[ai][0][m][j >> 2][j & 3] + g_[j], hl = acc[ai][1][m][j >> 2][j & 3] + l_[j];
                    const float glu = fminf(hg, 7.f), lin = fminf(fmaxf(hl, -7.f), 7.f);
                    o[j] = glu * sigmoidf_(1.702f * glu) * (lin + 1.f);
                }
                u32x4 w; w.x = pk2(o[0], o[1]); w.y = pk2(o[2], o[3]); w.z = pk2(o[4], o[5]); w.w = pk2(o[6], o[7]);
                *(u32x4*)(act + (size_t)row * 1024 + cc) = w;
            }
    }
};
struct EpiMoe2 {
    bf16_t* Y; const float* b2; const float* lgate; const LAS int* tile_s0; const LAS int* cnt;
    DEVI void operator()(const AccT& acc, const pg8::Unit& u, int wr, int wc, int fr, int fq) const {
        const int s0 = tile_s0[u.pm], n = cnt[u.g];
#pragma unroll
        for (int ai = 0; ai < 2; ++ai)
#pragma unroll
            for (int m = 0; m < 4; ++m) {
                const int rl = ai * 128 + wr * 64 + m * 16 + fr, slot = s0 + rl; const int row = u.pm * 256 + rl;
                const float gate = (slot < n) ? lgate[u.g * CAP + slot] : 0.f;
#pragma unroll
                for (int bj = 0; bj < 2; ++bj) {
                    const int col = u.pn * 256 + bj * 128 + wc * 32 + 8 * fq; const float* bp = b2 + (size_t)u.g * 1024 + col;
                    const f32x4 v0 = (acc[ai][bj][m][0] + *(const f32x4*)bp) * gate, v1 = (acc[ai][bj][m][1] + *(const f32x4*)(bp + 4)) * gate;
                    u32x4 w; w.x = pk2(v0[0], v0[1]); w.y = pk2(v0[2], v0[3]); w.z = pk2(v1[0], v1[1]); w.w = pk2(v1[2], v1[3]);
                    *(u32x4*)(Y + (size_t)row * 1024 + col) = w;
                }
            }
    }
};

namespace att {
constexpr int KVBLK = 64, LDQ = NP, LDK = NP;
constexpr float SCALE = 0.125f, THR = 8.f;
constexpr int SHM_V = KVBLK * 128 * 2, SHM_K = KVBLK * 128 * 2;
constexpr int OFF_VR = 0, OFF_KR = 4 * SHM_V;
constexpr int OFF_WS = 4 * SHM_V + 3 * SHM_K;
constexpr int OFF_E = 0;
constexpr int E_LD = 132;
constexpr int LDS_BYTES = OFF_WS + 8 * 64 * 4;
static_assert(128 * E_LD * 4 <= OFF_WS, "epilogue scratch must fit under the per-wave words");
#define KSWZ(row, colB) ((row) * 256 + ((colB) ^ (((row) & 7) << 4)))
#define SBAR() __builtin_amdgcn_sched_barrier(0)
DEVI int crow(int r, int hi) { return (r & 3) + 8 * (r >> 2) + 4 * hi; }
template <bool FIRST>
DEVI void partialSM(f32x16& p0, f32x16& p1, f32x16& negm, float& alpha) {
    constexpr float THRL = (THR / SCALE) * (SCALE * LOG2E);
    float pmax = p0[0];
#pragma unroll
    for (int r = 1; r < 16; ++r) pmax = fmaxf(pmax, p0[r]);
#pragma unroll
    for (int r = 0; r < 16; ++r) pmax = fmaxf(pmax, p1[r]);
    { auto rr = __builtin_amdgcn_permlane32_swap(__float_as_uint(pmax), __float_as_uint(pmax), false, false);
      pmax = fmaxf(__uint_as_float(rr[0]), __uint_as_float(rr[1])); }
    if (!FIRST && __builtin_expect(__all(pmax <= THRL), 1)) { alpha = 1.f; }
    else { const float d = FIRST ? pmax : fmaxf(pmax, 0.f); alpha = FIRST ? 1.f : __builtin_amdgcn_exp2f(-d);
#pragma unroll
        for (int r = 0; r < 16; ++r) { p0[r] -= d; p1[r] -= d; negm[r] -= d; } }
#pragma unroll
    for (int r = 0; r < 16; ++r) p0[r] = __builtin_amdgcn_exp2f(p0[r]);
}
DEVI void finishSM(f32x16& p0, f32x16& p1, float alpha, float& l_reg, bf16x8& pa0, bf16x8& pa1, bf16x8& pa2, bf16x8& pa3) {
#pragma unroll
    for (int r = 0; r < 16; ++r) p1[r] = __builtin_amdgcn_exp2f(p1[r]);
    float ps = 0;
#pragma unroll
    for (int r = 0; r < 16; ++r) ps += p0[r];
#pragma unroll
    for (int r = 0; r < 16; ++r) ps += p1[r];
    { auto rr = __builtin_amdgcn_permlane32_swap(__float_as_uint(ps), __float_as_uint(ps), false, false);
      ps = __uint_as_float(rr[0]) + __uint_as_float(rr[1]); }
    l_reg = l_reg * alpha + ps;
#define PK4(P, BASE, OUT) do { unsigned a0 = pk2a(P[BASE + 0], P[BASE + 1]), a1 = pk2a(P[BASE + 2], P[BASE + 3]);   \
    unsigned b0 = pk2a(P[BASE + 4], P[BASE + 5]), b1 = pk2a(P[BASE + 6], P[BASE + 7]);                              \
    auto r0 = __builtin_amdgcn_permlane32_swap(a0, b0, false, false); auto r1 = __builtin_amdgcn_permlane32_swap(a1, b1, false, false); \
    u32x4 w = {r0[0], r1[0], r0[1], r1[1]}; OUT = *reinterpret_cast<bf16x8*>(&w); } while (0)
    PK4(p0, 0, pa0); PK4(p0, 8, pa1); PK4(p1, 0, pa2); PK4(p1, 8, pa3);
#undef PK4
}
DEVI void qkt(f32x16& p0, f32x16& p1, const char* Ks, const bf16x8* qr, int r32, int hi, int st, const f32x16& negm) {
#pragma unroll
    for (int d0 = 0; d0 < 4; ++d0) { const int cb = ((st * 4 + d0) * 16 + hi * 8) * 2;
        const bf16x8 b0 = *reinterpret_cast<const bf16x8*>(Ks + KSWZ(r32, cb));
        const bf16x8 b1 = *reinterpret_cast<const bf16x8*>(Ks + KSWZ(32 + r32, cb));
        p0 = __builtin_amdgcn_mfma_f32_32x32x16_bf16(b0, qr[d0], d0 == 0 ? negm : p0, 0, 0, 0);
        p1 = __builtin_amdgcn_mfma_f32_32x32x16_bf16(b1, qr[d0], d0 == 0 ? negm : p1, 0, 0, 0); }
}
DEVI int v_st(int k, int c) { const int kk = (k & ~0xC) | ((k & 4) << 1) | ((k & 8) >> 1); return ((kk >> 3) * 4 + (c >> 5)) * 512 + ((kk & 7) * 32 + (c & 31)) * 2; }
DEVI int v_rd_base(int lane) { return ((lane & 3) << 3) | (((lane >> 2) & 3) << 6) | (((lane >> 4) & 1) << 5) | (((lane >> 5) & 1) << 8); }
constexpr int v_rd_off(int d0, int ks, int half) { return d0 * 512 + ks * 4096 + half * 2048; }
template <int OFF> DEVI s16x4 tr_read(int vb) {
    s16x4 r; asm volatile("ds_read_b64_tr_b16 %0, %1 offset:%2" : "=&v"(r) : "v"(vb), "i"(OFF) : "memory"); return r;
}
template <int D0> DEVI void pv_one(f32x16& od, int vb, bf16x8 pa0, bf16x8 pa1, bf16x8 pa2, bf16x8 pa3) {
    const s16x4 l0 = tr_read<v_rd_off(D0, 0, 0)>(vb), h0 = tr_read<v_rd_off(D0, 0, 1)>(vb), l1 = tr_read<v_rd_off(D0, 1, 0)>(vb), h1 = tr_read<v_rd_off(D0, 1, 1)>(vb);
    const s16x4 l2 = tr_read<v_rd_off(D0, 2, 0)>(vb), h2 = tr_read<v_rd_off(D0, 2, 1)>(vb), l3 = tr_read<v_rd_off(D0, 3, 0)>(vb), h3 = tr_read<v_rd_off(D0, 3, 1)>(vb);
    asm volatile("s_waitcnt lgkmcnt(0)" ::: "memory"); SBAR();
#define PK(L, H) (bf16x8){L[0], L[1], L[2], L[3], H[0], H[1], H[2], H[3]}
    od = __builtin_amdgcn_mfma_f32_32x32x16_bf16(pa0, PK(l0, h0), od, 0, 0, 0);
    od = __builtin_amdgcn_mfma_f32_32x32x16_bf16(pa1, PK(l1, h1), od, 0, 0, 0);
    od = __builtin_amdgcn_mfma_f32_32x32x16_bf16(pa2, PK(l2, h2), od, 0, 0, 0);
    od = __builtin_amdgcn_mfma_f32_32x32x16_bf16(pa3, PK(l3, h3), od, 0, 0, 0);
#undef PK
}
DEVI void pv_d0(f32x16* o, int vb, bf16x8 pa0, bf16x8 pa1, bf16x8 pa2, bf16x8 pa3) {
    pv_one<0>(o[0], vb, pa0, pa1, pa2, pa3); pv_one<1>(o[1], vb, pa0, pa1, pa2, pa3); pv_one<2>(o[2], vb, pa0, pa1, pa2, pa3); pv_one<3>(o[3], vb, pa0, pa1, pa2, pa3);
}
DEVI void attn_unit(const bf16_t* __restrict__ Qb, const bf16_t* __restrict__ Kh, const bf16_t* __restrict__ Vh, bf16_t* __restrict__ Ob, float lam, const float* __restrict__ dng, char* lds) {
    const int tid = threadIdx.x, wid = __builtin_amdgcn_readfirstlane(tid >> 6), lane = tid & 63, r32 = lane & 31, hi = lane >> 5, w4 = wid & 3, st = wid >> 2;
    char* V_lds = lds + OFF_VR; char* K_lds = lds + OFF_KR; LAS unsigned char* ldsL = (LAS unsigned char*)lds;
    float* wsf = (float*)(lds + OFF_WS) + wid * 64; float* li_l = wsf; float* al_l = wsf + 32;
    float l_reg = 0; f32x16 o[4] = {}; f32x16 negm = {}; bf16x8 qr[4];
    const bf16_t* Qw = Qb + (size_t)(w4 * 32 + r32) * LDQ + st * 64 + hi * 8;
#pragma unroll
    for (int d0 = 0; d0 < 4; ++d0) qr[d0] = *reinterpret_cast<const bf16x8*>(Qw + d0 * 16);
    unsigned kof[2], vof[2];
#pragma unroll
    for (int i = 0; i < 2; ++i) { const int q = 2 * wid + i;
        { const int row = 4 * q + (lane >> 4), colB = ((lane & 15) * 16) ^ ((row & 7) << 4); kof[i] = (unsigned)(row * LDK + colB / 2) * 2u; }
        { const int sub = 2 * q + (lane >> 5), kk = (sub >> 2) * 8 + ((lane & 31) >> 2), cc = (sub & 3) * 32 + (lane & 3) * 8;
          const int k = (kk & ~0xC) | ((kk & 4) << 1) | ((kk & 8) >> 1); vof[i] = (unsigned)(k * LDK + cc) * 2u; } }
    const int vb0 = (int)(uintptr_t)V_lds + v_rd_base(lane);
#define DMA_K(src_tile, slot) do { const char* kb_ = (const char*)Kh + (size_t)(src_tile) * (KVBLK * LDK * 2); _Pragma("unroll") for (int i_ = 0; i_ < 2; ++i_) \
        __builtin_amdgcn_global_load_lds((const unsigned*)(kb_ + kof[i_]), (LAS unsigned*)(ldsL + OFF_KR + (slot) * SHM_K + (2 * wid + i_) * 1024), 16, 0, 0); } while (0)
#define DMA_V(src_tile, slot) do { const char* vb_ = (const char*)Vh + (size_t)(src_tile) * (KVBLK * LDK * 2); _Pragma("unroll") for (int i_ = 0; i_ < 2; ++i_) \
        __builtin_amdgcn_global_load_lds((const unsigned*)(vb_ + vof[i_]), (LAS unsigned*)(ldsL + OFF_VR + (slot) * SHM_V + (2 * wid + i_) * 1024), 16, 0, 0); } while (0)
#define TILE_SYNC(n) do { asm volatile("s_waitcnt vmcnt(" #n ")" ::: "memory"); __builtin_amdgcn_s_barrier(); asm volatile("" ::: "memory"); } while (0)
#define RESC(a) do { if (__any((a) < 1.f)) { const int ln_ = lane_id_fresh(), hi_ = ln_ >> 5; float* al_ = (float*)(lds + OFF_WS) + wid * 64 + 32; \
    if (hi_ == 0) al_[ln_ & 31] = (a); asm volatile("s_waitcnt lgkmcnt(0)" ::: "memory"); \
    _Pragma("unroll") for (int d = 0; d < 4; ++d) _Pragma("unroll") for (int r = 0; r < 16; ++r) o[d][r] *= al_[crow(r, hi_)]; } } while (0)
    f32x16 pA0, pA1, pB0, pB1; float mnA = 0.f, mnB = 0.f, alA, alB; (void)mnA; (void)mnB; bf16x8 pa0, pa1, pa2, pa3; constexpr int NT = SEQ / KVBLK;
#define SEG_X(PN0, PN1, h_, PP0, PP1, alP) do { SBAR(); qkt(PN0, PN1, K_lds + ((h_) % 3) * SHM_K, qr, r32, hi, st, negm); finishSM(PP0, PP1, alP, l_reg, pa0, pa1, pa2, pa3); SBAR(); } while (0)
#define SEG_Y(PN0, PN1, h_, mnN, alN) do { pv_d0(o, vb0 + (((h_) - 1) & 3) * SHM_V, pa0, pa1, pa2, pa3); partialSM<false>(PN0, PN1, negm, alN); RESC(alN); } while (0)
#define ISSUE(h_) do { const int jk_ = (h_) + 2; DMA_K(jk_ < NT ? jk_ : NT - 1, jk_ % 3); DMA_V((h_) + 1, ((h_) + 1) & 3); } while (0)
    DMA_K(0, 0); DMA_V(0, 0); DMA_K(1, 1);
    TILE_SYNC(0);
    if (st == 0) {
        ISSUE(0); qkt(pA0, pA1, K_lds, qr, r32, hi, st, negm); partialSM<true>(pA0, pA1, negm, alA); TILE_SYNC(4);
        for (int h = 1; h + 1 < NT; h += 2) {
            SEG_X(pB0, pB1, h, pA0, pA1, alA);     ISSUE(h);     SEG_Y(pB0, pB1, h, mnB, alB);     TILE_SYNC(4);
            SEG_X(pA0, pA1, h + 1, pB0, pB1, alB); ISSUE(h + 1); SEG_Y(pA0, pA1, h + 1, mnA, alA); TILE_SYNC(4);
        }
        SEG_X(pB0, pB1, NT - 1, pA0, pA1, alA); SEG_Y(pB0, pB1, NT - 1, mnB, alB); TILE_SYNC(0);
        finishSM(pB0, pB1, alB, l_reg, pa0, pa1, pa2, pa3); SBAR();
        pv_d0(o, vb0 + ((NT - 1) & 3) * SHM_V, pa0, pa1, pa2, pa3);
    } else {
        ISSUE(0); qkt(pA0, pA1, K_lds, qr, r32, hi, st, negm); TILE_SYNC(4);
        ISSUE(1); partialSM<true>(pA0, pA1, negm, alA); SEG_X(pB0, pB1, 1, pA0, pA1, alA); TILE_SYNC(4);
        for (int h = 2; h + 3 < NT; h += 2) {
            SEG_Y(pB0, pB1, h - 1, mnB, alB); ISSUE(h);     SEG_X(pA0, pA1, h, pB0, pB1, alB);     TILE_SYNC(4);
            SEG_Y(pA0, pA1, h, mnA, alA);     ISSUE(h + 1); SEG_X(pB0, pB1, h + 1, pA0, pA1, alA); TILE_SYNC(4);
        }
        ISSUE(NT - 2); SEG_Y(pB0, pB1, NT - 3, mnB, alB); SEG_X(pA0, pA1, NT - 2, pB0, pB1, alB); TILE_SYNC(4);
        SEG_Y(pA0, pA1, NT - 2, mnA, alA); SEG_X(pB0, pB1, NT - 1, pA0, pA1, alA); TILE_SYNC(0);
        SEG_Y(pB0, pB1, NT - 1, mnB, alB);
        finishSM(pB0, pB1, alB, l_reg, pa0, pa1, pa2, pa3); SBAR();
        pv_d0(o, vb0 + ((NT - 1) & 3) * SHM_V, pa0, pa1, pa2, pa3);
    }
    asm volatile("s_waitcnt lgkmcnt(0)" ::: "memory"); __builtin_amdgcn_s_barrier(); asm volatile("" ::: "memory");
#undef SEG_X
#undef SEG_Y
#undef ISSUE
    if (hi == 0) li_l[r32] = l_reg; asm volatile("s_waitcnt lgkmcnt(0)" ::: "memory");
    float rli[16];
    const float sgn = st ? lam : 1.f;
#pragma unroll
    for (int r = 0; r < 16; ++r) rli[r] = __builtin_amdgcn_rcpf(li_l[crow(r, hi)]) * sgn;
    float* Es = (float*)(lds + OFF_E);
    if (st == 1) {
#pragma unroll
        for (int r = 0; r < 16; ++r) { const int orow = w4 * 32 + crow(r, hi);
#pragma unroll
            for (int d0 = 0; d0 < 4; ++d0) Es[orow * E_LD + d0 * 32 + r32] = o[d0][r] * rli[r]; }
    }
    __syncthreads();
    if (st == 0) {
#pragma unroll
        for (int r = 0; r < 16; ++r) { const int orow = w4 * 32 + crow(r, hi);
#pragma unroll
            for (int d0 = 0; d0 < 4; ++d0) { float* e = &Es[orow * E_LD + d0 * 32 + r32]; *e = o[d0][r] * rli[r] - *e; } }
    }
    __syncthreads();
    { const int row = tid >> 2, q = tid & 3; const float* e = &Es[row * E_LD + q * 32]; float v[32]; float ss = 0.f;
#pragma unroll
      for (int j = 0; j < 8; ++j) { const f32x4 t4 = *(const f32x4*)(e + 4 * j); v[4 * j] = t4[0]; v[4 * j + 1] = t4[1]; v[4 * j + 2] = t4[2]; v[4 * j + 3] = t4[3]; }
#pragma unroll
      for (int j = 0; j < 32; ++j) ss += v[j] * v[j];
      ss += __shfl_xor(ss, 1); ss += __shfl_xor(ss, 2);
      const float rs = __builtin_amdgcn_rsqf(ss * (1.f / 128.f) + EPS) * 0.8f;
      bf16_t* op = Ob + (size_t)row * 1024 + q * 32; const float* g = dng + q * 32;
#pragma unroll
      for (int j = 0; j < 4; ++j) { u32x4 w; w.x = pk2(v[8 * j] * rs * g[8 * j], v[8 * j + 1] * rs * g[8 * j + 1]); w.y = pk2(v[8 * j + 2] * rs * g[8 * j + 2], v[8 * j + 3] * rs * g[8 * j + 3]);
          w.z = pk2(v[8 * j + 4] * rs * g[8 * j + 4], v[8 * j + 5] * rs * g[8 * j + 5]); w.w = pk2(v[8 * j + 6] * rs * g[8 * j + 6], v[8 * j + 7] * rs * g[8 * j + 7]);
          *(u32x4*)(op + 8 * j) = w; }
    }
    __syncthreads();
#undef DMA_K
#undef DMA_V
#undef TILE_SYNC
#undef RESC
}
}

#define LDS_BAR() do { asm volatile("s_waitcnt lgkmcnt(0)" ::: "memory"); __builtin_amdgcn_s_barrier(); asm volatile("" ::: "memory"); } while (0)
namespace ret {
using att::crow;
DEVI size_t qf_index(int b, int h, int c, int w, int ks, int fq, int fr) { return (((((((size_t)(b * 4 + h) * 66 + c) * 8 + w) * 8 + ks) * 4 + fq) * 16 + fr) * 8); }
DEVI size_t ktf_index(int b, int h, int c, int w, int ks, int hh, int r32) { return (((((((size_t)(b * 4 + h) * 66 + c) * 8 + w) * 8 + ks) * 2 + hh) * 32 + r32) * 8); }
constexpr int VS_LD = 136;
constexpr int ST_LD = 264;
constexpr int TS_LD = 40;
constexpr int OFF_VS = 0, OFF_ST = 2 * 32 * VS_LD * 2, OFF_TS = OFF_ST + 2 * 32 * ST_LD * 2;
DEVI void scan_unit(int u, const bf16_t* __restrict__ QF, const bf16_t* __restrict__ KTF, const bf16_t* __restrict__ VT, bf16_t* __restrict__ OF, bf16_t* __restrict__ OB, const float* __restrict__ scal, char* lds) {
    const int b = u >> 7, h = (u >> 5) & 3, dir = (u >> 4) & 1, vs = u & 15;
    const int tid = threadIdx.x, w = __builtin_amdgcn_readfirstlane(tid >> 6), lane = tid & 63, r32 = lane & 31, hh = lane >> 5, fr = lane & 15, fq = lane >> 4;
    const float lgn = scal[dir * 4 + h];
    const float gch = __expf(lgn * 128.f);
    bf16_t* Vs = (bf16_t*)(lds + OFF_VS); bf16_t* St = (bf16_t*)(lds + OFF_ST); bf16_t* Ts = (bf16_t*)(lds + OFF_TS) + w * (16 * TS_LD);
    for (int i = tid; i < 32 * ST_LD / 2; i += 512) ((unsigned*)St)[i] = 0u;
    f32x16 S = {};
    const bf16_t* QFb = QF + qf_index(b, h, 0, w, 0, 0, 0) + lane * 8;
    const bf16_t* KTFb = KTF + ktf_index(b, h, 0, w, 0, 0, 0) + lane * 8;
    const bf16_t* VTb = VT + ((size_t)(b * 4 + h) * 512 + vs * 32) * SEQ;
    bf16_t* Odir = dir ? OB : OF;
    bf16_t* sink = (bf16_t*)((char*)OF + (WS_DUMMY - WS_OF));
    const int sv = tid >> 4, sj = (tid & 15) * 8;
    float wj[8];
#pragma unroll
    for (int e = 0; e < 8; ++e) { const int j = sj + e; wj[e] = __expf(lgn * (float)(dir ? j : 127 - j)); }
    const int itok = 16 * w + fr;
    const float qd = __expf(lgn * (float)(dir ? 128 - itok : itok + 1));
    bf16x8 kfA[8], kfB[8], qfA[8], qfB[8]; bf16x8 vA, vB;
#define CHUNK_OF(k) (dir ? ((k) == 0 ? 1 : ((k) == 1 ? 0 : 67 - (k))) : (k))
#define CLAMPK(kk) ((kk) < 66 ? (kk) : 65)
#define LOADK(KF_, kk) do { const size_t co_ = (size_t)CHUNK_OF(CLAMPK(kk)) * 32768; \
        _Pragma("unroll") for (int ks = 0; ks < 8; ++ks) KF_[ks] = *(const bf16x8*)(KTFb + co_ + ((ks + vs) & 7) * 512); } while (0)
#define LOADV(VR_, kk) do { VR_ = *(const bf16x8*)(VTb + (size_t)sv * SEQ + CHUNK_OF(CLAMPK(kk)) * 128 + sj); } while (0)
#define LOADQ(QF_, kk) do { const size_t co_ = (size_t)CHUNK_OF(CLAMPK(kk)) * 32768;     \
        _Pragma("unroll") for (int ks = 0; ks < 8; ++ks) QF_[ks] = *(const bf16x8*)(QFb + co_ + ((ks + vs) & 7) * 512); } while (0)
#define STEP(k, KF_, V_, QF_) do { \
        const int cn = CHUNK_OF(k); \
        bf16_t* Vsk = Vs + ((k) & 1) * (32 * VS_LD); const bf16_t* Stk = St + ((k) & 1) * (32 * ST_LD); bf16_t* Stn = St + (((k) + 1) & 1) * (32 * ST_LD); \
        { u32x4 vv = *reinterpret_cast<u32x4*>(&V_); u32x4 ww; \
          ww.x = pk2(lo_f(vv.x) * wj[0], hi_f(vv.x) * wj[1]); ww.y = pk2(lo_f(vv.y) * wj[2], hi_f(vv.y) * wj[3]); \
          ww.z = pk2(lo_f(vv.z) * wj[4], hi_f(vv.z) * wj[5]); ww.w = pk2(lo_f(vv.w) * wj[6], hi_f(vv.w) * wj[7]); \
          *(u32x4*)(Vsk + sv * VS_LD + sj) = ww; } \
        LOADV(V_, (k) + 2); \
        __syncthreads();     \
        _Pragma("unroll") for (int r = 0; r < 16; ++r) S[r] *= gch; \
        _Pragma("unroll") for (int ks = 0; ks < 8; ++ks) { \
            const bf16x8 vf = *(const bf16x8*)(Vsk + r32 * VS_LD + ((ks + vs) & 7) * 16 + hh * 8); \
            S = __builtin_amdgcn_mfma_f32_32x32x16_bf16(KF_[ks], vf, S, 0, 0, 0); } \
        LOADK(KF_, (k) + 2); \
        _Pragma("unroll") for (int g = 0; g < 4; ++g) { u32x2 ww; ww.x = pk2(S[4 * g], S[4 * g + 1]); ww.y = pk2(S[4 * g + 2], S[4 * g + 3]); \
            *(u32x2*)(Stn + r32 * ST_LD + 32 * w + 8 * g + 4 * hh) = ww; } \
        {                    \
            f32x4 a0 = {0.f, 0.f, 0.f, 0.f}, a1 = {0.f, 0.f, 0.f, 0.f}; \
            _Pragma("unroll") for (int ks = 0; ks < 8; ++ks) { \
                const bf16x8 s0f = *(const bf16x8*)(Stk + (fr) * ST_LD + ((ks + vs) & 7) * 32 + fq * 8); \
                const bf16x8 s1f = *(const bf16x8*)(Stk + (16 + fr) * ST_LD + ((ks + vs) & 7) * 32 + fq * 8); \
                a0 = __builtin_amdgcn_mfma_f32_16x16x32_bf16(s0f, QF_[ks], a0, 0, 0, 0); \
                a1 = __builtin_amdgcn_mfma_f32_16x16x32_bf16(s1f, QF_[ks], a1, 0, 0, 0); } \
            u32x2 w0, w1; w0.x = pk2(a0[0] * qd, a0[1] * qd); w0.y = pk2(a0[2] * qd, a0[3] * qd); w1.x = pk2(a1[0] * qd, a1[1] * qd); w1.y = pk2(a1[2] * qd, a1[3] * qd); \
            *(u32x2*)(Ts + fr * TS_LD + 4 * fq) = w0; *(u32x2*)(Ts + fr * TS_LD + 16 + 4 * fq) = w1;        \
            asm volatile("s_waitcnt lgkmcnt(0)" ::: "memory"); \
            const int tk = lane >> 2, l = (cn - 2) * 128 + 16 * w + tk; \
            const u32x4 ov = *(const u32x4*)(Ts + tk * TS_LD + (lane & 3) * 8); \
            bf16_t* op = (cn >= 2 ? Odir + (size_t)(b * LSEQ + l) * 2048 : sink + (size_t)(16 * w + tk) * 2048) + h * 512 + vs * 32 + (lane & 3) * 8; \
            *(u32x4*)op = ov; } \
        LOADQ(QF_, (k) + 2); \
    } while (0)
    LOADK(kfA, 0); LOADV(vA, 0); LOADK(kfB, 1); LOADV(vB, 1); LOADQ(qfA, 0); LOADQ(qfB, 1);
#pragma unroll 1
    for (int k2 = 0; k2 < 66; k2 += 2) {
        STEP(k2 + 0, kfA, vA, qfA);
        STEP(k2 + 1, kfB, vB, qfB);
    }
    __syncthreads();
#undef STEP
#undef LOADK
#undef LOADV
#undef LOADQ
#undef CHUNK_OF
}
constexpr int QL_LD = 264, PL_LD = 136, VL_LD = 136;
constexpr int OFF_QL = 0, OFF_KL = 128 * QL_LD * 2, OFF_PL = 0, OFF_VL = OFF_KL;
DEVI void intra_unit(int u, const bf16_t* __restrict__ P, const bf16_t* __restrict__ VT, bf16_t* __restrict__ OI, const float* __restrict__ scal, char* lds) {
    const int b = u >> 8, h = (u >> 6) & 3, lc = u & 63, s0 = (lc + 2) * 128;
    const int tid = threadIdx.x, w = __builtin_amdgcn_readfirstlane(tid >> 6), lane = tid & 63, r32 = lane & 31, hh = lane >> 5;
    const int tr = w >> 1, tc0 = 2 * (w & 1);
    bf16_t* Ql = (bf16_t*)(lds + OFF_QL); bf16_t* Kl = (bf16_t*)(lds + OFF_KL); bf16_t* Pl = (bf16_t*)(lds + OFF_PL); bf16_t* Vl = (bf16_t*)(lds + OFF_VL);
    {
        const int srow = tid >> 5, pc = (tid & 31) * 8;
        const bf16_t* qg = P + ((size_t)b * SEQ + s0 + srow) * NP + C_RQ + h * 256 + pc; const bf16_t* kg = qg + (C_RK - C_RQ);
        u32x4 qv[8], kv[8];
#pragma unroll
        for (int it = 0; it < 8; ++it) { qv[it] = *(const u32x4*)(qg + (size_t)it * 16 * NP); kv[it] = *(const u32x4*)(kg + (size_t)it * 16 * NP); }
#pragma unroll
        for (int it = 0; it < 8; ++it) { *(u32x4*)(Ql + (it * 16 + srow) * QL_LD + pc) = qv[it]; *(u32x4*)(Kl + (it * 16 + srow) * QL_LD + pc) = kv[it]; }
    }
    __syncthreads();
    f32x16 c0 = {}, c1 = {};
#pragma unroll 4
    for (int ks = 0; ks < 16; ++ks) {
        const bf16x8 a = *(const bf16x8*)(Ql + (32 * tr + r32) * QL_LD + ks * 16 + hh * 8);
        const bf16x8 b0 = *(const bf16x8*)(Kl + (32 * tc0 + r32) * QL_LD + ks * 16 + hh * 8), b1 = *(const bf16x8*)(Kl + (32 * tc0 + 32 + r32) * QL_LD + ks * 16 + hh * 8);
        c0 = __builtin_amdgcn_mfma_f32_32x32x16_bf16(a, b0, c0, 0, 0, 0);
        c1 = __builtin_amdgcn_mfma_f32_32x32x16_bf16(a, b1, c1, 0, 0, 0);
    }
    const int vrow = tid >> 4, vpc = (tid & 15) * 8;
    const bf16_t* vg = VT + ((size_t)(b * 4 + h) * 512 + vrow) * SEQ + s0 + vpc;
    u32x4 vv[4];
#pragma unroll
    for (int it = 0; it < 4; ++it) vv[it] = *(const u32x4*)(vg + (size_t)(it * 32) * SEQ);
    LDS_BAR();
    const float lf2 = scal[h] * LOG2E, lb2 = scal[4 + h] * LOG2E;
#pragma unroll
    for (int t = 0; t < 2; ++t) {
        const int j = 32 * (tc0 + t) + r32;
#pragma unroll
        for (int r = 0; r < 16; ++r) {
            const int i = 32 * tr + crow(r, hh); const float dlt = (float)(i - j);
            float dm = 0.f;
            if (j <= i) dm += __builtin_amdgcn_exp2f(dlt * lf2);
            if (j >= i) dm += __builtin_amdgcn_exp2f(-dlt * lb2);
            const float v = (t ? c1[r] : c0[r]) * dm;
            Pl[i * PL_LD + j] = (bf16_t)f2bf(v);
        }
    }
    bf16x8 pf[8];
    bf16_t* Ob = OI + ((size_t)b * LSEQ + lc * 128 + 32 * tr + r32) * 2048 + h * 512;
#pragma unroll 1
    for (int vb = 0; vb < 4; ++vb) {
        bf16_t* Vb = Vl + (vb & 1) * (128 * VL_LD);
#pragma unroll
        for (int it = 0; it < 4; ++it) *(u32x4*)(Vb + (it * 32 + vrow) * VL_LD + vpc) = vv[it];
        if (vb < 3) {
#pragma unroll
            for (int it = 0; it < 4; ++it) vv[it] = *(const u32x4*)(vg + (size_t)((vb + 1) * 128 + it * 32) * SEQ);
        }
        LDS_BAR();
        if (vb == 0) {
#pragma unroll
            for (int ks = 0; ks < 8; ++ks) pf[ks] = *(const bf16x8*)(Pl + (32 * tr + r32) * PL_LD + ks * 16 + hh * 8);
        }
#pragma unroll
        for (int t = 0; t < 2; ++t) {
            const int vt = (w & 1) * 2 + t;
            f32x16 oacc = {};
#pragma unroll
            for (int ks = 0; ks < 8; ++ks) {
                const bf16x8 a = *(const bf16x8*)(Vb + (32 * vt + r32) * VL_LD + ks * 16 + hh * 8);
                oacc = __builtin_amdgcn_mfma_f32_32x32x16_bf16(a, pf[ks], oacc, 0, 0, 0);
            }
            const int v0 = vb * 128 + vt * 32;
#pragma unroll
            for (int g = 0; g < 4; ++g) { u32x2 ww; ww.x = pk2(oacc[4 * g], oacc[4 * g + 1]); ww.y = pk2(oacc[4 * g + 2], oacc[4 * g + 3]);
                *(u32x2*)(Ob + v0 + 8 * g + 4 * hh) = ww; }
        }
    }
    __syncthreads();
}
}

constexpr int NPH = 12;
constexpr int LDS_BYTES = 160 * 1024;
constexpr int LDS_TAB = 131072;

struct Ctx {
    int tid, lane, wave, gw, NGW, G, bid;
    char* lds;
};

struct TrTile { const float* W; bf16_t* WT; int K, N, k0, n0, perm; };
DEVI int tr_orow(const TrTile& t, int n) { return t.perm ? 256 * ((n & 1023) >> 7) + 128 * (n >> 10) + (n & 127) : n; }
DEVI void tr_load(const TrTile& t, f32x4 (&v)[16], int tid) { const int wv = tid >> 6, l = tid & 63;
#pragma unroll
    for (int i = 0; i < 16; ++i) v[i] = *(const f32x4*)(t.W + (size_t)(t.k0 + 16 * wv + i) * t.N + t.n0 + 4 * l); }
DEVI void tr_to_lds(const f32x4 (&v)[16], unsigned* T, int tid) { const int wv = tid >> 6, l = tid & 63;
#pragma unroll
    for (int e = 0; e < 4; ++e) { const int n = 4 * l + e;
#pragma unroll
        for (int h = 0; h < 2; ++h) { u32x4 o; o.x = pk2(v[8 * h][e], v[8 * h + 1][e]); o.y = pk2(v[8 * h + 2][e], v[8 * h + 3][e]); o.z = pk2(v[8 * h + 4][e], v[8 * h + 5][e]); o.w = pk2(v[8 * h + 6][e], v[8 * h + 7][e]);
            *(u32x4*)(T + n * 64 + 4 * ((2 * wv + h) ^ (l & 7))) = o; } } }
DEVI void tr_store(const TrTile& t, const unsigned* T, int tid) { const int piece = tid & 15;
#pragma unroll
    for (int it = 0; it < 8; ++it) { const int n = (tid >> 4) + 32 * it;
        const u32x4 o = *(const u32x4*)(T + n * 64 + 4 * (piece ^ ((n >> 2) & 7)));
        *(u32x4*)(t.WT + (size_t)tr_orow(t, t.n0 + n) * t.K + t.k0 + piece * 8) = o; } }

DEVI void phase_prep(const Params& p, const Ctx& c) {
    unsigned char* ws = p.ws;
    constexpr int T_IN = 8 * (NP / 256), T_BR = 16 * 4, T_BD = 8 * 4, T_OUT = T_BD, T_W1 = 8 * 8, T_W2 = 8 * 4;
    int NTIL = T_IN + T_BR + T_BD + T_OUT;
    asm volatile("" : "+s"(NTIL));
    auto tile_of = [&](int it) { TrTile t; int r = it; t.perm = 0;
        if (r < T_IN) { const int nb = NP / 256; t.W = p.w_in; t.WT = (bf16_t*)(ws + WS_WIN); t.K = 1024; t.N = NP; t.k0 = (r / nb) * 128; t.n0 = (r % nb) * 256; return t; } r -= T_IN;
        if (r < T_BR) { t.W = p.w_br_ret; t.WT = (bf16_t*)(ws + WS_WBR); t.K = 2048; t.N = 1024; t.k0 = (r / 4) * 128; t.n0 = (r % 4) * 256; return t; } r -= T_BR;
        if (r < T_BD) { t.W = p.w_br_diff; t.WT = (bf16_t*)(ws + WS_WBD); t.K = 1024; t.N = 1024; t.k0 = (r / 4) * 128; t.n0 = (r % 4) * 256; return t; } r -= T_BD;
        if (r < T_OUT) { t.W = p.w_out; t.WT = (bf16_t*)(ws + WS_WOUT); t.K = 1024; t.N = 1024; t.k0 = (r / 4) * 128; t.n0 = (r % 4) * 256; return t; } r -= T_OUT;
        const int e = r / (T_W1 + T_W2); r -= e * (T_W1 + T_W2);
        if (r < T_W1) { t.W = p.w1 + (size_t)e * 1024 * 2048; t.WT = (bf16_t*)(ws + WS_W1) + (size_t)e * 2048 * 1024; t.K = 1024; t.N = 2048; t.k0 = (r / 8) * 128; t.n0 = (r % 8) * 256; t.perm = 1; return t; } r -= T_W1;
        t.W = p.w2 + (size_t)e * 1024 * 1024; t.WT = (bf16_t*)(ws + WS_W2) + (size_t)e * 1024 * 1024; t.K = 1024; t.N = 1024; t.k0 = (r / 4) * 128; t.n0 = (r % 4) * 256; return t; };
    {
        unsigned* Tl = (unsigned*)c.lds; f32x4 v[16];
        int it = c.bid; TrTile cur = tile_of(it < NTIL ? it : 0);
        if (it < NTIL) tr_load(cur, v, c.tid);
        while (it < NTIL) {
            tr_to_lds(v, Tl, c.tid);
            const int nx = it + c.G; TrTile nxt = tile_of(nx < NTIL ? nx : 0);
            if (nx < NTIL) tr_load(nxt, v, c.tid);
            LDS_BAR();
            tr_store(cur, Tl, c.tid);
            LDS_BAR();
            cur = nxt; it = nx;
        }
    }
    float* mod = (float*)(ws + WS_MOD);
    __syncthreads();
    float* sil = (float*)c.lds + 1024;
    if (c.G - 1 - c.bid < 192) { for (int i = c.tid; i < 3072; i += 512) sil[i] = siluf_(i < 2048 ? p.c[i] : p.c_ctx[i - 2048]); }
    __syncthreads();
    for (int cgp = c.G - 1 - c.bid; cgp < 192; cgp += c.G) {
        const int col = cgp * 32 + (c.lane & 31), kh = c.lane >> 5; float a0 = 0.f, a1 = 0.f, a2 = 0.f;
        for (int k0 = c.wave * 128; k0 < c.wave * 128 + 128; k0 += 64) {
            float wv[32];
#pragma unroll
            for (int i = 0; i < 32; ++i) wv[i] = p.w_mod[(size_t)(k0 + 2 * i + kh) * 6144 + col];
#pragma unroll
            for (int i = 0; i < 32; ++i) { const float* sp = sil + k0 + 2 * i + kh; a0 += sp[0] * wv[i]; a1 += sp[1024] * wv[i]; a2 += sp[2048] * wv[i]; }
        }
        a0 += __shfl_xor(a0, 32); a1 += __shfl_xor(a1, 32); a2 += __shfl_xor(a2, 32);
        float* red = (float*)c.lds;
        if (kh == 0) { red[(c.wave * 3 + 0) * 32 + c.lane] = a0; red[(c.wave * 3 + 1) * 32 + c.lane] = a1; red[(c.wave * 3 + 2) * 32 + c.lane] = a2; }
        __syncthreads();
        if (c.tid < 96) { const int v = c.tid >> 5, l = c.tid & 31; float s = 0.f;
#pragma unroll
            for (int w = 0; w < 8; ++w) s += red[(w * 3 + v) * 32 + l];
            mod[v * 6144 + cgp * 32 + l] = s + p.b_mod[cgp * 32 + l]; }
        __syncthreads();
    }
    const int gt = c.bid * 512 + c.tid;
    if (gt < 128 * 64) { const int pos = gt >> 6, i = gt & 63; const float inv = powf(10000.f, -(float)i / 64.f); float s, co; sincosf((float)pos * inv, &s, &co);
        ((float2*)(ws + WS_TABR))[gt] = make_float2(co, s); }
    else if (gt < 128 * 64 + 128 * 16) { const int q = gt - 128 * 64, pos = q >> 4, i = q & 15; const float inv = powf(10000.f, -(float)i / 16.f); float s, co; sincosf((float)pos * inv, &s, &co);
        ((float2*)(ws + WS_TABD))[q] = make_float2(co, s); }
    else if (gt < 128 * 80 + 8) { const int q = gt - 128 * 80; const float xl = p.ret_decay[q]; ((float*)(ws + WS_SCAL))[q] = -log1pf(expf(-xl)); }
    else if (gt >= 128 * 80 + 64 && gt < 128 * 80 + 128) {
        const int i = gt - (128 * 80 + 64); const float s01 = wave_sum(p.dlam[i] * p.dlam[64 + i]), s23 = wave_sum(p.dlam[128 + i] * p.dlam[192 + i]);
        if (i == 0) ((float*)(ws + WS_SCAL))[8] = expf(s01) - expf(s23) + 0.2f; }
}

constexpr int Q1_TILES = NE * 64, Q2_TILES = NE * 32;
DEVI TrTile conv_tile(const Params& p, int qsel, int t) {
    TrTile tt;
    if (qsel == 0) { const int e = t >> 6, r = t & 63; tt.W = p.w1 + (size_t)e * 1024 * 2048; tt.WT = (bf16_t*)(p.ws + WS_W1) + (size_t)e * 2048 * 1024; tt.K = 1024; tt.N = 2048; tt.k0 = (r >> 3) * 128; tt.n0 = (r & 7) * 256; tt.perm = 1; }
    else { const int e = t >> 5, r = t & 31; tt.W = p.w2 + (size_t)e * 1024 * 1024; tt.WT = (bf16_t*)(p.ws + WS_W2) + (size_t)e * 1024 * 1024; tt.K = 1024; tt.N = 1024; tt.k0 = (r >> 2) * 128; tt.n0 = (r & 3) * 256; tt.perm = 0; }
    return tt;
}
DEVI void conv_run(const Params& p, const Ctx& c, int qsel, bool peek, bool stoppable) {
    unsigned* Tl = (unsigned*)c.lds; int* qs = (int*)(c.lds + 65536);
    int* q = (int*)(p.ws + WS_Q) + 64 * qsel; const int lim = qsel ? Q2_TILES : Q1_TILES;
    __syncthreads();
    const int* flagp = (const int*)(p.ws + WS_Q) + 128; int flg = 0; bool live = true;
    int pre = lim;
    if (c.tid == 0) {
        int t0 = lim, t1 = lim;
        if ((!peek || __hip_atomic_load(q, __ATOMIC_RELAXED, __HIP_MEMORY_SCOPE_AGENT) < lim) && !(stoppable && __hip_atomic_load(flagp, __ATOMIC_RELAXED, __HIP_MEMORY_SCOPE_AGENT) != 0)) { t0 = (int)atomicInc((unsigned*)q, 0xFFFFFFFFu); t1 = (int)atomicInc((unsigned*)q, 0xFFFFFFFFu); pre = (int)atomicInc((unsigned*)q, 0xFFFFFFFFu); }
        qs[0] = t0 < lim ? t0 : -1; qs[1] = t1 < lim ? t1 : -1; }
    __syncthreads();
    int ia = __builtin_amdgcn_readfirstlane(qs[0]), ib = __builtin_amdgcn_readfirstlane(qs[1]);
    if (ia < 0) return;
    f32x4 va[16], vb[16];
    TrTile dummy; dummy.W = p.w1; dummy.WT = nullptr; dummy.K = 0; dummy.N = 0; dummy.k0 = 0; dummy.n0 = 0; dummy.perm = 0;
    TrTile ta = conv_tile(p, qsel, ia), tb = ib >= 0 ? conv_tile(p, qsel, ib) : dummy;
    tr_load(ta, va, c.tid);
    tr_load(tb, vb, c.tid);
    LDS_BAR();
#define CONV_STEP(IT, TT_, V) { tr_to_lds(V, Tl, c.tid); \
        if (c.tid == 0) { const bool ok = live && pre < lim; qs[0] = ok ? pre : -1; live = ok && flg == 0; if (live) pre = (int)atomicInc((unsigned*)q, 0xFFFFFFFFu); \
                          if (stoppable) flg = __hip_atomic_load(flagp, __ATOMIC_RELAXED, __HIP_MEMORY_SCOPE_AGENT); } \
        LDS_BAR(); \
        const int nx = __builtin_amdgcn_readfirstlane(qs[0]); const TrTile done = TT_; TT_ = nx >= 0 ? conv_tile(p, qsel, nx) : dummy; \
        tr_load(TT_, V, c.tid); \
        tr_store(done, Tl, c.tid); IT = nx; \
        LDS_BAR(); }
    CONV_STEP(ia, ta, va)
    if (ib >= 0) {
        CONV_STEP(ib, tb, vb)
        while (ia >= 0) {
            CONV_STEP(ia, ta, va)
            if (ib < 0) break;
            CONV_STEP(ib, tb, vb)
        }
    }
#undef CONV_STEP
}

DEVI void phase_hl(const Params& p, const Ctx& c) {
    const float* mod = (const float*)(p.ws + WS_MOD); bf16_t* HL = (bf16_t*)(p.ws + WS_HL);
    for (int r = c.gw; r < TT; r += c.NGW) {
        const int b = r / SEQ, s = r % SEQ; const bool isctx = s < CTXL;
        const float* src = isctx ? p.ctx + ((size_t)b * CTXL + s) * DM : p.x + ((size_t)b * LSEQ + (s - CTXL)) * DM;
        const float* mv = mod + (isctx ? 2 : b) * 6144;
        const f32x4* xr = (const f32x4*)src + c.lane; f32x4 v[4]; float ss = 0.f;
#pragma unroll
        for (int j = 0; j < 4; ++j) { v[j] = xr[64 * j]; ss += (v[j][0] * v[j][0] + v[j][1] * v[j][1]) + (v[j][2] * v[j][2] + v[j][3] * v[j][3]); }
        const float rstd = __builtin_amdgcn_rsqf(wave_sum(ss) * (1.f / DM) + EPS);
        u32x2* o8 = (u32x2*)(HL + (size_t)r * DM) + c.lane;
#pragma unroll
        for (int j = 0; j < 4; ++j) { const int k = 4 * c.lane + 256 * j;
            const f32x4 g = *(const f32x4*)(p.norm1_g + k), sh = *(const f32x4*)(mv + k), sc = *(const f32x4*)(mv + 1024 + k);
            const f32x4 y = (v[j] * rstd * g) * (sc + 1.f) + sh; u32x2 w; w.x = pk2(y[0], y[1]); w.y = pk2(y[2], y[3]); o8[64 * j] = w; }
    }
}

DEVI void phase_post(const Params& p, const Ctx& c) {
    bf16_t* P = (bf16_t*)(p.ws + WS_P); const float2* tabR = (const float2*)(p.ws + WS_TABR); const float2* tabD = (const float2*)(p.ws + WS_TABD);
    for (int r = c.gw; r < TT; r += c.NGW) {
        const int s = r % SEQ; const bool lat = s >= CTXL; const int tpos = lat ? s - CTXL : 0; const int prow = tpos >> 6, pcol = tpos & 63;
        bf16_t* pr = P + (size_t)r * NP;
        if (lat) {
            const int blk = c.lane >> 3, i8 = (c.lane & 7) * 8; const int pos = (blk & 1) ? pcol : prow;
            bf16_t* q1 = pr + C_RQ + blk * 128 + i8; const u32x4 a = *(const u32x4*)q1, bq = *(const u32x4*)(q1 + 64);
            const unsigned aw[4] = {a.x, a.y, a.z, a.w}, bw[4] = {bq.x, bq.y, bq.z, bq.w}; unsigned o1[4], o2[4];
#pragma unroll
            for (int e = 0; e < 4; ++e) { const float2 t0 = tabR[pos * 64 + i8 + 2 * e], t1 = tabR[pos * 64 + i8 + 2 * e + 1];
                const float x1a = lo_f(aw[e]), x1b = hi_f(aw[e]), x2a = lo_f(bw[e]), x2b = hi_f(bw[e]);
                o1[e] = pk2((x1a * t0.x - x2a * t0.y) * 0.0625f, (x1b * t1.x - x2b * t1.y) * 0.0625f);
                o2[e] = pk2((x1a * t0.y + x2a * t0.x) * 0.0625f, (x1b * t1.y + x2b * t1.x) * 0.0625f); }
            *(u32x4*)q1 = (u32x4){o1[0], o1[1], o1[2], o1[3]}; *(u32x4*)(q1 + 64) = (u32x4){o2[0], o2[1], o2[2], o2[3]};
            {
                const int bb = r / SEQ, hq = blk >> 1, d0 = (blk & 1) * 128 + i8, cc = s >> 7, ii = s & 127;
                bf16_t* QFp = (bf16_t*)(p.ws + WS_DV);
                *(u32x4*)(QFp + ret::qf_index(bb, hq, cc, ii >> 4, d0 >> 5, (d0 >> 3) & 3, ii & 15)) = (u32x4){o1[0], o1[1], o1[2], o1[3]};
                *(u32x4*)(QFp + ret::qf_index(bb, hq, cc, ii >> 4, (d0 >> 5) + 2, (d0 >> 3) & 3, ii & 15)) = (u32x4){o2[0], o2[1], o2[2], o2[3]};
            }
        }
#pragma unroll
        for (int which = 0; which < 2; ++which) {
            if (which == 0 && !lat) continue;
            const float* gq = which ? p.dk_g : p.dq_g;
            const int q4 = c.lane & 3; bf16_t* dp = pr + (which ? C_DK : C_DQ) + (c.lane >> 2) * 64 + q4 * 16;
            const u32x4 a = *(const u32x4*)dp, bq = *(const u32x4*)(dp + 8); const unsigned wv[8] = {a.x, a.y, a.z, a.w, bq.x, bq.y, bq.z, bq.w};
            float v[16]; float ss = 0.f;
#pragma unroll
            for (int e = 0; e < 8; ++e) { v[2 * e] = lo_f(wv[e]); v[2 * e + 1] = hi_f(wv[e]); ss += v[2 * e] * v[2 * e] + v[2 * e + 1] * v[2 * e + 1]; }
            ss += __shfl_xor(ss, 1); ss += __shfl_xor(ss, 2);
            const float rs = __builtin_amdgcn_rsqf(ss * (1.f / 64.f) + EPS) * (which ? 1.f : att::SCALE * LOG2E);
            const int pos = (q4 & 2) ? pcol : prow; unsigned ow[8]; float y[16];
#pragma unroll
            for (int e = 0; e < 16; ++e) y[e] = v[e] * rs * gq[q4 * 16 + e];
#pragma unroll
            for (int e = 0; e < 16; ++e) { const float other = __shfl_xor(y[e], 1); const float2 t = tabD[pos * 16 + e];
                y[e] = (q4 & 1) ? (other * t.y + y[e] * t.x) : (y[e] * t.x - other * t.y); }
#pragma unroll
            for (int e = 0; e < 8; ++e) ow[e] = pk2(y[2 * e], y[2 * e + 1]);
            *(u32x4*)dp = (u32x4){ow[0], ow[1], ow[2], ow[3]}; *(u32x4*)(dp + 8) = (u32x4){ow[4], ow[5], ow[6], ow[7]};
        }
    }
    bf16_t* KT = (bf16_t*)(p.ws + WS_KT); bf16_t* VT = (bf16_t*)(p.ws + WS_VT);
    bf16_t* Tl = (bf16_t*)c.lds;
    constexpr int TLD = 72;
    constexpr int NU = NB * 132 * 24;
    const int tok = c.tid >> 3, c8 = (c.tid & 7) * 8, wsw = (c.tid & 7) << 3;
    auto unit_src = [&](int u) { const int cb = u % 24, tb = (u / 24) % 132, b = u / (24 * 132); const int colbase = cb < 8 ? C_RK + cb * 128 : C_RV + (cb - 8) * 128;
        return P + ((size_t)b * SEQ + tb * 64 + tok) * NP + colbase + c8; };
    u32x4 a, bq;
    { bf16_t* s0 = unit_src(c.bid < NU ? c.bid : NU - 1); a = *(const u32x4*)s0; bq = *(const u32x4*)(s0 + 64); }
    for (int u = c.bid; u < NU; u += c.G) {
        const int cb = u % 24, tb = (u / 24) % 132, b = u / (24 * 132);
        const int s = tb * 64 + tok; const bool isk = cb < 8;
        bf16_t* src = unit_src(u);
        u32x4 an, bn; { const int un = u + c.G; bf16_t* sn = unit_src(un < NU ? un : NU - 1); an = *(const u32x4*)sn; bn = *(const u32x4*)(sn + 64); }
        if (isk) {
            const bool lat = s >= CTXL; const int tpos = lat ? s - CTXL : 0; const int pos = (cb & 1) ? (tpos & 63) : (tpos >> 6);
            const unsigned aw[4] = {a.x, a.y, a.z, a.w}, bw[4] = {bq.x, bq.y, bq.z, bq.w}; unsigned o1[4], o2[4];
#pragma unroll
            for (int e = 0; e < 4; ++e) { const float2 t0 = tabR[pos * 64 + c8 + 2 * e], t1 = tabR[pos * 64 + c8 + 2 * e + 1];
                const float x1a = lo_f(aw[e]), x1b = hi_f(aw[e]), x2a = lo_f(bw[e]), x2b = hi_f(bw[e]);
                o1[e] = pk2(x1a * t0.x - x2a * t0.y, x1b * t1.x - x2b * t1.y);
                o2[e] = pk2(x1a * t0.y + x2a * t0.x, x1b * t1.y + x2b * t1.x); }
            a = (u32x4){o1[0], o1[1], o1[2], o1[3]}; bq = (u32x4){o2[0], o2[1], o2[2], o2[3]};
            *(u32x4*)src = a; *(u32x4*)(src + 64) = bq;
        }
        { const unsigned aw[4] = {a.x, a.y, a.z, a.w}, bw[4] = {bq.x, bq.y, bq.z, bq.w}; const int tk = tok ^ wsw;
#pragma unroll
          for (int e = 0; e < 4; ++e) { Tl[(c8 + 2 * e) * TLD + tk] = (bf16_t)(aw[e] & 0xffffu); Tl[(c8 + 2 * e + 1) * TLD + tk] = (bf16_t)(aw[e] >> 16);
              Tl[(64 + c8 + 2 * e) * TLD + tk] = (bf16_t)(bw[e] & 0xffffu); Tl[(64 + c8 + 2 * e + 1) * TLD + tk] = (bf16_t)(bw[e] >> 16); } }
        LDS_BAR();
        if (isk) {
            const int col = c.tid & 127, tp = c.tid >> 7, sw = ((col >> 3) & 7) << 3; const u32x4 r0 = *(const u32x4*)(Tl + col * TLD + ((16 * tp) ^ sw)), r1 = *(const u32x4*)(Tl + col * TLD + ((16 * tp + 8) ^ sw));
            const int hk = cb >> 1, d = (cb & 1) * 128 + col, jb = (tb & 1) * 64 + 16 * tp;
            bf16_t* dst = KT + ret::ktf_index(b, hk, tb >> 1, d >> 5, jb >> 4, 0, d & 31);
            *(u32x4*)dst = r0; *(u32x4*)(dst + 32 * 8) = r1;
        } else {
          const int col = c.tid >> 2, t4 = (c.tid & 3) * 16, sw = ((col >> 3) & 7) << 3; const u32x4 r0 = *(const u32x4*)(Tl + col * TLD + (t4 ^ sw)), r1 = *(const u32x4*)(Tl + col * TLD + ((t4 + 8) ^ sw));
          bf16_t* dst = VT + ((size_t)b * 2048 + (cb - 8) * 128 + col) * SEQ + tb * 64 + t4;
          *(u32x4*)dst = r0; *(u32x4*)(dst + 8) = r1; }
        LDS_BAR();
        a = an; bq = bn;
    }
    __syncthreads();
}

DEVI int scan_map(int u, int G) { if (G != 256) return u; const int x = u & 7, j = u >> 3; return ((x + 8 * (j >> 4)) << 4) | (j & 15); }
DEVI void phase_mix(const Params& p, const Ctx& c) {
    const bf16_t* P = (const bf16_t*)(p.ws + WS_P); const bf16_t* KT = (const bf16_t*)(p.ws + WS_KT); const bf16_t* VT = (const bf16_t*)(p.ws + WS_VT);
    const float* scal = (const float*)(p.ws + WS_SCAL);
#ifndef MK_MIX_PROBE
#define MK_MIX_PROBE 0
#endif
#ifndef MK_MIX_ONLY
#define MK_MIX_ONLY 0
#endif
    const float lam = scal[8];
    const bool attn_first = (c.G == 256) && (c.bid >= 128);
#define MIX_RET() do { for (int u = c.bid; u < 256; u += c.G) ret::scan_unit(scan_map(u & 255, c.G), (const bf16_t*)(p.ws + WS_DV), KT, VT, (bf16_t*)(p.ws + WS_OF), (bf16_t*)(p.ws + WS_OB), scal, c.lds); \
        for (int u = c.bid; u < 512; u += c.G) ret::intra_unit(u & 511, P, VT, (bf16_t*)(p.ws + WS_OI), scal, c.lds); } while (0)
    if (!attn_first) MIX_RET();
    for (int a_ = c.bid; a_ < 1024; a_ += c.G) { const int a = a_ & 1023;
        const int rr = a / c.G, wq = a % c.G; int bh, qb;
        if (c.G == 256) { const int xcd = wq & 7, j = wq >> 3; bh = xcd * 2 + (rr >> 1); qb = (rr & 1) * 32 + j; } else { bh = a >> 6; qb = a & 63; }
        const int b = bh >> 3, h = bh & 7;
        const bf16_t* Qb = P + ((size_t)b * SEQ + CTXL + qb * 128) * NP + C_DQ + h * 128;
        const bf16_t* Kh = P + ((size_t)b * SEQ) * NP + C_DK + h * 128;
        const bf16_t* Vh = P + ((size_t)b * SEQ) * NP + C_DV + h * 128;
        bf16_t* Ob = (bf16_t*)(p.ws + WS_OD) + ((size_t)b * LSEQ + qb * 128) * 1024 + h * 128;
        att::attn_unit(Qb, Kh, Vh, Ob, lam, p.dn_g, c.lds);
    }
    if (attn_first) { __syncthreads(); MIX_RET(); }
#undef MIX_RET
}

DEVI void phase_retgate(const Params& p, const Ctx& c) {
    bf16_t* OI = (bf16_t*)(p.ws + WS_OI); const bf16_t* OF = (const bf16_t*)(p.ws + WS_OF); const bf16_t* OB = (const bf16_t*)(p.ws + WS_OB); const bf16_t* P = (const bf16_t*)(p.ws + WS_P);
    for (int it = c.gw; it < T * 4; it += c.NGW) {
        const int t = it >> 2, h = it & 3; const size_t off = (size_t)t * 2048 + h * 512 + c.lane * 8;
        const u32x4 a = *(const u32x4*)(OI + off), f = *(const u32x4*)(OF + off), bb = *(const u32x4*)(OB + off);
        const u32x4 rg = *(const u32x4*)(P + (size_t)rowc_of(t) * NP + C_RG + h * 512 + c.lane * 8);
        const unsigned aw[4] = {a.x, a.y, a.z, a.w}, fw[4] = {f.x, f.y, f.z, f.w}, bw[4] = {bb.x, bb.y, bb.z, bb.w}, gw_[4] = {rg.x, rg.y, rg.z, rg.w};
        float v[8]; float ss = 0.f;
#pragma unroll
        for (int e = 0; e < 4; ++e) { v[2 * e] = lo_f(aw[e]) + lo_f(fw[e]) + lo_f(bw[e]); v[2 * e + 1] = hi_f(aw[e]) + hi_f(fw[e]) + hi_f(bw[e]); ss += v[2 * e] * v[2 * e] + v[2 * e + 1] * v[2 * e + 1]; }
        const float rs = __builtin_amdgcn_rsqf(wave_sum(ss) * (1.f / 512.f) + EPS);
        const float* g = p.ret_norm_g + h * 512 + c.lane * 8; unsigned ow[4];
#pragma unroll
        for (int e = 0; e < 4; ++e) ow[e] = pk2(v[2 * e] * rs * g[2 * e] * siluf_(lo_f(gw_[e])), v[2 * e + 1] * rs * g[2 * e + 1] * siluf_(hi_f(gw_[e])));
        *(u32x4*)(OI + off) = (u32x4){ow[0], ow[1], ow[2], ow[3]};
    }
}

DEVI void phase_route(const Params& p, const Ctx& c) {
    constexpr int RW_LD = 1028;
    float* rwT = (float*)c.lds;
    for (int i = c.tid; i < 8 * 1024; i += 512) {
        const f32x4 w4 = ((const f32x4*)p.router_w)[i]; const int k = i >> 3, e0 = (i & 7) * 4;
        rwT[(e0 + 0) * RW_LD + k] = w4[0]; rwT[(e0 + 1) * RW_LD + k] = w4[1]; rwT[(e0 + 2) * RW_LD + k] = w4[2]; rwT[(e0 + 3) * RW_LD + k] = w4[3]; }
    __syncthreads();
    const float* mod = (const float*)(p.ws + WS_MOD); bf16_t* H2 = (bf16_t*)(p.ws + WS_HL);
    int* cnt = (int*)(p.ws + WS_CNT); int* ltok = (int*)(p.ws + WS_LTOK); float* lgate = (float*)(p.ws + WS_LGATE); int* pos = (int*)(p.ws + WS_POS);
    int2* stash = (int2*)(c.lds + 135168) + c.wave * 64; int* stok = (int*)(c.lds + 135168 + 8 * 64 * 8) + c.wave * 16; int nst = 0;
    for (int t = c.gw; t < T; t += c.NGW) {
        const int b = t >> 13; const float* mv = mod + b * 6144;
        const f32x4* xr = (const f32x4*)(p.out + (size_t)t * DM) + c.lane; f32x4 v[4]; float ss = 0.f;
#pragma unroll
        for (int j = 0; j < 4; ++j) { v[j] = xr[64 * j]; ss += (v[j][0] * v[j][0] + v[j][1] * v[j][1]) + (v[j][2] * v[j][2] + v[j][3] * v[j][3]); }
        const float rstd = __builtin_amdgcn_rsqf(wave_sum(ss) * (1.f / DM) + EPS);
        u32x2* o8 = (u32x2*)(H2 + (size_t)t * DM) + c.lane;
#pragma unroll
        for (int j = 0; j < 4; ++j) { const int k = 4 * c.lane + 256 * j;
            const f32x4 g = *(const f32x4*)(p.norm2_g + k), sh = *(const f32x4*)(mv + 3072 + k), sc = *(const f32x4*)(mv + 4096 + k);
            v[j] = (v[j] * rstd * g) * (sc + 1.f) + sh; u32x2 w; w.x = pk2(v[j][0], v[j][1]); w.y = pk2(v[j][2], v[j][3]); o8[64 * j] = w; }
        float a[32];
#pragma unroll
        for (int e = 0; e < 32; ++e) { float s = 0.f;
#pragma unroll
            for (int j = 0; j < 4; ++j) { const f32x4 wv = *(const f32x4*)(rwT + e * RW_LD + 4 * c.lane + 256 * j); s += (v[j][0] * wv[0] + v[j][1] * wv[1]) + (v[j][2] * wv[2] + v[j][3] * wv[3]); }
            a[e] = s; if ((e & 3) == 3) __builtin_amdgcn_sched_barrier(0); }
#define HALVE(N, OFF) _Pragma("unroll") for (int i = 0; i < (N) / 2; ++i) { const bool up = (c.lane & (OFF)) != 0; const float snd = up ? a[i] : a[i + (N) / 2]; const float rcv = __shfl_xor(snd, (OFF)); a[i] = (up ? a[i + (N) / 2] : a[i]) + rcv; }
        HALVE(32, 32) HALVE(16, 16) HALVE(8, 8) HALVE(4, 4) HALVE(2, 2)
#undef HALVE
        float logit = a[0] + __shfl_xor(a[0], 1); const int myE = c.lane >> 1; logit += p.router_b[myE];
        float tv[4]; int ti[4]; float cur = logit;
#pragma unroll
        for (int k = 0; k < 4; ++k) { float bv = cur; int bi = myE;
#pragma unroll
            for (int o = 1; o < 64; o <<= 1) { const float ov = __shfl_xor(bv, o); const int oi = __shfl_xor(bi, o); if (ov > bv || (ov == bv && oi < bi)) { bv = ov; bi = oi; } }
            tv[k] = bv; ti[k] = bi; if (myE == bi) cur = -3.0e38f; }
        const float e1 = __expf(tv[1] - tv[0]), e2 = __expf(tv[2] - tv[0]), e3 = __expf(tv[3] - tv[0]); const float inv = 1.f / (1.f + e1 + e2 + e3);
        if (c.lane < 4) { const int k = c.lane; const int e = k == 0 ? ti[0] : (k == 1 ? ti[1] : (k == 2 ? ti[2] : ti[3])); const float g = (k == 0 ? 1.f : (k == 1 ? e1 : (k == 2 ? e2 : e3))) * inv;
            stash[nst * 4 + k] = make_int2(e, __float_as_int(g)); }
        if (c.lane == 0) stok[nst] = t;
        ++nst;
        if (nst == 16 || t + c.NGW >= T) {
            asm volatile("s_waitcnt lgkmcnt(0)" ::: "memory");
            if (c.lane < nst * 4) { const int2 eg = stash[c.lane]; const int tt = stok[c.lane >> 2], e = eg.x;
                const int slot = atomicAdd(cnt + e, 1); ltok[e * CAP + slot] = tt; lgate[e * CAP + slot] = __int_as_float(eg.y); pos[tt * 4 + (c.lane & 3)] = e * CAP + slot; }
            asm volatile("s_waitcnt lgkmcnt(0)" ::: "memory");
            nst = 0; }
    }
    __syncthreads();
}

DEVI int build_tiles(const Params& p, const Ctx& c) {
    LAS int* tb = (LAS int*)(c.lds + LDS_TAB);
    const int* cnt = (const int*)(p.ws + WS_CNT);
    if (c.tid < 32) tb[576 + c.tid] = cnt[c.tid];
    __syncthreads();
    if (c.tid < 32) {
        const int e = c.tid; int base = 0, tot = 0;
        for (int j = 0; j < 32; ++j) { const int nj = (tb[576 + j] + 255) >> 8; base += j < e ? nj : 0; tot += nj; }
        const int n = (tb[576 + e] + 255) >> 8; tb[608 + e] = base;
        for (int i = 0; i < n; ++i) { tb[base + i] = e; tb[288 + base + i] = i * 256; }
        if (e == 0) tb[640] = tot; }
    __syncthreads();
    return tb[640];
}

DEVI void phase_combine(const Params& p, const Ctx& c) {
    const int NT = build_tiles(p, c); (void)NT;
    const int lane = lane_id_fresh();
    LAS int* tb = (LAS int*)(c.lds + LDS_TAB);
    const float* mod = (const float*)(p.ws + WS_MOD); const int* pos = (const int*)(p.ws + WS_POS); const bf16_t* Y = (const bf16_t*)(p.ws + WS_Y);
    for (int t = c.gw; t < T; t += c.NGW) {
        const int b = t >> 13; size_t yr[4];
#pragma unroll
        for (int k = 0; k < 4; ++k) { const int pp = pos[t * 4 + k]; const int e = pp >> 14, slot = pp & (CAP - 1); yr[k] = (size_t)(tb[608 + e] * 256 + slot) * 1024; }
        float* orow = p.out + (size_t)t * DM;
#pragma unroll
        for (int j = 0; j < 2; ++j) { const int k0 = lane * 8 + 512 * j; float s[8] = {0.f, 0.f, 0.f, 0.f, 0.f, 0.f, 0.f, 0.f};
#pragma unroll
            for (int k = 0; k < 4; ++k) { const u32x4 y = *(const u32x4*)(Y + yr[k] + k0); s[0] += lo_f(y.x); s[1] += hi_f(y.x); s[2] += lo_f(y.y); s[3] += hi_f(y.y); s[4] += lo_f(y.z); s[5] += hi_f(y.z); s[6] += lo_f(y.w); s[7] += hi_f(y.w); }
            const float* gp = mod + b * 6144 + 5120 + k0;
            f32x4 x0 = *(const f32x4*)(orow + k0), x1 = *(const f32x4*)(orow + k0 + 4);
            const f32x4 g0 = *(const f32x4*)gp, g1 = *(const f32x4*)(gp + 4);
            x0 += g0 * (f32x4){s[0], s[1], s[2], s[3]}; x1 += g1 * (f32x4){s[4], s[5], s[6], s[7]};
            *(f32x4*)(orow + k0) = x0; *(f32x4*)(orow + k0 + 4) = x1; }
    }
}

__global__ void __launch_bounds__(512, 2) mk_fwd(Params p) {
    extern __shared__ __attribute__((aligned(16))) unsigned char lds_raw[];
    Ctx c; c.tid = threadIdx.x; c.lane = c.tid & 63; c.wave = __builtin_amdgcn_readfirstlane(c.tid >> 6); c.G = gridDim.x; c.bid = blockIdx.x;
    c.gw = c.bid * 8 + c.wave; c.NGW = c.G * 8; c.lds = (char*)lds_raw;
    LAS unsigned char* lds = (LAS unsigned char*)lds_raw;
    unsigned char* ws = p.ws;
    const int lo = p.ph_lo, hi = p.ph_hi;
#define IN(k) (lo <= (k) && (k) < hi)
#ifndef MK_REPEAT_PHASE
#define MK_REPEAT_PHASE (-1)
#define MK_REPEAT_N 0
#endif
#define REPS(k)
    volatile LAS unsigned* bst = (volatile LAS unsigned*)(lds + LDS_BYTES - 16);
    if (c.tid < 4) bst[c.tid] = 0u;
    __syncthreads();
    if (lo == 0 && hi == NPH) {
        { const int i = c.bid * 512 + c.tid; if (i < (int)(WS_ZERO_BYTES / 4)) { ((unsigned*)ws)[i] = 0u; __threadfence(); } }
        cg::this_grid().sync();
    }
    XcdBarrier xbar = xcd_barrier_post((unsigned*)(ws + WS_BAR), bst);
#define SEAM(k) do { if (IN(k) && IN((k) + 1)) xcd_barrier(xbar); } while (0)
#define PH0 { phase_prep(p, c); }
#define PH1 { phase_hl(p, c); }
#define PH2 { const int ncv = pg8::conv_count((TT / 256) * (NP / 256), c.G); \
        if (c.bid < c.G - ncv) { pg8::ProbDense S; S.init(ws + WS_HL, ws + WS_WIN, TT, NP, 1024, c.G, c.bid, ncv); EpiStoreBf16 E{(bf16_t*)(ws + WS_P), NP}; pg8::gemm_phase(lds, S, E); \
            if (c.tid == 0) atomicAdd((int*)(ws + WS_Q) + 128, 1); conv_run(p, c, 0, true, false); } \
        else { conv_run(p, c, 0, false, false); conv_run(p, c, 1, false, true); } }
#define PH3 { phase_post(p, c); }
#define PH4 { phase_mix(p, c); }
#define PH5 { phase_retgate(p, c); }
#define PH6 { { pg8::ProbDense S; S.init(ws + WS_OI, ws + WS_WBR, T, 1024, 2048, c.G, c.bid); EpiGate1 E{(float*)(ws + WS_OF), (const bf16_t*)(ws + WS_P)}; pg8::gemm_phase(lds, S, E); } \
        __syncthreads(); \
        { pg8::ProbDense S; S.init(ws + WS_OD, ws + WS_WBD, T, 1024, 1024, c.G, c.bid); EpiGate2 E{(const float*)(ws + WS_OF), (bf16_t*)(ws + WS_OB), (const bf16_t*)(ws + WS_P)}; pg8::gemm_phase(lds, S, E); } }
#define PH7 { pg8::ProbDense S; S.init(ws + WS_OB, ws + WS_WOUT, T, 1024, 1024, c.G, c.bid); EpiResid E{p.x, p.out, (const float*)(ws + WS_MOD)}; pg8::gemm_phase(lds, S, E); }
#define PH8 { phase_route(p, c); }
#define PH9 { const int NT = build_tiles(p, c); LAS int* tb = (LAS int*)(c.lds + LDS_TAB); \
        const int ncv = pg8::conv_count(NT * 8, c.G); \
        if (c.bid < c.G - ncv) { pg8::ProbMoe S; S.A = (const char*)(ws + WS_HL); S.Bt = (const char*)(ws + WS_W1); S.K = 1024; S.nN = 8; S.NT = NT; S.G = c.G; S.c = c.bid; S.nconv = ncv; S.bstride = (size_t)2048 * 1024 * 2; \
            S.tile_e = tb; S.tile_s0 = tb + 288; S.cnt = tb + 576; S.ltok = (const int*)(ws + WS_LTOK); S.gather = true; \
            EpiSwiglu E{(bf16_t*)(ws + WS_ACT), p.b1}; pg8::gemm_phase(lds, S, E); } \
        conv_run(p, c, 1, c.bid < c.G - ncv, false); }
#define PH10 { const int NT = build_tiles(p, c); LAS int* tb = (LAS int*)(c.lds + LDS_TAB); \
        pg8::ProbMoe S; S.A = (const char*)(ws + WS_ACT); S.Bt = (const char*)(ws + WS_W2); S.K = 1024; S.nN = 4; S.NT = NT; S.G = c.G; S.c = c.bid; S.nconv = 0; S.bstride = (size_t)1024 * 1024 * 2; \
        S.tile_e = tb; S.tile_s0 = tb + 288; S.cnt = tb + 576; S.ltok = (const int*)(ws + WS_LTOK); S.gather = false; \
        EpiMoe2 E{(bf16_t*)(ws + WS_Y), p.b2, (const float*)(ws + WS_LGATE), tb + 288, tb + 576}; pg8::gemm_phase(lds, S, E); }
#define PH11 { phase_combine(p, c); }
#ifndef MK_DUP
#define MK_DUP (-1)
#endif
#ifndef MK_ONLY
#define MK_ONLY (-1)
#endif
#define RUN(k, BODY) do { if ((MK_ONLY < 0 || MK_ONLY == (k)) && IN(k)) { BODY if (MK_DUP == (k)) { xcd_barrier(xbar); BODY } } SEAM(k); } while (0)
    RUN(0, PH0); RUN(1, PH1); RUN(2, PH2); RUN(3, PH3);
    if (MK_DUP == 23 && IN(3)) { PH2 xcd_barrier(xbar); PH3 xcd_barrier(xbar); }
    RUN(4, PH4); RUN(5, PH5); RUN(6, PH6); RUN(7, PH7); RUN(8, PH8); RUN(9, PH9); RUN(10, PH10);
    if ((MK_ONLY < 0 || MK_ONLY == 11) && IN(11)) PH11
#undef IN
#undef SEAM
}


extern "C" void kernel_launch(void* const* d_in, const int* in_sizes, int n_in, void* d_out, int out_size, void* d_ws, size_t ws_size, hipStream_t stream) {
    static int grid = 0;
    if (grid == 0) {
        if (n_in != 24 || ws_size < WS_END) { fprintf(stderr, "kernel_launch: unexpected inputs (n_in %d, ws %zu, need %zu)\n", n_in, ws_size, (size_t)WS_END); grid = -1; return; }
        int dev = 0, cus = 0, per_cu = 0;
        (void)hipGetDevice(&dev); (void)hipDeviceGetAttribute(&cus, hipDeviceAttributeMultiprocessorCount, dev);
        if (hipFuncSetAttribute((const void*)mk_fwd, hipFuncAttributeMaxDynamicSharedMemorySize, LDS_BYTES) != hipSuccess) { fprintf(stderr, "kernel_launch: hipFuncSetAttribute failed\n"); grid = -1; return; }
        if (hipOccupancyMaxActiveBlocksPerMultiprocessor(&per_cu, (const void*)mk_fwd, 512, LDS_BYTES) != hipSuccess || per_cu < 1) { fprintf(stderr, "kernel_launch: occupancy query says %d\n", per_cu); per_cu = 1; }
        (void)hipGetLastError();
        grid = cus;
    }
    if (grid < 0) return;
#if !MK_ONE_LAUNCH
    (void)hipMemsetAsync((char*)d_ws, 0, WS_ZERO_BYTES, stream);
#endif
    Params p{};
    const float** pp = (const float**)&p;
    for (int i = 0; i < 24; ++i) pp[i] = (const float*)d_in[i];
    p.out = (float*)d_out; p.ws = (unsigned char*)d_ws;
#if MK_ONE_LAUNCH
    p.ph_lo = 0; p.ph_hi = NPH;
    void* args[] = {&p};
    hipError_t e = hipLaunchCooperativeKernel((const void*)mk_fwd, dim3(grid), dim3(512), args, LDS_BYTES, stream);
    if (e != hipSuccess) fprintf(stderr, "cooperative launch failed: %s (grid %d)\n", hipGetErrorString(e), grid);
#else
#ifndef MK_LAST_PHASE
#define MK_LAST_PHASE (NPH - 1)
#endif
    for (int ph = 0; ph <= MK_LAST_PHASE; ++ph) {
        p.ph_lo = ph; p.ph_hi = ph + 1;
        hipLaunchKernelGGL(mk_fwd, dim3(grid), dim3(512), LDS_BYTES, stream, p);
    }

#endif
}
```

```cpp
#include <hip/hip_runtime.h>
#include <hip/hip_cooperative_groups.h>
#include <cstdio>
#include <cstdint>
namespace cg = cooperative_groups;

#ifndef MK_ONE_LAUNCH
#define MK_ONE_LAUNCH 1
#endif

#define DEVI __device__ __forceinline__
#define LAS __attribute__((address_space(3)))
typedef unsigned short bf16_t;
typedef short bf16x8 __attribute__((ext_vector_type(8)));
typedef short s16x4 __attribute__((ext_vector_type(4)));
typedef float f32x4 __attribute__((ext_vector_type(4)));
typedef float f32x16 __attribute__((ext_vector_type(16)));
typedef unsigned u32x4 __attribute__((ext_vector_type(4)));
typedef unsigned u32x2 __attribute__((ext_vector_type(2)));

constexpr int NB = 2, LSEQ = 8192, CTXL = 256, SEQ = LSEQ + CTXL;
constexpr int T = NB * LSEQ;
constexpr int TT = NB * SEQ;
constexpr int DM = 1024, NP = 11264;
constexpr int C_RQ = 0, C_RK = 1024, C_RV = 2048, C_RG = 4096, C_DQ = 6144, C_DK = 7168, C_DV = 8192, C_GA = 9216, C_GB = 10240;
constexpr int NE = 32, CAP = 16384, MAXTILES = 288;
constexpr float EPS = 1e-6f;
constexpr float LOG2E = 1.4426950408889634f;

constexpr size_t al256(size_t x) { return (x + 255) / 256 * 256; }
constexpr size_t WS_CNT = 0;
constexpr size_t WS_Q = 1024;
constexpr size_t WS_BAR = 4096;
constexpr size_t WS_ZERO_BYTES = 4096 + 16384;
constexpr size_t WS_MOD = WS_ZERO_BYTES;
constexpr size_t WS_SCAL = al256(WS_MOD + 3 * 6144 * 4);
constexpr size_t WS_TABR = WS_SCAL + 256;
constexpr size_t WS_TABD = WS_TABR + 128 * 64 * 8;
constexpr size_t WS_WIN = al256(WS_TABD + 128 * 16 * 8);
constexpr size_t WS_WBR = WS_WIN + (size_t)NP * DM * 2;
constexpr size_t WS_WBD = WS_WBR + (size_t)1024 * 2048 * 2;
constexpr size_t WS_WOUT = WS_WBD + (size_t)1024 * 1024 * 2;
constexpr size_t WS_W1 = WS_WOUT + (size_t)1024 * 1024 * 2;
constexpr size_t WS_W2 = WS_W1 + (size_t)NE * 2048 * 1024 * 2;
constexpr size_t WS_HL = WS_W2 + (size_t)NE * 1024 * 1024 * 2;
constexpr size_t WS_P = WS_HL + (size_t)TT * DM * 2;
constexpr size_t WS_KT = WS_P + (size_t)TT * NP * 2;
constexpr size_t WS_VT = WS_KT + (size_t)NB * 1024 * SEQ * 2;
constexpr size_t WS_OI = WS_VT + (size_t)NB * 2048 * SEQ * 2;
constexpr size_t WS_OF = WS_OI + (size_t)T * 2048 * 2;
constexpr size_t WS_OB = WS_OF + (size_t)T * 2048 * 2;
constexpr size_t WS_OD = WS_OB + (size_t)T * 2048 * 2;
constexpr size_t WS_LTOK = WS_OD + (size_t)T * 1024 * 2;
constexpr size_t WS_LGATE = WS_LTOK + (size_t)NE * CAP * 4;
constexpr size_t WS_POS = WS_LGATE + (size_t)NE * CAP * 4;
constexpr size_t WS_DV = WS_POS + (size_t)T * 4 * 4;
constexpr size_t WS_DUMMY = WS_DV + (size_t)NB * 8 * SEQ * 128 * 2;
constexpr size_t WS_END = WS_DUMMY + (size_t)128 * 2048 * 2;
constexpr size_t WS_ACT = WS_P;
constexpr size_t WS_Y = WS_P + (size_t)MAXTILES * 256 * 1024 * 2;
static_assert(WS_Y + (size_t)MAXTILES * 256 * 1024 * 2 <= WS_KT, "act/y overlay must fit in P");
static_assert(WS_END <= ((size_t)1 << 30), "workspace must fit 1 GiB");

struct Params {
    const float *x, *c, *ctx, *c_ctx, *norm1_g, *norm2_g, *w_mod, *b_mod, *w_in, *ret_decay, *ret_norm_g, *dq_g, *dk_g, *dlam, *dn_g,
        *w_br_ret, *w_br_diff, *w_out, *router_w, *router_b, *w1, *b1, *w2, *b2;
    float* out; unsigned char* ws;
    int ph_lo, ph_hi;
};

DEVI float bf2f(unsigned u) { return __uint_as_float(u << 16); }
DEVI unsigned f2bf(float f) { unsigned u = __float_as_uint(f); return (u + 0x7fffu + ((u >> 16) & 1u)) >> 16; }
typedef __bf16 bf16x2_t __attribute__((ext_vector_type(2)));
typedef float f32x2_t __attribute__((ext_vector_type(2)));
DEVI unsigned pk2(float lo, float hi) { const f32x2_t v = {lo, hi}; const bf16x2_t b = __builtin_convertvector(v, bf16x2_t); return __builtin_bit_cast(unsigned, b); }
DEVI unsigned pk2a(float lo, float hi) { unsigned r; asm volatile("v_cvt_pk_bf16_f32 %0, %1, %2" : "=v"(r) : "v"(lo), "v"(hi)); return r; }
DEVI float lo_f(unsigned w) { return __uint_as_float(w << 16); }
DEVI float hi_f(unsigned w) { return __uint_as_float(w & 0xffff0000u); }
DEVI float wave_sum(float v) {
#pragma unroll
    for (int o = 1; o < 64; o <<= 1) v += __shfl_xor(v, o);
    return v;
}
DEVI int lane_id_fresh() { int l; asm volatile("v_mbcnt_lo_u32_b32 %0, -1, 0\n\tv_mbcnt_hi_u32_b32 %0, -1, %0" : "=v"(l)); return l; }
DEVI float sigmoidf_(float x) { return __builtin_amdgcn_rcpf(1.f + __builtin_amdgcn_exp2f(-x * LOG2E)); }
DEVI float siluf_(float x) { return x * sigmoidf_(x); }
#define LDS_WAIT() asm volatile("s_waitcnt lgkmcnt(0)" ::: "memory")
#define VM_WAIT() asm volatile("s_waitcnt vmcnt(0)" ::: "memory")


#define XB_TMO      128
#define XB_XCNT(j)  (256  + 64 * (j))
#define XB_XSUB(j)  (1280 + 64 * (j))
#define XB_XGEN(j)  (2304 + 64 * (j))
#define XB_TOP      3328
#define XB_TOPGEN   3392
#define XCD_BAR_WORDS 3456
#define XB_SPIN_CAP (1u << 18)
DEVI unsigned xb_ld(unsigned* p)              { return __hip_atomic_load(p, __ATOMIC_RELAXED, __HIP_MEMORY_SCOPE_AGENT); }
DEVI unsigned xb_add(unsigned* p, unsigned v) { return __hip_atomic_fetch_add(p, v, __ATOMIC_RELAXED, __HIP_MEMORY_SCOPE_AGENT); }
DEVI unsigned xb_xcc_id() { return (unsigned)__builtin_amdgcn_s_getreg((3 << 11) | 20) & 0xFu; }
#define XB_SPIN(cond, bar) do { unsigned _sp = 0; while (cond) { __builtin_amdgcn_s_sleep(1); \
    if ((++_sp & 255u) == 0u) { if (xb_ld(&(bar)[XB_TMO])) break; if (_sp > XB_SPIN_CAP) { atomicAdd(&(bar)[XB_TMO], 1u); break; } } } } while (0)
struct XcdBarrier { unsigned* bar; unsigned x; volatile LAS unsigned* st; };
DEVI XcdBarrier xcd_barrier_post(unsigned* bar, volatile LAS unsigned* st) {
    XcdBarrier b; b.bar = bar; b.x = xb_xcc_id(); b.st = st;
    if (threadIdx.x == 0) (void)xb_add(&bar[XB_XCNT(b.x)], 1u);
    return b;
}
DEVI void xcd_barrier_complete(unsigned* bar, unsigned x, unsigned& nloc, unsigned& nx) {
    const unsigned G = gridDim.x * gridDim.y * gridDim.z;
    unsigned sum, cnt, mine, sp = 0u;
    for (;;) {
        sum = 0u; cnt = 0u; mine = 0u;
#pragma unroll
        for (unsigned j = 0; j < 16; ++j) { const unsigned c = xb_ld(&bar[XB_XCNT(j)]); sum += c; cnt += (c > 0u) ? 1u : 0u; mine = (j == x) ? c : mine; }
        if (sum == G) break;
        __builtin_amdgcn_s_sleep(1);
        if ((++sp & 255u) == 0u) { if (xb_ld(&bar[XB_TMO])) break; if (sp > XB_SPIN_CAP) { atomicAdd(&bar[XB_TMO], 1u); break; } }
    }
    nloc = mine > 0u ? mine : 1u; nx = cnt > 0u ? cnt : 1u;
}
DEVI void xcd_barrier(const XcdBarrier& b) {
    asm volatile("s_waitcnt vmcnt(0)" ::: "memory");
    __syncthreads();
    if (threadIdx.x == 0) {
        unsigned* bar = b.bar;
        __builtin_amdgcn_s_waitcnt(0);
        unsigned nloc = b.st[0], nx = b.st[1];
        if (nloc == 0u) { xcd_barrier_complete(bar, b.x, nloc, nx); b.st[0] = nloc; b.st[1] = nx; }
        const unsigned old = xb_add(&bar[XB_XSUB(b.x)], 1u);
        const unsigned gen = old / nloc;
        if (old + 1u == (gen + 1u) * nloc) {
            __builtin_amdgcn_fence(__ATOMIC_RELEASE, "agent");
            asm volatile("s_waitcnt vmcnt(0)" ::: "memory");
            const unsigned og = xb_add(&bar[XB_TOP], 1u);
            const unsigned tg = og / nx;
            if (og + 1u == (tg + 1u) * nx) xb_add(&bar[XB_TOPGEN], 1u);
            else XB_SPIN(xb_ld(&bar[XB_TOPGEN]) == tg, bar);
            __builtin_amdgcn_fence(__ATOMIC_ACQUIRE, "agent");
            xb_add(&bar[XB_XGEN(b.x)], 1u);
            asm volatile("s_waitcnt vmcnt(0)" ::: "memory");
        } else {
            XB_SPIN(xb_ld(&bar[XB_XGEN(b.x)]) == gen, bar);
            __builtin_amdgcn_fence(__ATOMIC_ACQUIRE, "agent");
            asm volatile("s_waitcnt vmcnt(0)" ::: "memory");
        }
    }
    __syncthreads();
}

namespace pg8 {
constexpr int BM = 256, BK = 64, HALF = 128, HTB = HALF * BK * 2, STAGE_BYTES = 8 * HTB, NXCD = 8, WGM = 8;
__host__ __device__ __forceinline__ int lds_byte(int r, int c) { const int st = (r >> 4) * 2 + (c >> 5), rr = r & 15, cc = c & 31, ob = rr * 64 + cc * 2; return st * 1024 + (ob ^ (((ob >> 9) & 1) << 5)); }
__host__ __device__ __forceinline__ void stage_rc(int b, int& R, int& C) { const int st = b / 1024, sb = b % 1024, swz = sb ^ (((sb >> 9) & 1) << 5); R = (st >> 1) * 16 + swz / 64; C = (st & 1) * 32 + (swz % 64) / 2; }
__host__ __device__ __forceinline__ int perm32(int rho) { const int n = rho >> 4, i = rho & 15; return 8 * (i >> 2) + 4 * n + (i & 3); }
struct Unit { int pm, pn, g; };

DEVI int conv_count(int units, int G) { const int Rf = units / G, rem = units - Rf * G; return rem ? (G - rem) / (Rf + 1) : 0; }
DEVI bool adopt(int units, int G, int c, int nconv, int i, long& L) {
    const int Rf = units / G, rem = units - Rf * G;
    if (i > Rf) return false;
    if (i == Rf && c >= rem) { const int j = c - rem; if (j >= nconv * Rf) return false; L = (long)(j / nconv) * G + (G - nconv) + (j % nconv); }
    return true;
}
struct ProbDense {
    const char* A; const char* Bt; int K, nM, nN, nwg, G, c, nconv;
    DEVI void init(const void* A_, const void* Bt_, int M, int N, int K_, int G_, int c_, int nconv_ = 0) { A = (const char*)A_; Bt = (const char*)Bt_; K = K_; nM = M / BM; nN = N / BM; nwg = nM * nN; G = G_; c = c_; nconv = nconv_; }
    DEVI bool next(int i, Unit& u) const {
        long L = (long)i * G + c;
        if (nconv) { if (!adopt(nwg, G, c, nconv, i, L)) return false; }
        if (L >= nwg) return false;
        int wgid = (int)L; { const int q = nwg / NXCD, r = nwg % NXCD, xcd = wgid % NXCD, off = wgid / NXCD; wgid = (xcd < r ? xcd * (q + 1) : r * (q + 1) + (xcd - r) * q) + off; }
        const int nig = WGM * nN, gid = wgid / nig, fm = gid * WGM, gsz = (nM - fm) < WGM ? (nM - fm) : WGM;
        u.pm = fm + ((wgid % nig) % gsz); u.pn = (wgid % nig) / gsz; u.g = 0; return true;
    }
    DEVI void a_offs(const Unit& u, const int (&R)[2], const int (&C)[2], unsigned (&va)[2][2]) const {
#pragma unroll
        for (int h = 0; h < 2; ++h)
#pragma unroll
            for (int i = 0; i < 2; ++i) va[h][i] = (unsigned)(((u.pm * BM + h * HALF + R[i]) * K + C[i]) * 2);
    }
    DEVI const char* b_base(const Unit& u) const { return Bt + (size_t)u.pn * BM * K * 2; }
};

struct ProbMoe {
    const char* A; const char* Bt; int K, nN, NT, G, c, nconv; size_t bstride;
    const LAS int* tile_e; const LAS int* tile_s0; const LAS int* cnt; const int* ltok; bool gather;
    DEVI bool next(int i, Unit& u) const {
        long Ll = (long)i * G + c;
        if (nconv) { if (!adopt(NT * nN, G, c, nconv, i, Ll)) return false; }
        const int L = (int)Ll; const int tile = L / nN; if (tile >= NT) return false;
        u.pm = tile; u.pn = L % nN; u.g = tile_e[tile]; return true;
    }
    DEVI void a_offs(const Unit& u, const int (&R)[2], const int (&C)[2], unsigned (&va)[2][2]) const {
        const int s0 = tile_s0[u.pm], n = cnt[u.g];
#pragma unroll
        for (int h = 0; h < 2; ++h)
#pragma unroll
            for (int i = 0; i < 2; ++i) {
                int row;
                if (gather) { const int slot = s0 + h * HALF + R[i]; row = (slot < n) ? ltok[u.g * CAP + slot] : 0; }
                else row = u.pm * BM + h * HALF + R[i];
                va[h][i] = (unsigned)((row * K + C[i]) * 2);
            }
    }
    DEVI const char* b_base(const Unit& u) const { return Bt + (size_t)u.g * bstride + (size_t)u.pn * BM * K * 2; }
};

template <class Prob, class Epi>
DEVI void gemm_phase(LAS unsigned char* lds, const Prob& S, const Epi& E) {
    const int tid = threadIdx.x, wid = __builtin_amdgcn_readfirstlane(tid >> 6), lane = tid & 63, wr = wid >> 2, wc = wid & 3, fr = lane & 15, fq = lane >> 4;
    const int K = S.K, nt = K / BK;
    int Rs[2], Cs[2]; unsigned voffB[2];
#pragma unroll
    for (int i = 0; i < 2; ++i) { int R, C; stage_rc(tid * 16 + i * 8192, R, C); Rs[i] = R; Cs[i] = C; const int Rb = (R & ~31) + perm32(R & 31); voffB[i] = (unsigned)(Rb * K + C) * 2u; }
    const size_t kstep = (size_t)(BK * 2);
    const size_t hstep = (size_t)HALF * K * 2;
    const unsigned ldsw = (unsigned)wid * 1024u;
    const int aoff = lds_byte(wr * 64 + fr, fq * 8), boff = lds_byte(wc * 32 + fr, fq * 8);
#define PG8_SA(b, h) (((b) * 2 + (h)) * HTB)
#define PG8_SB(b, h) ((4 + (b) * 2 + (h)) * HTB)
#define PG8_STAGE(bufoff, gbase, voff) do { _Pragma("unroll") for (int _i = 0; _i < 2; ++_i) \
        __builtin_amdgcn_global_load_lds((const unsigned*)((const char*)(gbase) + (voff)[_i]), (LAS unsigned*)(lds + (bufoff) + ldsw + _i * 8192), 16, 0, 0); } while (0)
#define PG8_LDA(dst, b, h) do { _Pragma("unroll") for (int m = 0; m < 4; ++m) _Pragma("unroll") for (int k = 0; k < 2; ++k) dst[m][k] = *(const LAS bf16x8*)(lds + PG8_SA(b, h) + aoff + m * 2048 + k * 1024); } while (0)
#define PG8_LDB(dst, b, h) do { _Pragma("unroll") for (int n = 0; n < 2; ++n) _Pragma("unroll") for (int k = 0; k < 2; ++k) dst[n][k] = *(const LAS bf16x8*)(lds + PG8_SB(b, h) + boff + n * 2048 + k * 1024); } while (0)
#define PG8_MMA(ai, bj, At, Bt) do { __builtin_amdgcn_s_setprio(1); _Pragma("unroll") for (int m = 0; m < 4; ++m) _Pragma("unroll") for (int n = 0; n < 2; ++n) _Pragma("unroll") for (int k = 0; k < 2; ++k) \
        acc[ai][bj][m][n] = __builtin_amdgcn_mfma_f32_16x16x32_bf16(Bt[n][k], At[m][k], acc[ai][bj][m][n], 0, 0, 0); __builtin_amdgcn_s_setprio(0); } while (0)
#define PG8_WAIT_V(n) asm volatile("s_waitcnt vmcnt(" #n ")" ::: "memory")
#define PG8_WAIT_L(n) asm volatile("s_waitcnt lgkmcnt(" #n ")" ::: "memory")
#define PG8_BAR __builtin_amdgcn_s_barrier()
#define PG8_SCHED __builtin_amdgcn_sched_barrier(0)
    Unit cur, nxt; int ui = 0;
    if (!S.next(0, cur)) return;
    f32x4 acc[2][2][4][2];
#pragma unroll
    for (int a = 0; a < 2; ++a)
#pragma unroll
        for (int b = 0; b < 2; ++b)
#pragma unroll
            for (int m = 0; m < 4; ++m)
#pragma unroll
                for (int n = 0; n < 2; ++n) acc[a][b][m][n] = (f32x4){0.f, 0.f, 0.f, 0.f};
    bf16x8 At[4][2], B0[2][2], B1[2][2];
    unsigned va[2][2], nva[2][2];
    S.a_offs(cur, Rs, Cs, va);
    const char* cB = S.b_base(cur);
    const char* A0 = S.A;
    PG8_STAGE(PG8_SB(0, 0), cB, voffB); PG8_STAGE(PG8_SB(0, 1), cB + hstep, voffB); PG8_STAGE(PG8_SA(0, 0), A0, va[0]); PG8_STAGE(PG8_SA(0, 1), A0, va[1]);
    if (wr == 1) PG8_BAR;
    PG8_WAIT_V(2); PG8_BAR;
    PG8_STAGE(PG8_SB(1, 0), cB + kstep, voffB); PG8_STAGE(PG8_SA(1, 0), A0 + kstep, va[0]); PG8_STAGE(PG8_SB(1, 1), cB + hstep + kstep, voffB);
    PG8_WAIT_V(6); PG8_BAR;
    for (;;) {
        const bool has_next = S.next(ui + 1, nxt);
        const char* nB = cB;
#pragma unroll
        for (int h = 0; h < 2; ++h)
#pragma unroll
            for (int i = 0; i < 2; ++i) nva[h][i] = va[h][i];
        if (has_next) { S.a_offs(nxt, Rs, Cs, nva); nB = S.b_base(nxt); }
        for (int t = 0; t < nt; t += 2) {
            const bool last = (t == nt - 2);
            const char* a1 = A0 + (size_t)(t + 1) * kstep;
            const char* a2 = last ? A0 : A0 + (size_t)(t + 2) * kstep; const char* b2 = last ? nB : cB + (size_t)(t + 2) * kstep;
            const char* a3 = a2 + kstep; const char* b3 = b2 + kstep;
            unsigned v2[2][2];
#pragma unroll
            for (int h = 0; h < 2; ++h)
#pragma unroll
                for (int i = 0; i < 2; ++i) v2[h][i] = last ? nva[h][i] : va[h][i];
            PG8_LDB(B0, 0, 0); PG8_LDB(B1, 0, 1); PG8_SCHED; PG8_LDA(At, 0, 0); PG8_STAGE(PG8_SA(1, 1), a1, va[1]);
            PG8_WAIT_V(8); PG8_WAIT_L(0); PG8_BAR; PG8_MMA(0, 0, At, B0); PG8_MMA(0, 1, At, B1); PG8_BAR; PG8_SCHED;
            PG8_LDA(At, 0, 1); PG8_STAGE(PG8_SB(0, 0), b2, voffB); PG8_STAGE(PG8_SB(0, 1), b2 + hstep, voffB); PG8_STAGE(PG8_SA(0, 0), a2, v2[0]);
            PG8_WAIT_V(8); PG8_WAIT_L(0); PG8_BAR; PG8_MMA(1, 0, At, B0); PG8_MMA(1, 1, At, B1); PG8_BAR; PG8_SCHED;
            PG8_LDB(B0, 1, 0); PG8_LDB(B1, 1, 1); PG8_SCHED; PG8_LDA(At, 1, 0); PG8_STAGE(PG8_SA(0, 1), a2, v2[1]);
            PG8_WAIT_V(8); PG8_WAIT_L(0); PG8_BAR; PG8_MMA(0, 0, At, B0); PG8_MMA(0, 1, At, B1); PG8_BAR; PG8_SCHED;
            PG8_LDA(At, 1, 1); PG8_STAGE(PG8_SB(1, 0), b3, voffB); PG8_STAGE(PG8_SB(1, 1), b3 + hstep, voffB); PG8_STAGE(PG8_SA(1, 0), a3, v2[0]);
            PG8_WAIT_V(8); PG8_WAIT_L(0); PG8_BAR; PG8_MMA(1, 0, At, B0); PG8_MMA(1, 1, At, B1); PG8_BAR; PG8_SCHED;
        }
        if (wr == 0) PG8_BAR;
        E(acc, cur, wr, wc, fr, fq);
        if (!has_next) break;
#pragma unroll
        for (int a = 0; a < 2; ++a)
#pragma unroll
            for (int b = 0; b < 2; ++b)
#pragma unroll
                for (int m = 0; m < 4; ++m)
#pragma unroll
                    for (int n = 0; n < 2; ++n) acc[a][b][m][n] = (f32x4){0.f, 0.f, 0.f, 0.f};
        cur = nxt; cB = nB; ++ui;
#pragma unroll
        for (int h = 0; h < 2; ++h)
#pragma unroll
            for (int i = 0; i < 2; ++i) va[h][i] = nva[h][i];
        if (wr == 1) PG8_BAR;
    }
    PG8_WAIT_V(0);
    PG8_BAR;
#undef PG8_SA
#undef PG8_SB
#undef PG8_STAGE
#undef PG8_LDA
#undef PG8_LDB
#undef PG8_MMA
#undef PG8_WAIT_V
#undef PG8_WAIT_L
#undef PG8_BAR
#undef PG8_SCHED
}
}

typedef f32x4 AccT[2][2][4][2];
#define EPI_LOOP(...) _Pragma("unroll") for (int ai = 0; ai < 2; ++ai) _Pragma("unroll") for (int m = 0; m < 4; ++m) { const int row = u.pm * 256 + ai * 128 + wr * 64 + m * 16 + fr; \
    _Pragma("unroll") for (int bj = 0; bj < 2; ++bj) { const int col = u.pn * 256 + bj * 128 + wc * 32 + 8 * fq; const f32x4 v0 = acc[ai][bj][m][0], v1 = acc[ai][bj][m][1]; __VA_ARGS__ } }

struct EpiStoreBf16 {
    bf16_t* O; int ldc;
    DEVI void operator()(const AccT& acc, const pg8::Unit& u, int wr, int wc, int fr, int fq) const {
        EPI_LOOP({ u32x4 w; w.x = pk2(v0[0], v0[1]); w.y = pk2(v0[2], v0[3]); w.z = pk2(v1[0], v1[1]); w.w = pk2(v1[2], v1[3]);
                   *(u32x4*)(O + (size_t)row * ldc + col) = w; })
    }
};
DEVI int rowc_of(int t) { return (t >> 13) * SEQ + CTXL + (t & 8191); }
struct EpiGate1 {
    float* M1; const bf16_t* P;
    DEVI void operator()(const AccT& acc, const pg8::Unit& u, int wr, int wc, int fr, int fq) const {
        EPI_LOOP({ const u32x4 g = *(const u32x4*)(P + (size_t)rowc_of(row) * NP + C_GA + col);
                   f32x4 o0, o1; o0[0] = sigmoidf_(lo_f(g.x)) * v0[0]; o0[1] = sigmoidf_(hi_f(g.x)) * v0[1]; o0[2] = sigmoidf_(lo_f(g.y)) * v0[2]; o0[3] = sigmoidf_(hi_f(g.y)) * v0[3];
                   o1[0] = sigmoidf_(lo_f(g.z)) * v1[0]; o1[1] = sigmoidf_(hi_f(g.z)) * v1[1]; o1[2] = sigmoidf_(lo_f(g.w)) * v1[2]; o1[3] = sigmoidf_(hi_f(g.w)) * v1[3];
                   float* d = M1 + (size_t)row * DM + col; *(f32x4*)d = o0; *(f32x4*)(d + 4) = o1; })
    }
};
struct EpiGate2 {
    const float* M1; bf16_t* M; const bf16_t* P;
    DEVI void operator()(const AccT& acc, const pg8::Unit& u, int wr, int wc, int fr, int fq) const {
        EPI_LOOP({ const u32x4 g = *(const u32x4*)(P + (size_t)rowc_of(row) * NP + C_GB + col);
                   const float* s = M1 + (size_t)row * DM + col; const f32x4 a0 = *(const f32x4*)s, a1 = *(const f32x4*)(s + 4);
                   u32x4 w; w.x = pk2(a0[0] + sigmoidf_(lo_f(g.x)) * v0[0], a0[1] + sigmoidf_(hi_f(g.x)) * v0[1]); w.y = pk2(a0[2] + sigmoidf_(lo_f(g.y)) * v0[2], a0[3] + sigmoidf_(hi_f(g.y)) * v0[3]);
                   w.z = pk2(a1[0] + sigmoidf_(lo_f(g.z)) * v1[0], a1[1] + sigmoidf_(hi_f(g.z)) * v1[1]); w.w = pk2(a1[2] + sigmoidf_(lo_f(g.w)) * v1[2], a1[3] + sigmoidf_(hi_f(g.w)) * v1[3]);
                   *(u32x4*)(M + (size_t)row * DM + col) = w; })
    }
};
struct EpiResid {
    const float* x; float* out; const float* mod;
    DEVI void operator()(const AccT& acc, const pg8::Unit& u, int wr, int wc, int fr, int fq) const {
        EPI_LOOP({ const int b = row >> 13; const float* gp = mod + b * 6144 + 2048 + col;
                   const f32x4 g0 = *(const f32x4*)gp, g1 = *(const f32x4*)(gp + 4);
                   const float* xs = x + (size_t)row * DM + col; float* d = out + (size_t)row * DM + col;
                   *(f32x4*)d = *(const f32x4*)xs + g0 * v0; *(f32x4*)(d + 4) = *(const f32x4*)(xs + 4) + g1 * v1; })
    }
};
struct EpiSwiglu {
    bf16_t* act; const float* b1;
    DEVI void operator()(const AccT& acc, const pg8::Unit& u, int wr, int wc, int fr, int fq) const {
        const int cc = u.pn * 128 + wc * 32 + 8 * fq; const float* bg = b1 + (size_t)u.g * 2048 + cc; const float* bl = bg + 1024;
        float g_[8], l_[8];
#pragma unroll
        for (int j = 0; j < 8; ++j) { g_[j] = bg[j]; l_[j] = bl[j]; }
#pragma unroll
        for (int ai = 0; ai < 2; ++ai)
#pragma unroll
            for (int m = 0; m < 4; ++m) {
                const int row = u.pm * 256 + ai * 128 + wr * 64 + m * 16 + fr; float o[8];
#pragma unroll
                for (int j = 0; j < 8; ++j) {
                    const float hg = acc[ai][0][m][j >> 2][j & 3] + g_[j], hl = acc[ai][1][m][j >> 2][j & 3] + l_[j];
                    const float glu = fminf(hg, 7.f), lin = fminf(fmaxf(hl, -7.f), 7.f);
                    o[j] = glu * sigmoidf_(1.702f * glu) * (lin + 1.f);
                }
                u32x4 w; w.x = pk2(o[0], o[1]); w.y = pk2(o[2], o[3]); w.z = pk2(o[4], o[5]); w.w = pk2(o[6], o[7]);
                *(u32x4*)(act + (size_t)row * 1024 + cc) = w;
            }
    }
};
struct EpiMoe2 {
    bf16_t* Y; const float* b2; const float* lgate; const LAS int* tile_s0; const LAS int* cnt;
    DEVI void operator()(const AccT& acc, const pg8::Unit& u, int wr, int wc, int fr, int fq) const {
        const int s0 = tile_s0[u.pm], n = cnt[u.g];
#pragma unroll
        for (int ai = 0; ai < 2; ++ai)
#pragma unroll
            for (int m = 0; m < 4; ++m) {
                const int rl = ai * 128 + wr * 64 + m * 16 + fr, slot = s0 + rl; const int row = u.pm * 256 + rl;
                const float gate = (slot < n) ? lgate[u.g * CAP + slot] : 0.f;
#pragma unroll
                for (int bj = 0; bj < 2; ++bj) {
                    const int col = u.pn * 256 + bj * 128 + wc * 32 + 8 * fq; const float* bp = b2 + (size_t)u.g * 1024 + col;
                    const f32x4 v0 = (acc[ai][bj][m][0] + *(const f32x4*)bp) * gate, v1 = (acc[ai][bj][m][1] + *(const f32x4*)(bp + 4)) * gate;
                    u32x4 w; w.x = pk2(v0[0], v0[1]); w.y = pk2(v0[2], v0[3]); w.z = pk2(v1[0], v1[1]); w.w = pk2(v1[2], v1[3]);
                    *(u32x4*)(Y + (size_t)row * 1024 + col) = w;
                }
            }
    }
};

namespace att {
constexpr int KVBLK = 64, LDQ = NP, LDK = NP;
constexpr float SCALE = 0.125f, THR = 8.f;
constexpr int SHM_V = KVBLK * 128 * 2, SHM_K = KVBLK * 128 * 2;
constexpr int OFF_VR = 0, OFF_KR = 4 * SHM_V;
constexpr int OFF_WS = 4 * SHM_V + 3 * SHM_K;
constexpr int OFF_E = 0;
constexpr int E_LD = 132;
constexpr int LDS_BYTES = OFF_WS + 8 * 64 * 4;
static_assert(128 * E_LD * 4 <= OFF_WS, "epilogue scratch must fit under the per-wave words");
#define KSWZ(row, colB) ((row) * 256 + ((colB) ^ (((row) & 7) << 4)))
#define SBAR() __builtin_amdgcn_sched_barrier(0)
DEVI int crow(int r, int hi) { return (r & 3) + 8 * (r >> 2) + 4 * hi; }
template <bool FIRST>
DEVI void partialSM(f32x16& p0, f32x16& p1, f32x16& negm, float& alpha, bool fixedref) {
    constexpr float THRL = (THR / SCALE) * (SCALE * LOG2E);
    if (fixedref) { alpha = 1.f;
#pragma unroll
        for (int r = 0; r < 16; ++r) p0[r] = __builtin_amdgcn_exp2f(p0[r]);
        return; }
    float pmax = p0[0];
#pragma unroll
    for (int r = 1; r < 16; ++r) pmax = fmaxf(pmax, p0[r]);
#pragma unroll
    for (int r = 0; r < 16; ++r) pmax = fmaxf(pmax, p1[r]);
    { auto rr = __builtin_amdgcn_permlane32_swap(__float_as_uint(pmax), __float_as_uint(pmax), false, false);
      pmax = fmaxf(__uint_as_float(rr[0]), __uint_as_float(rr[1])); }
    if (!FIRST && __builtin_expect(__all(pmax <= THRL), 1)) { alpha = 1.f; }
    else { const float d = FIRST ? pmax : fmaxf(pmax, 0.f); alpha = FIRST ? 1.f : __builtin_amdgcn_exp2f(-d);
#pragma unroll
        for (int r = 0; r < 16; ++r) { p0[r] -= d; p1[r] -= d; negm[r] -= d; } }
#pragma unroll
    for (int r = 0; r < 16; ++r) p0[r] = __builtin_amdgcn_exp2f(p0[r]);
}
DEVI void finishSM(f32x16& p0, f32x16& p1, float alpha, float& l_reg, bf16x8& pa0, bf16x8& pa1, bf16x8& pa2, bf16x8& pa3) {
#pragma unroll
    for (int r = 0; r < 16; ++r) p1[r] = __builtin_amdgcn_exp2f(p1[r]);
    float ps = 0;
#pragma unroll
    for (int r = 0; r < 16; ++r) ps += p0[r];
#pragma unroll
    for (int r = 0; r < 16; ++r) ps += p1[r];
    { auto rr = __builtin_amdgcn_permlane32_swap(__float_as_uint(ps), __float_as_uint(ps), false, false);
      ps = __uint_as_float(rr[0]) + __uint_as_float(rr[1]); }
    l_reg = l_reg * alpha + ps;
#define PK4(P, BASE, OUT) do { unsigned a0 = pk2a(P[BASE + 0], P[BASE + 1]), a1 = pk2a(P[BASE + 2], P[BASE + 3]);   \
    unsigned b0 = pk2a(P[BASE + 4], P[BASE + 5]), b1 = pk2a(P[BASE + 6], P[BASE + 7]);                              \
    auto r0 = __builtin_amdgcn_permlane32_swap(a0, b0, false, false); auto r1 = __builtin_amdgcn_permlane32_swap(a1, b1, false, false); \
    u32x4 w = {r0[0], r1[0], r0[1], r1[1]}; OUT = *reinterpret_cast<bf16x8*>(&w); } while (0)
    PK4(p0, 0, pa0); PK4(p0, 8, pa1); PK4(p1, 0, pa2); PK4(p1, 8, pa3);
#undef PK4
}
DEVI void qkt(f32x16& p0, f32x16& p1, const char* Ks, const bf16x8* qr, int r32, int hi, int st, const f32x16& negm) {
#pragma unroll
    for (int d0 = 0; d0 < 4; ++d0) { const int cb = ((st * 4 + d0) * 16 + hi * 8) * 2;
        const bf16x8 b0 = *reinterpret_cast<const bf16x8*>(Ks + KSWZ(r32, cb));
        const bf16x8 b1 = *reinterpret_cast<const bf16x8*>(Ks + KSWZ(32 + r32, cb));
        p0 = __builtin_amdgcn_mfma_f32_32x32x16_bf16(b0, qr[d0], d0 == 0 ? negm : p0, 0, 0, 0);
        p1 = __builtin_amdgcn_mfma_f32_32x32x16_bf16(b1, qr[d0], d0 == 0 ? negm : p1, 0, 0, 0); }
}
DEVI int v_st(int k, int c) { const int kk = (k & ~0xC) | ((k & 4) << 1) | ((k & 8) >> 1); return ((kk >> 3) * 4 + (c >> 5)) * 512 + ((kk & 7) * 32 + (c & 31)) * 2; }
DEVI int v_rd_base(int lane) { return ((lane & 3) << 3) | (((lane >> 2) & 3) << 6) | (((lane >> 4) & 1) << 5) | (((lane >> 5) & 1) << 8); }
constexpr int v_rd_off(int d0, int ks, int half) { return d0 * 512 + ks * 4096 + half * 2048; }
template <int OFF> DEVI s16x4 tr_read(int vb) {
    s16x4 r; asm volatile("ds_read_b64_tr_b16 %0, %1 offset:%2" : "=&v"(r) : "v"(vb), "i"(OFF) : "memory"); return r;
}
template <int D0> DEVI void pv_one(f32x16& od, int vb, bf16x8 pa0, bf16x8 pa1, bf16x8 pa2, bf16x8 pa3) {
    const s16x4 l0 = tr_read<v_rd_off(D0, 0, 0)>(vb), h0 = tr_read<v_rd_off(D0, 0, 1)>(vb), l1 = tr_read<v_rd_off(D0, 1, 0)>(vb), h1 = tr_read<v_rd_off(D0, 1, 1)>(vb);
    const s16x4 l2 = tr_read<v_rd_off(D0, 2, 0)>(vb), h2 = tr_read<v_rd_off(D0, 2, 1)>(vb), l3 = tr_read<v_rd_off(D0, 3, 0)>(vb), h3 = tr_read<v_rd_off(D0, 3, 1)>(vb);
    asm volatile("s_waitcnt lgkmcnt(0)" ::: "memory"); SBAR();
#define PK(L, H) (bf16x8){L[0], L[1], L[2], L[3], H[0], H[1], H[2], H[3]}
    od = __builtin_amdgcn_mfma_f32_32x32x16_bf16(pa0, PK(l0, h0), od, 0, 0, 0);
    od = __builtin_amdgcn_mfma_f32_32x32x16_bf16(pa1, PK(l1, h1), od, 0, 0, 0);
    od = __builtin_amdgcn_mfma_f32_32x32x16_bf16(pa2, PK(l2, h2), od, 0, 0, 0);
    od = __builtin_amdgcn_mfma_f32_32x32x16_bf16(pa3, PK(l3, h3), od, 0, 0, 0);
#undef PK
}
DEVI void pv_d0(f32x16* o, int vb, bf16x8 pa0, bf16x8 pa1, bf16x8 pa2, bf16x8 pa3) {
    pv_one<0>(o[0], vb, pa0, pa1, pa2, pa3); pv_one<1>(o[1], vb, pa0, pa1, pa2, pa3); pv_one<2>(o[2], vb, pa0, pa1, pa2, pa3); pv_one<3>(o[3], vb, pa0, pa1, pa2, pa3);
}
DEVI void attn_unit(const bf16_t* __restrict__ Qb, const bf16_t* __restrict__ Kh, const bf16_t* __restrict__ Vh, bf16_t* __restrict__ Ob, float lam, bool fixedref, const float* __restrict__ dng, char* lds) {
    const int tid = threadIdx.x, wid = __builtin_amdgcn_readfirstlane(tid >> 6), lane = tid & 63, r32 = lane & 31, hi = lane >> 5, w4 = wid & 3, st = wid >> 2;
    char* V_lds = lds + OFF_VR; char* K_lds = lds + OFF_KR; LAS unsigned char* ldsL = (LAS unsigned char*)lds;
    float* wsf = (float*)(lds + OFF_WS) + wid * 64; float* li_l = wsf; float* al_l = wsf + 32;
    float l_reg = 0; f32x16 o[4] = {}; f32x16 negm = {}; bf16x8 qr[4];
    const bf16_t* Qw = Qb + (size_t)(w4 * 32 + r32) * LDQ + st * 64 + hi * 8;
#pragma unroll
    for (int d0 = 0; d0 < 4; ++d0) qr[d0] = *reinterpret_cast<const bf16x8*>(Qw + d0 * 16);
    unsigned kof[2], vof[2];
#pragma unroll
    for (int i = 0; i < 2; ++i) { const int q = 2 * wid + i;
        { const int row = 4 * q + (lane >> 4), colB = ((lane & 15) * 16) ^ ((row & 7) << 4); kof[i] = (unsigned)(row * LDK + colB / 2) * 2u; }
        { const int sub = 2 * q + (lane >> 5), kk = (sub >> 2) * 8 + ((lane & 31) >> 2), cc = (sub & 3) * 32 + (lane & 3) * 8;
          const int k = (kk & ~0xC) | ((kk & 4) << 1) | ((kk & 8) >> 1); vof[i] = (unsigned)(k * LDK + cc) * 2u; } }
    const int vb0 = (int)(uintptr_t)V_lds + v_rd_base(lane);
#define DMA_K(src_tile, slot) do { const char* kb_ = (const char*)Kh + (size_t)(src_tile) * (KVBLK * LDK * 2); _Pragma("unroll") for (int i_ = 0; i_ < 2; ++i_) \
        __builtin_amdgcn_global_load_lds((const unsigned*)(kb_ + kof[i_]), (LAS unsigned*)(ldsL + OFF_KR + (slot) * SHM_K + (2 * wid + i_) * 1024), 16, 0, 0); } while (0)
#define DMA_V(src_tile, slot) do { const char* vb_ = (const char*)Vh + (size_t)(src_tile) * (KVBLK * LDK * 2); _Pragma("unroll") for (int i_ = 0; i_ < 2; ++i_) \
        __builtin_amdgcn_global_load_lds((const unsigned*)(vb_ + vof[i_]), (LAS unsigned*)(ldsL + OFF_VR + (slot) * SHM_V + (2 * wid + i_) * 1024), 16, 0, 0); } while (0)
#define TILE_SYNC(n) do { asm volatile("s_waitcnt vmcnt(" #n ")" ::: "memory"); __builtin_amdgcn_s_barrier(); asm volatile("" ::: "memory"); } while (0)
#define RESC(a) do { if (__any((a) < 1.f)) { const int ln_ = lane_id_fresh(), hi_ = ln_ >> 5; float* al_ = (float*)(lds + OFF_WS) + wid * 64 + 32; \
    if (hi_ == 0) al_[ln_ & 31] = (a); asm volatile("s_waitcnt lgkmcnt(0)" ::: "memory"); \
    _Pragma("unroll") for (int d = 0; d < 4; ++d) _Pragma("unroll") for (int r = 0; r < 16; ++r) o[d][r] *= al_[crow(r, hi_)]; } } while (0)
    f32x16 pA0, pA1, pB0, pB1; float mnA = 0.f, mnB = 0.f, alA, alB; (void)mnA; (void)mnB; bf16x8 pa0, pa1, pa2, pa3; constexpr int NT = SEQ / KVBLK;
#define SEG_X(PN0, PN1, h_, PP0, PP1, alP) do { SBAR(); qkt(PN0, PN1, K_lds + ((h_) % 3) * SHM_K, qr, r32, hi, st, negm); finishSM(PP0, PP1, alP, l_reg, pa0, pa1, pa2, pa3); SBAR(); } while (0)
#define SEG_Y(PN0, PN1, h_, mnN, alN) do { pv_d0(o, vb0 + (((h_) - 1) & 3) * SHM_V, pa0, pa1, pa2, pa3); partialSM<false>(PN0, PN1, negm, alN, fixedref); if (!fixedref) RESC(alN); } while (0)
#define ISSUE(h_) do { const int jk_ = (h_) + 2; DMA_K(jk_ < NT ? jk_ : NT - 1, jk_ % 3); DMA_V((h_) + 1, ((h_) + 1) & 3); } while (0)
    DMA_K(0, 0); DMA_V(0, 0); DMA_K(1, 1);
    TILE_SYNC(0);
    if (st == 0) {
        ISSUE(0); qkt(pA0, pA1, K_lds, qr, r32, hi, st, negm); partialSM<true>(pA0, pA1, negm, alA, fixedref); TILE_SYNC(4);
        for (int h = 1; h + 1 < NT; h += 2) {
            SEG_X(pB0, pB1, h, pA0, pA1, alA);     ISSUE(h);     SEG_Y(pB0, pB1, h, mnB, alB);     TILE_SYNC(4);
            SEG_X(pA0, pA1, h + 1, pB0, pB1, alB); ISSUE(h + 1); SEG_Y(pA0, pA1, h + 1, mnA, alA); TILE_SYNC(4);
        }
        SEG_X(pB0, pB1, NT - 1, pA0, pA1, alA); SEG_Y(pB0, pB1, NT - 1, mnB, alB); TILE_SYNC(0);
        finishSM(pB0, pB1, alB, l_reg, pa0, pa1, pa2, pa3); SBAR();
        pv_d0(o, vb0 + ((NT - 1) & 3) * SHM_V, pa0, pa1, pa2, pa3);
    } else {
        ISSUE(0); qkt(pA0, pA1, K_lds, qr, r32, hi, st, negm); TILE_SYNC(4);
        ISSUE(1); partialSM<true>(pA0, pA1, negm, alA, fixedref); SEG_X(pB0, pB1, 1, pA0, pA1, alA); TILE_SYNC(4);
        for (int h = 2; h + 3 < NT; h += 2) {
            SEG_Y(pB0, pB1, h - 1, mnB, alB); ISSUE(h);     SEG_X(pA0, pA1, h, pB0, pB1, alB);     TILE_SYNC(4);
            SEG_Y(pA0, pA1, h, mnA, alA);     ISSUE(h + 1); SEG_X(pB0, pB1, h + 1, pA0, pA1, alA); TILE_SYNC(4);
        }
        ISSUE(NT - 2); SEG_Y(pB0, pB1, NT - 3, mnB, alB); SEG_X(pA0, pA1, NT - 2, pB0, pB1, alB); TILE_SYNC(4);
        SEG_Y(pA0, pA1, NT - 2, mnA, alA); SEG_X(pB0, pB1, NT - 1, pA0, pA1, alA); TILE_SYNC(0);
        SEG_Y(pB0, pB1, NT - 1, mnB, alB);
        finishSM(pB0, pB1, alB, l_reg, pa0, pa1, pa2, pa3); SBAR();
        pv_d0(o, vb0 + ((NT - 1) & 3) * SHM_V, pa0, pa1, pa2, pa3);
    }
    asm volatile("s_waitcnt lgkmcnt(0)" ::: "memory"); __builtin_amdgcn_s_barrier(); asm volatile("" ::: "memory");
#undef SEG_X
#undef SEG_Y
#undef ISSUE
    if (hi == 0) li_l[r32] = l_reg; asm volatile("s_waitcnt lgkmcnt(0)" ::: "memory");
    float rli[16];
    const float sgn = st ? lam : 1.f;
#pragma unroll
    for (int r = 0; r < 16; ++r) rli[r] = __builtin_amdgcn_rcpf(li_l[crow(r, hi)]) * sgn;
    float* Es = (float*)(lds + OFF_E);
    if (st == 1) {
#pragma unroll
        for (int r = 0; r < 16; ++r) { const int orow = w4 * 32 + crow(r, hi);
#pragma unroll
            for (int d0 = 0; d0 < 4; ++d0) Es[orow * E_LD + d0 * 32 + r32] = o[d0][r] * rli[r]; }
    }
    __syncthreads();
    if (st == 0) {
#pragma unroll
        for (int r = 0; r < 16; ++r) { const int orow = w4 * 32 + crow(r, hi);
#pragma unroll
            for (int d0 = 0; d0 < 4; ++d0) { float* e = &Es[orow * E_LD + d0 * 32 + r32]; *e = o[d0][r] * rli[r] - *e; } }
    }
    __syncthreads();
    { const int row = tid >> 2, q = tid & 3; const float* e = &Es[row * E_LD + q * 32]; float v[32]; float ss = 0.f;
#pragma unroll
      for (int j = 0; j < 8; ++j) { const f32x4 t4 = *(const f32x4*)(e + 4 * j); v[4 * j] = t4[0]; v[4 * j + 1] = t4[1]; v[4 * j + 2] = t4[2]; v[4 * j + 3] = t4[3]; }
#pragma unroll
      for (int j = 0; j < 32; ++j) ss += v[j] * v[j];
      ss += __shfl_xor(ss, 1); ss += __shfl_xor(ss, 2);
      const float rs = __builtin_amdgcn_rsqf(ss * (1.f / 128.f) + EPS) * 0.8f;
      bf16_t* op = Ob + (size_t)row * 1024 + q * 32; const float* g = dng + q * 32;
#pragma unroll
      for (int j = 0; j < 4; ++j) { u32x4 w; w.x = pk2(v[8 * j] * rs * g[8 * j], v[8 * j + 1] * rs * g[8 * j + 1]); w.y = pk2(v[8 * j + 2] * rs * g[8 * j + 2], v[8 * j + 3] * rs * g[8 * j + 3]);
          w.z = pk2(v[8 * j + 4] * rs * g[8 * j + 4], v[8 * j + 5] * rs * g[8 * j + 5]); w.w = pk2(v[8 * j + 6] * rs * g[8 * j + 6], v[8 * j + 7] * rs * g[8 * j + 7]);
          *(u32x4*)(op + 8 * j) = w; }
    }
    __syncthreads();
#undef DMA_K
#undef DMA_V
#undef TILE_SYNC
#undef RESC
}
}

#define LDS_BAR() do { asm volatile("s_waitcnt lgkmcnt(0)" ::: "memory"); __builtin_amdgcn_s_barrier(); asm volatile("" ::: "memory"); } while (0)
namespace ret {
using att::crow;
DEVI size_t qf_index(int b, int h, int c, int w, int ks, int fq, int fr) { return (((((((size_t)(b * 4 + h) * 66 + c) * 8 + w) * 8 + ks) * 4 + fq) * 16 + fr) * 8); }
DEVI size_t ktf_index(int b, int h, int c, int w, int ks, int hh, int r32) { return (((((((size_t)(b * 4 + h) * 66 + c) * 8 + w) * 8 + ks) * 2 + hh) * 32 + r32) * 8); }
constexpr int VS_LD = 136;
constexpr int ST_LD = 264;
constexpr int TS_LD = 40;
constexpr int OFF_VS = 0, OFF_ST = 2 * 32 * VS_LD * 2, OFF_TS = OFF_ST + 2 * 32 * ST_LD * 2;
DEVI void scan_unit(int u, const bf16_t* __restrict__ QF, const bf16_t* __restrict__ KTF, const bf16_t* __restrict__ VT, bf16_t* __restrict__ OF, bf16_t* __restrict__ OB, const float* __restrict__ scal, char* lds) {
    const int b = u >> 7, h = (u >> 5) & 3, dir = (u >> 4) & 1, vs = u & 15;
    const int tid = threadIdx.x, w = __builtin_amdgcn_readfirstlane(tid >> 6), lane = tid & 63, r32 = lane & 31, hh = lane >> 5, fr = lane & 15, fq = lane >> 4;
    const float lgn = scal[dir * 4 + h];
    const float gch = __expf(lgn * 128.f);
    bf16_t* Vs = (bf16_t*)(lds + OFF_VS); bf16_t* St = (bf16_t*)(lds + OFF_ST); bf16_t* Ts = (bf16_t*)(lds + OFF_TS) + w * (16 * TS_LD);
    for (int i = tid; i < 32 * ST_LD / 2; i += 512) ((unsigned*)St)[i] = 0u;
    f32x16 S = {};
    const bf16_t* QFb = QF + qf_index(b, h, 0, w, 0, 0, 0) + lane * 8;
    const bf16_t* KTFb = KTF + ktf_index(b, h, 0, w, 0, 0, 0) + lane * 8;
    const bf16_t* VTb = VT + ((size_t)(b * 4 + h) * 512 + vs * 32) * SEQ;
    bf16_t* Odir = dir ? OB : OF;
    bf16_t* sink = (bf16_t*)((char*)OF + (WS_DUMMY - WS_OF));
    const int sv = tid >> 4, sj = (tid & 15) * 8;
    float wj[8];
#pragma unroll
    for (int e = 0; e < 8; ++e) { const int j = sj + e; wj[e] = __expf(lgn * (float)(dir ? j : 127 - j)); }
    const int itok = 16 * w + fr;
    const float qd = __expf(lgn * (float)(dir ? 128 - itok : itok + 1));
    bf16x8 kfA[8], kfB[8], qfA[8], qfB[8]; bf16x8 vA, vB;
#define CHUNK_OF(k) (dir ? ((k) == 0 ? 1 : ((k) == 1 ? 0 : 67 - (k))) : (k))
#define CLAMPK(kk) ((kk) < 66 ? (kk) : 65)
#define LOADK(KF_, kk) do { const size_t co_ = (size_t)CHUNK_OF(CLAMPK(kk)) * 32768; \
        _Pragma("unroll") for (int ks = 0; ks < 8; ++ks) KF_[ks] = *(const bf16x8*)(KTFb + co_ + ((ks + vs) & 7) * 512); } while (0)
#define LOADV(VR_, kk) do { VR_ = *(const bf16x8*)(VTb + (size_t)sv * SEQ + CHUNK_OF(CLAMPK(kk)) * 128 + sj); } while (0)
#define LOADQ(QF_, kk) do { const size_t co_ = (size_t)CHUNK_OF(CLAMPK(kk)) * 32768;     \
        _Pragma("unroll") for (int ks = 0; ks < 8; ++ks) QF_[ks] = *(const bf16x8*)(QFb + co_ + ((ks + vs) & 7) * 512); } while (0)
#define STEP(k, KF_, V_, QF_) do { \
        const int cn = CHUNK_OF(k); \
        bf16_t* Vsk = Vs + ((k) & 1) * (32 * VS_LD); const bf16_t* Stk = St + ((k) & 1) * (32 * ST_LD); bf16_t* Stn = St + (((k) + 1) & 1) * (32 * ST_LD); \
        { u32x4 vv = *reinterpret_cast<u32x4*>(&V_); u32x4 ww; \
          ww.x = pk2(lo_f(vv.x) * wj[0], hi_f(vv.x) * wj[1]); ww.y = pk2(lo_f(vv.y) * wj[2], hi_f(vv.y) * wj[3]); \
          ww.z = pk2(lo_f(vv.z) * wj[4], hi_f(vv.z) * wj[5]); ww.w = pk2(lo_f(vv.w) * wj[6], hi_f(vv.w) * wj[7]); \
          *(u32x4*)(Vsk + sv * VS_LD + sj) = ww; } \
        LOADV(V_, (k) + 2); \
        __syncthreads();     \
        _Pragma("unroll") for (int r = 0; r < 16; ++r) S[r] *= gch; \
        _Pragma("unroll") for (int ks = 0; ks < 8; ++ks) { \
            const bf16x8 vf = *(const bf16x8*)(Vsk + r32 * VS_LD + ((ks + vs) & 7) * 16 + hh * 8); \
            S = __builtin_amdgcn_mfma_f32_32x32x16_bf16(KF_[ks], vf, S, 0, 0, 0); } \
        LOADK(KF_, (k) + 2); \
        _Pragma("unroll") for (int g = 0; g < 4; ++g) { u32x2 ww; ww.x = pk2(S[4 * g], S[4 * g + 1]); ww.y = pk2(S[4 * g + 2], S[4 * g + 3]); \
            *(u32x2*)(Stn + r32 * ST_LD + 32 * w + 8 * g + 4 * hh) = ww; } \
        {                    \
            f32x4 a0 = {0.f, 0.f, 0.f, 0.f}, a1 = {0.f, 0.f, 0.f, 0.f}; \
            _Pragma("unroll") for (int ks = 0; ks < 8; ++ks) { \
                const bf16x8 s0f = *(const bf16x8*)(Stk + (fr) * ST_LD + ((ks + vs) & 7) * 32 + fq * 8); \
                const bf16x8 s1f = *(const bf16x8*)(Stk + (16 + fr) * ST_LD + ((ks + vs) & 7) * 32 + fq * 8); \
                a0 = __builtin_amdgcn_mfma_f32_16x16x32_bf16(s0f, QF_[ks], a0, 0, 0, 0); \
                a1 = __builtin_amdgcn_mfma_f32_16x16x32_bf16(s1f, QF_[ks], a1, 0, 0, 0); } \
            u32x2 w0, w1; w0.x = pk2(a0[0] * qd, a0[1] * qd); w0.y = pk2(a0[2] * qd, a0[3] * qd); w1.x = pk2(a1[0] * qd, a1[1] * qd); w1.y = pk2(a1[2] * qd, a1[3] * qd); \
            *(u32x2*)(Ts + fr * TS_LD + 4 * fq) = w0; *(u32x2*)(Ts + fr * TS_LD + 16 + 4 * fq) = w1;        \
            asm volatile("s_waitcnt lgkmcnt(0)" ::: "memory"); \
            const int tk = lane >> 2, l = (cn - 2) * 128 + 16 * w + tk; \
            const u32x4 ov = *(const u32x4*)(Ts + tk * TS_LD + (lane & 3) * 8); \
            bf16_t* op = (cn >= 2 ? Odir + (size_t)(b * LSEQ + l) * 2048 : sink + (size_t)(16 * w + tk) * 2048) + h * 512 + vs * 32 + (lane & 3) * 8; \
            *(u32x4*)op = ov; } \
        LOADQ(QF_, (k) + 2); \
    } while (0)
    LOADK(kfA, 0); LOADV(vA, 0); LOADK(kfB, 1); LOADV(vB, 1); LOADQ(qfA, 0); LOADQ(qfB, 1);
#pragma unroll 1
    for (int k2 = 0; k2 < 66; k2 += 2) {
        STEP(k2 + 0, kfA, vA, qfA);
        STEP(k2 + 1, kfB, vB, qfB);
    }
    __syncthreads();
#undef STEP
#undef LOADK
#undef LOADV
#undef LOADQ
#undef CHUNK_OF
}
constexpr int QL_LD = 264, PL_LD = 136, VL_LD = 136;
constexpr int OFF_QL = 0, OFF_KL = 128 * QL_LD * 2, OFF_PL = 0, OFF_VL = OFF_KL;
DEVI void intra_unit(int u, const bf16_t* __restrict__ P, const bf16_t* __restrict__ VT, bf16_t* __restrict__ OI, const float* __restrict__ scal, char* lds) {
    const int b = u >> 8, h = (u >> 6) & 3, lc = u & 63, s0 = (lc + 2) * 128;
    const int tid = threadIdx.x, w = __builtin_amdgcn_readfirstlane(tid >> 6), lane = tid & 63, r32 = lane & 31, hh = lane >> 5;
    const int tr = w >> 1, tc0 = 2 * (w & 1);
    bf16_t* Ql = (bf16_t*)(lds + OFF_QL); bf16_t* Kl = (bf16_t*)(lds + OFF_KL); bf16_t* Pl = (bf16_t*)(lds + OFF_PL); bf16_t* Vl = (bf16_t*)(lds + OFF_VL);
    {
        const int srow = tid >> 5, pc = (tid & 31) * 8;
        const bf16_t* qg = P + ((size_t)b * SEQ + s0 + srow) * NP + C_RQ + h * 256 + pc; const bf16_t* kg = qg + (C_RK - C_RQ);
        u32x4 qv[8], kv[8];
#pragma unroll
        for (int it = 0; it < 8; ++it) { qv[it] = *(const u32x4*)(qg + (size_t)it * 16 * NP); kv[it] = *(const u32x4*)(kg + (size_t)it * 16 * NP); }
#pragma unroll
        for (int it = 0; it < 8; ++it) { *(u32x4*)(Ql + (it * 16 + srow) * QL_LD + pc) = qv[it]; *(u32x4*)(Kl + (it * 16 + srow) * QL_LD + pc) = kv[it]; }
    }
    __syncthreads();
    f32x16 c0 = {}, c1 = {};
#pragma unroll 4
    for (int ks = 0; ks < 16; ++ks) {
        const bf16x8 a = *(const bf16x8*)(Ql + (32 * tr + r32) * QL_LD + ks * 16 + hh * 8);
        const bf16x8 b0 = *(const bf16x8*)(Kl + (32 * tc0 + r32) * QL_LD + ks * 16 + hh * 8), b1 = *(const bf16x8*)(Kl + (32 * tc0 + 32 + r32) * QL_LD + ks * 16 + hh * 8);
        c0 = __builtin_amdgcn_mfma_f32_32x32x16_bf16(a, b0, c0, 0, 0, 0);
        c1 = __builtin_amdgcn_mfma_f32_32x32x16_bf16(a, b1, c1, 0, 0, 0);
    }
    const int vrow = tid >> 4, vpc = (tid & 15) * 8;
    const bf16_t* vg = VT + ((size_t)(b * 4 + h) * 512 + vrow) * SEQ + s0 + vpc;
    u32x4 vv[4];
#pragma unroll
    for (int it = 0; it < 4; ++it) vv[it] = *(const u32x4*)(vg + (size_t)(it * 32) * SEQ);
    LDS_BAR();
    const float lf2 = scal[h] * LOG2E, lb2 = scal[4 + h] * LOG2E;
#pragma unroll
    for (int t = 0; t < 2; ++t) {
        const int j = 32 * (tc0 + t) + r32;
#pragma unroll
        for (int r = 0; r < 16; ++r) {
            const int i = 32 * tr + crow(r, hh); const float dlt = (float)(i - j);
            float dm = 0.f;
            if (j <= i) dm += __builtin_amdgcn_exp2f(dlt * lf2);
            if (j >= i) dm += __builtin_amdgcn_exp2f(-dlt * lb2);
            const float v = (t ? c1[r] : c0[r]) * dm;
            Pl[i * PL_LD + j] = (bf16_t)f2bf(v);
        }
    }
    bf16x8 pf[8];
    bf16_t* Ob = OI + ((size_t)b * LSEQ + lc * 128 + 32 * tr + r32) * 2048 + h * 512;
#pragma unroll 1
    for (int vb = 0; vb < 4; ++vb) {
        bf16_t* Vb = Vl + (vb & 1) * (128 * VL_LD);
#pragma unroll
        for (int it = 0; it < 4; ++it) *(u32x4*)(Vb + (it * 32 + vrow) * VL_LD + vpc) = vv[it];
        if (vb < 3) {
#pragma unroll
            for (int it = 0; it < 4; ++it) vv[it] = *(const u32x4*)(vg + (size_t)((vb + 1) * 128 + it * 32) * SEQ);
        }
        LDS_BAR();
        if (vb == 0) {
#pragma unroll
            for (int ks = 0; ks < 8; ++ks) pf[ks] = *(const bf16x8*)(Pl + (32 * tr + r32) * PL_LD + ks * 16 + hh * 8);
        }
#pragma unroll
        for (int t = 0; t < 2; ++t) {
            const int vt = (w & 1) * 2 + t;
            f32x16 oacc = {};
#pragma unroll
            for (int ks = 0; ks < 8; ++ks) {
                const bf16x8 a = *(const bf16x8*)(Vb + (32 * vt + r32) * VL_LD + ks * 16 + hh * 8);
                oacc = __builtin_amdgcn_mfma_f32_32x32x16_bf16(a, pf[ks], oacc, 0, 0, 0);
            }
            const int v0 = vb * 128 + vt * 32;
#pragma unroll
            for (int g = 0; g < 4; ++g) { u32x2 ww; ww.x = pk2(oacc[4 * g], oacc[4 * g + 1]); ww.y = pk2(oacc[4 * g + 2], oacc[4 * g + 3]);
                *(u32x2*)(Ob + v0 + 8 * g + 4 * hh) = ww; }
        }
    }
    __syncthreads();
}
}

constexpr int NPH = 12;
constexpr int LDS_BYTES = 160 * 1024;
constexpr int LDS_TAB = 131072;

struct Ctx {
    int tid, lane, wave, gw, NGW, G, bid;
    char* lds;
};

struct TrTile { const float* W; bf16_t* WT; int K, N, k0, n0, perm; };
DEVI int tr_orow(const TrTile& t, int n) { return t.perm ? 256 * ((n & 1023) >> 7) + 128 * (n >> 10) + (n & 127) : n; }
DEVI void tr_load(const TrTile& t, f32x4 (&v)[16], int tid) { const int wv = tid >> 6, l = tid & 63;
#pragma unroll
    for (int i = 0; i < 16; ++i) v[i] = *(const f32x4*)(t.W + (size_t)(t.k0 + 16 * wv + i) * t.N + t.n0 + 4 * l); }
DEVI void tr_to_lds(const f32x4 (&v)[16], unsigned* T, int tid) { const int wv = tid >> 6, l = tid & 63;
#pragma unroll
    for (int e = 0; e < 4; ++e) { const int n = 4 * l + e;
#pragma unroll
        for (int h = 0; h < 2; ++h) { u32x4 o; o.x = pk2(v[8 * h][e], v[8 * h + 1][e]); o.y = pk2(v[8 * h + 2][e], v[8 * h + 3][e]); o.z = pk2(v[8 * h + 4][e], v[8 * h + 5][e]); o.w = pk2(v[8 * h + 6][e], v[8 * h + 7][e]);
            *(u32x4*)(T + n * 64 + 4 * ((2 * wv + h) ^ (l & 7))) = o; } } }
DEVI void tr_store(const TrTile& t, const unsigned* T, int tid) { const int piece = tid & 15;
#pragma unroll
    for (int it = 0; it < 8; ++it) { const int n = (tid >> 4) + 32 * it;
        const u32x4 o = *(const u32x4*)(T + n * 64 + 4 * (piece ^ ((n >> 2) & 7)));
        *(u32x4*)(t.WT + (size_t)tr_orow(t, t.n0 + n) * t.K + t.k0 + piece * 8) = o; } }

DEVI void phase_prep(const Params& p, const Ctx& c) {
    unsigned char* ws = p.ws;
    constexpr int T_IN = 8 * (NP / 256), T_BR = 16 * 4, T_BD = 8 * 4, T_OUT = T_BD, T_W1 = 8 * 8, T_W2 = 8 * 4;
    int NTIL = T_IN + T_BR + T_BD + T_OUT;
    asm volatile("" : "+s"(NTIL));
    auto tile_of = [&](int it) { TrTile t; int r = it; t.perm = 0;
        if (r < T_IN) { const int nb = NP / 256; t.W = p.w_in; t.WT = (bf16_t*)(ws + WS_WIN); t.K = 1024; t.N = NP; t.k0 = (r / nb) * 128; t.n0 = (r % nb) * 256; return t; } r -= T_IN;
        if (r < T_BR) { t.W = p.w_br_ret; t.WT = (bf16_t*)(ws + WS_WBR); t.K = 2048; t.N = 1024; t.k0 = (r / 4) * 128; t.n0 = (r % 4) * 256; return t; } r -= T_BR;
        if (r < T_BD) { t.W = p.w_br_diff; t.WT = (bf16_t*)(ws + WS_WBD); t.K = 1024; t.N = 1024; t.k0 = (r / 4) * 128; t.n0 = (r % 4) * 256; return t; } r -= T_BD;
        if (r < T_OUT) { t.W = p.w_out; t.WT = (bf16_t*)(ws + WS_WOUT); t.K = 1024; t.N = 1024; t.k0 = (r / 4) * 128; t.n0 = (r % 4) * 256; return t; } r -= T_OUT;
        const int e = r / (T_W1 + T_W2); r -= e * (T_W1 + T_W2);
        if (r < T_W1) { t.W = p.w1 + (size_t)e * 1024 * 2048; t.WT = (bf16_t*)(ws + WS_W1) + (size_t)e * 2048 * 1024; t.K = 1024; t.N = 2048; t.k0 = (r / 8) * 128; t.n0 = (r % 8) * 256; t.perm = 1; return t; } r -= T_W1;
        t.W = p.w2 + (size_t)e * 1024 * 1024; t.WT = (bf16_t*)(ws + WS_W2) + (size_t)e * 1024 * 1024; t.K = 1024; t.N = 1024; t.k0 = (r / 4) * 128; t.n0 = (r % 4) * 256; return t; };
    {
        unsigned* Tl = (unsigned*)c.lds; f32x4 v[16];
        int it = c.bid; TrTile cur = tile_of(it < NTIL ? it : 0);
        if (it < NTIL) tr_load(cur, v, c.tid);
        while (it < NTIL) {
            tr_to_lds(v, Tl, c.tid);
            const int nx = it + c.G; TrTile nxt = tile_of(nx < NTIL ? nx : 0);
            if (nx < NTIL) tr_load(nxt, v, c.tid);
            LDS_BAR();
            tr_store(cur, Tl, c.tid);
            LDS_BAR();
            cur = nxt; it = nx;
        }
    }
    float* mod = (float*)(ws + WS_MOD);
    __syncthreads();
    float* sil = (float*)c.lds + 1024;
    if (c.G - 1 - c.bid < 192) { for (int i = c.tid; i < 3072; i += 512) sil[i] = siluf_(i < 2048 ? p.c[i] : p.c_ctx[i - 2048]); }
    __syncthreads();
    for (int cgp = c.G - 1 - c.bid; cgp < 192; cgp += c.G) {
        const int col = cgp * 32 + (c.lane & 31), kh = c.lane >> 5; float a0 = 0.f, a1 = 0.f, a2 = 0.f;
        for (int k0 = c.wave * 128; k0 < c.wave * 128 + 128; k0 += 64) {
            float wv[32];
#pragma unroll
            for (int i = 0; i < 32; ++i) wv[i] = p.w_mod[(size_t)(k0 + 2 * i + kh) * 6144 + col];
#pragma unroll
            for (int i = 0; i < 32; ++i) { const float* sp = sil + k0 + 2 * i + kh; a0 += sp[0] * wv[i]; a1 += sp[1024] * wv[i]; a2 += sp[2048] * wv[i]; }
        }
        a0 += __shfl_xor(a0, 32); a1 += __shfl_xor(a1, 32); a2 += __shfl_xor(a2, 32);
        float* red = (float*)c.lds;
        if (kh == 0) { red[(c.wave * 3 + 0) * 32 + c.lane] = a0; red[(c.wave * 3 + 1) * 32 + c.lane] = a1; red[(c.wave * 3 + 2) * 32 + c.lane] = a2; }
        __syncthreads();
        if (c.tid < 96) { const int v = c.tid >> 5, l = c.tid & 31; float s = 0.f;
#pragma unroll
            for (int w = 0; w < 8; ++w) s += red[(w * 3 + v) * 32 + l];
            mod[v * 6144 + cgp * 32 + l] = s + p.b_mod[cgp * 32 + l]; }
        __syncthreads();
    }
    const int gt = c.bid * 512 + c.tid;
    if (gt < 128 * 64) { const int pos = gt >> 6, i = gt & 63; const float inv = powf(10000.f, -(float)i / 64.f); float s, co; sincosf((float)pos * inv, &s, &co);
        ((float2*)(ws + WS_TABR))[gt] = make_float2(co, s); }
    else if (gt < 128 * 64 + 128 * 16) { const int q = gt - 128 * 64, pos = q >> 4, i = q & 15; const float inv = powf(10000.f, -(float)i / 16.f); float s, co; sincosf((float)pos * inv, &s, &co);
        ((float2*)(ws + WS_TABD))[q] = make_float2(co, s); }
    else if (gt < 128 * 80 + 8) { const int q = gt - 128 * 80; const float xl = p.ret_decay[q]; ((float*)(ws + WS_SCAL))[q] = -log1pf(expf(-xl)); }
    else if (gt >= 128 * 80 + 64 && gt < 128 * 80 + 128) {
        const int i = gt - (128 * 80 + 64); const float s01 = wave_sum(p.dlam[i] * p.dlam[64 + i]), s23 = wave_sum(p.dlam[128 + i] * p.dlam[192 + i]);
        if (i == 0) ((float*)(ws + WS_SCAL))[8] = expf(s01) - expf(s23) + 0.2f; }
    else if (gt >= 128 * 80 + 128 && gt < 128 * 80 + 192) {
        const int i = gt - (128 * 80 + 128); float gq = fabsf(p.dq_g[i]), gk = fabsf(p.dk_g[i]);
#pragma unroll
        for (int o = 1; o < 64; o <<= 1) { gq = fmaxf(gq, __shfl_xor(gq, o)); gk = fmaxf(gk, __shfl_xor(gk, o)); }
        if (i == 0) ((float*)(ws + WS_SCAL))[9] = 64.f * 1.02f * gq * gk * (att::SCALE * LOG2E); }
}

constexpr int Q1_TILES = NE * 64, Q2_TILES = NE * 32;
DEVI TrTile conv_tile(const Params& p, int qsel, int t) {
    TrTile tt;
    if (qsel == 0) { const int e = t >> 6, r = t & 63; tt.W = p.w1 + (size_t)e * 1024 * 2048; tt.WT = (bf16_t*)(p.ws + WS_W1) + (size_t)e * 2048 * 1024; tt.K = 1024; tt.N = 2048; tt.k0 = (r >> 3) * 128; tt.n0 = (r & 7) * 256; tt.perm = 1; }
    else { const int e = t >> 5, r = t & 31; tt.W = p.w2 + (size_t)e * 1024 * 1024; tt.WT = (bf16_t*)(p.ws + WS_W2) + (size_t)e * 1024 * 1024; tt.K = 1024; tt.N = 1024; tt.k0 = (r >> 2) * 128; tt.n0 = (r & 3) * 256; tt.perm = 0; }
    return tt;
}
DEVI void conv_run(const Params& p, const Ctx& c, int qsel, bool peek, bool stoppable) {
    unsigned* Tl = (unsigned*)c.lds; int* qs = (int*)(c.lds + 65536);
    int* q = (int*)(p.ws + WS_Q) + 64 * qsel; const int lim = qsel ? Q2_TILES : Q1_TILES;
    __syncthreads();
    const int* flagp = (const int*)(p.ws + WS_Q) + 128; int flg = 0; bool live = true;
    int pre = lim;
    if (c.tid == 0) {
        int t0 = lim, t1 = lim;
        if ((!peek || __hip_atomic_load(q, __ATOMIC_RELAXED, __HIP_MEMORY_SCOPE_AGENT) < lim) && !(stoppable && __hip_atomic_load(flagp, __ATOMIC_RELAXED, __HIP_MEMORY_SCOPE_AGENT) != 0)) { t0 = (int)atomicInc((unsigned*)q, 0xFFFFFFFFu); t1 = (int)atomicInc((unsigned*)q, 0xFFFFFFFFu); pre = (int)atomicInc((unsigned*)q, 0xFFFFFFFFu); }
        qs[0] = t0 < lim ? t0 : -1; qs[1] = t1 < lim ? t1 : -1; }
    __syncthreads();
    int ia = __builtin_amdgcn_readfirstlane(qs[0]), ib = __builtin_amdgcn_readfirstlane(qs[1]);
    if (ia < 0) return;
    f32x4 va[16], vb[16];
    TrTile dummy; dummy.W = p.w1; dummy.WT = nullptr; dummy.K = 0; dummy.N = 0; dummy.k0 = 0; dummy.n0 = 0; dummy.perm = 0;
    TrTile ta = conv_tile(p, qsel, ia), tb = ib >= 0 ? conv_tile(p, qsel, ib) : dummy;
    tr_load(ta, va, c.tid);
    tr_load(tb, vb, c.tid);
    LDS_BAR();
#define CONV_STEP(IT, TT_, V) { tr_to_lds(V, Tl, c.tid); \
        if (c.tid == 0) { const bool ok = live && pre < lim; qs[0] = ok ? pre : -1; live = ok && flg == 0; if (live) pre = (int)atomicInc((unsigned*)q, 0xFFFFFFFFu); \
                          if (stoppable) flg = __hip_atomic_load(flagp, __ATOMIC_RELAXED, __HIP_MEMORY_SCOPE_AGENT); } \
        LDS_BAR(); \
        const int nx = __builtin_amdgcn_readfirstlane(qs[0]); const TrTile done = TT_; TT_ = nx >= 0 ? conv_tile(p, qsel, nx) : dummy; \
        tr_load(TT_, V, c.tid); \
        tr_store(done, Tl, c.tid); IT = nx; \
        LDS_BAR(); }
    CONV_STEP(ia, ta, va)
    if (ib >= 0) {
        CONV_STEP(ib, tb, vb)
        while (ia >= 0) {
            CONV_STEP(ia, ta, va)
            if (ib < 0) break;
            CONV_STEP(ib, tb, vb)
        }
    }
#undef CONV_STEP
}

DEVI void phase_hl(const Params& p, const Ctx& c) {
    const float* mod = (const float*)(p.ws + WS_MOD); bf16_t* HL = (bf16_t*)(p.ws + WS_HL);
    for (int r = c.gw; r < TT; r += c.NGW) {
        const int b = r / SEQ, s = r % SEQ; const bool isctx = s < CTXL;
        const float* src = isctx ? p.ctx + ((size_t)b * CTXL + s) * DM : p.x + ((size_t)b * LSEQ + (s - CTXL)) * DM;
        const float* mv = mod + (isctx ? 2 : b) * 6144;
        const f32x4* xr = (const f32x4*)src + c.lane; f32x4 v[4]; float ss = 0.f;
#pragma unroll
        for (int j = 0; j < 4; ++j) { v[j] = xr[64 * j]; ss += (v[j][0] * v[j][0] + v[j][1] * v[j][1]) + (v[j][2] * v[j][2] + v[j][3] * v[j][3]); }
        const float rstd = __builtin_amdgcn_rsqf(wave_sum(ss) * (1.f / DM) + EPS);
        u32x2* o8 = (u32x2*)(HL + (size_t)r * DM) + c.lane;
#pragma unroll
        for (int j = 0; j < 4; ++j) { const int k = 4 * c.lane + 256 * j;
            const f32x4 g = *(const f32x4*)(p.norm1_g + k), sh = *(const f32x4*)(mv + k), sc = *(const f32x4*)(mv + 1024 + k);
            const f32x4 y = (v[j] * rstd * g) * (sc + 1.f) + sh; u32x2 w; w.x = pk2(y[0], y[1]); w.y = pk2(y[2], y[3]); o8[64 * j] = w; }
    }
}

DEVI void phase_post(const Params& p, const Ctx& c) {
    bf16_t* P = (bf16_t*)(p.ws + WS_P); const float2* tabR = (const float2*)(p.ws + WS_TABR); const float2* tabD = (const float2*)(p.ws + WS_TABD);
    for (int r = c.gw; r < TT; r += c.NGW) {
        const int s = r % SEQ; const bool lat = s >= CTXL; const int tpos = lat ? s - CTXL : 0; const int prow = tpos >> 6, pcol = tpos & 63;
        bf16_t* pr = P + (size_t)r * NP;
        if (lat) {
            const int blk = c.lane >> 3, i8 = (c.lane & 7) * 8; const int pos = (blk & 1) ? pcol : prow;
            bf16_t* q1 = pr + C_RQ + blk * 128 + i8; const u32x4 a = *(const u32x4*)q1, bq = *(const u32x4*)(q1 + 64);
            const unsigned aw[4] = {a.x, a.y, a.z, a.w}, bw[4] = {bq.x, bq.y, bq.z, bq.w}; unsigned o1[4], o2[4];
#pragma unroll
            for (int e = 0; e < 4; ++e) { const float2 t0 = tabR[pos * 64 + i8 + 2 * e], t1 = tabR[pos * 64 + i8 + 2 * e + 1];
                const float x1a = lo_f(aw[e]), x1b = hi_f(aw[e]), x2a = lo_f(bw[e]), x2b = hi_f(bw[e]);
                o1[e] = pk2((x1a * t0.x - x2a * t0.y) * 0.0625f, (x1b * t1.x - x2b * t1.y) * 0.0625f);
                o2[e] = pk2((x1a * t0.y + x2a * t0.x) * 0.0625f, (x1b * t1.y + x2b * t1.x) * 0.0625f); }
            *(u32x4*)q1 = (u32x4){o1[0], o1[1], o1[2], o1[3]}; *(u32x4*)(q1 + 64) = (u32x4){o2[0], o2[1], o2[2], o2[3]};
            {
                const int bb = r / SEQ, hq = blk >> 1, d0 = (blk & 1) * 128 + i8, cc = s >> 7, ii = s & 127;
                bf16_t* QFp = (bf16_t*)(p.ws + WS_DV);
                *(u32x4*)(QFp + ret::qf_index(bb, hq, cc, ii >> 4, d0 >> 5, (d0 >> 3) & 3, ii & 15)) = (u32x4){o1[0], o1[1], o1[2], o1[3]};
                *(u32x4*)(QFp + ret::qf_index(bb, hq, cc, ii >> 4, (d0 >> 5) + 2, (d0 >> 3) & 3, ii & 15)) = (u32x4){o2[0], o2[1], o2[2], o2[3]};
            }
        }
#pragma unroll
        for (int which = 0; which < 2; ++which) {
            if (which == 0 && !lat) continue;
            const float* gq = which ? p.dk_g : p.dq_g;
            const int q4 = c.lane & 3; bf16_t* dp = pr + (which ? C_DK : C_DQ) + (c.lane >> 2) * 64 + q4 * 16;
            const u32x4 a = *(const u32x4*)dp, bq = *(const u32x4*)(dp + 8); const unsigned wv[8] = {a.x, a.y, a.z, a.w, bq.x, bq.y, bq.z, bq.w};
            float v[16]; float ss = 0.f;
#pragma unroll
            for (int e = 0; e < 8; ++e) { v[2 * e] = lo_f(wv[e]); v[2 * e + 1] = hi_f(wv[e]); ss += v[2 * e] * v[2 * e] + v[2 * e + 1] * v[2 * e + 1]; }
            ss += __shfl_xor(ss, 1); ss += __shfl_xor(ss, 2);
            const float rs = __builtin_amdgcn_rsqf(ss * (1.f / 64.f) + EPS) * (which ? 1.f : att::SCALE * LOG2E);
            const int pos = (q4 & 2) ? pcol : prow; unsigned ow[8]; float y[16];
#pragma unroll
            for (int e = 0; e < 16; ++e) y[e] = v[e] * rs * gq[q4 * 16 + e];
#pragma unroll
            for (int e = 0; e < 16; ++e) { const float other = __shfl_xor(y[e], 1); const float2 t = tabD[pos * 16 + e];
                y[e] = (q4 & 1) ? (other * t.y + y[e] * t.x) : (y[e] * t.x - other * t.y); }
#pragma unroll
            for (int e = 0; e < 8; ++e) ow[e] = pk2(y[2 * e], y[2 * e + 1]);
            *(u32x4*)dp = (u32x4){ow[0], ow[1], ow[2], ow[3]}; *(u32x4*)(dp + 8) = (u32x4){ow[4], ow[5], ow[6], ow[7]};
        }
    }
    bf16_t* KT = (bf16_t*)(p.ws + WS_KT); bf16_t* VT = (bf16_t*)(p.ws + WS_VT);
    bf16_t* Tl = (bf16_t*)c.lds;
    constexpr int TLD = 72;
    constexpr int NU = NB * 132 * 24;
    const int tok = c.tid >> 3, c8 = (c.tid & 7) * 8, wsw = (c.tid & 7) << 3;
    auto unit_src = [&](int u) { const int cb = u % 24, tb = (u / 24) % 132, b = u / (24 * 132); const int colbase = cb < 8 ? C_RK + cb * 128 : C_RV + (cb - 8) * 128;
        return P + ((size_t)b * SEQ + tb * 64 + tok) * NP + colbase + c8; };
    u32x4 a, bq;
    { bf16_t* s0 = unit_src(c.bid < NU ? c.bid : NU - 1); a = *(const u32x4*)s0; bq = *(const u32x4*)(s0 + 64); }
    for (int u = c.bid; u < NU; u += c.G) {
        const int cb = u % 24, tb = (u / 24) % 132, b = u / (24 * 132);
        const int s = tb * 64 + tok; const bool isk = cb < 8;
        bf16_t* src = unit_src(u);
        u32x4 an, bn; { const int un = u + c.G; bf16_t* sn = unit_src(un < NU ? un : NU - 1); an = *(const u32x4*)sn; bn = *(const u32x4*)(sn + 64); }
        if (isk) {
            const bool lat = s >= CTXL; const int tpos = lat ? s - CTXL : 0; const int pos = (cb & 1) ? (tpos & 63) : (tpos >> 6);
            const unsigned aw[4] = {a.x, a.y, a.z, a.w}, bw[4] = {bq.x, bq.y, bq.z, bq.w}; unsigned o1[4], o2[4];
#pragma unroll
            for (int e = 0; e < 4; ++e) { const float2 t0 = tabR[pos * 64 + c8 + 2 * e], t1 = tabR[pos * 64 + c8 + 2 * e + 1];
                const float x1a = lo_f(aw[e]), x1b = hi_f(aw[e]), x2a = lo_f(bw[e]), x2b = hi_f(bw[e]);
                o1[e] = pk2(x1a * t0.x - x2a * t0.y, x1b * t1.x - x2b * t1.y);
                o2[e] = pk2(x1a * t0.y + x2a * t0.x, x1b * t1.y + x2b * t1.x); }
            a = (u32x4){o1[0], o1[1], o1[2], o1[3]}; bq = (u32x4){o2[0], o2[1], o2[2], o2[3]};
            *(u32x4*)src = a; *(u32x4*)(src + 64) = bq;
        }
        { const unsigned aw[4] = {a.x, a.y, a.z, a.w}, bw[4] = {bq.x, bq.y, bq.z, bq.w}; const int tk = tok ^ wsw;
#pragma unroll
          for (int e = 0; e < 4; ++e) { Tl[(c8 + 2 * e) * TLD + tk] = (bf16_t)(aw[e] & 0xffffu); Tl[(c8 + 2 * e + 1) * TLD + tk] = (bf16_t)(aw[e] >> 16);
              Tl[(64 + c8 + 2 * e) * TLD + tk] = (bf16_t)(bw[e] & 0xffffu); Tl[(64 + c8 + 2 * e + 1) * TLD + tk] = (bf16_t)(bw[e] >> 16); } }
        LDS_BAR();
        if (isk) {
            const int col = c.tid & 127, tp = c.tid >> 7, sw = ((col >> 3) & 7) << 3; const u32x4 r0 = *(const u32x4*)(Tl + col * TLD + ((16 * tp) ^ sw)), r1 = *(const u32x4*)(Tl + col * TLD + ((16 * tp + 8) ^ sw));
            const int hk = cb >> 1, d = (cb & 1) * 128 + col, jb = (tb & 1) * 64 + 16 * tp;
            bf16_t* dst = KT + ret::ktf_index(b, hk, tb >> 1, d >> 5, jb >> 4, 0, d & 31);
            *(u32x4*)dst = r0; *(u32x4*)(dst + 32 * 8) = r1;
        } else {
          const int col = c.tid >> 2, t4 = (c.tid & 3) * 16, sw = ((col >> 3) & 7) << 3; const u32x4 r0 = *(const u32x4*)(Tl + col * TLD + (t4 ^ sw)), r1 = *(const u32x4*)(Tl + col * TLD + ((t4 + 8) ^ sw));
          bf16_t* dst = VT + ((size_t)b * 2048 + (cb - 8) * 128 + col) * SEQ + tb * 64 + t4;
          *(u32x4*)dst = r0; *(u32x4*)(dst + 8) = r1; }
        LDS_BAR();
        a = an; bq = bn;
    }
    __syncthreads();
}

DEVI int scan_map(int u, int G) { if (G != 256) return u; const int x = u & 7, j = u >> 3; return ((x + 8 * (j >> 4)) << 4) | (j & 15); }
DEVI void phase_mix(const Params& p, const Ctx& c) {
    const bf16_t* P = (const bf16_t*)(p.ws + WS_P); const bf16_t* KT = (const bf16_t*)(p.ws + WS_KT); const bf16_t* VT = (const bf16_t*)(p.ws + WS_VT);
    const float* scal = (const float*)(p.ws + WS_SCAL);
#ifndef MK_MIX_PROBE
#define MK_MIX_PROBE 0
#endif
#ifndef MK_MIX_ONLY
#define MK_MIX_ONLY 0
#endif
    const float lam = scal[8];
    const bool fixedref = __builtin_amdgcn_readfirstlane(__float_as_int(scal[9])) != 0 && scal[9] <= 60.f && scal[9] > 0.f;
    const bool attn_first = (c.G == 256) && (c.bid >= 128);
#define MIX_RET() do { for (int u = c.bid; u < 256; u += c.G) ret::scan_unit(scan_map(u & 255, c.G), (const bf16_t*)(p.ws + WS_DV), KT, VT, (bf16_t*)(p.ws + WS_OF), (bf16_t*)(p.ws + WS_OB), scal, c.lds); \
        for (int u = c.bid; u < 512; u += c.G) ret::intra_unit(u & 511, P, VT, (bf16_t*)(p.ws + WS_OI), scal, c.lds); } while (0)
    if (!attn_first) MIX_RET();
    for (int a_ = c.bid; a_ < 1024; a_ += c.G) { const int a = a_ & 1023;
        const int rr = a / c.G, wq = a % c.G; int bh, qb;
        if (c.G == 256) { const int xcd = wq & 7, j = wq >> 3; bh = xcd * 2 + (rr >> 1); qb = (rr & 1) * 32 + j; } else { bh = a >> 6; qb = a & 63; }
        const int b = bh >> 3, h = bh & 7;
        const bf16_t* Qb = P + ((size_t)b * SEQ + CTXL + qb * 128) * NP + C_DQ + h * 128;
        const bf16_t* Kh = P + ((size_t)b * SEQ) * NP + C_DK + h * 128;
        const bf16_t* Vh = P + ((size_t)b * SEQ) * NP + C_DV + h * 128;
        bf16_t* Ob = (bf16_t*)(p.ws + WS_OD) + ((size_t)b * LSEQ + qb * 128) * 1024 + h * 128;
        att::attn_unit(Qb, Kh, Vh, Ob, lam, fixedref, p.dn_g, c.lds);
    }
    if (attn_first) { __syncthreads(); MIX_RET(); }
#undef MIX_RET
}

DEVI void phase_retgate(const Params& p, const Ctx& c) {
    bf16_t* OI = (bf16_t*)(p.ws + WS_OI); const bf16_t* OF = (const bf16_t*)(p.ws + WS_OF); const bf16_t* OB = (const bf16_t*)(p.ws + WS_OB); const bf16_t* P = (const bf16_t*)(p.ws + WS_P);
    for (int it = c.gw; it < T * 4; it += c.NGW) {
        const int t = it >> 2, h = it & 3; const size_t off = (size_t)t * 2048 + h * 512 + c.lane * 8;
        const u32x4 a = *(const u32x4*)(OI + off), f = *(const u32x4*)(OF + off), bb = *(const u32x4*)(OB + off);
        const u32x4 rg = *(const u32x4*)(P + (size_t)rowc_of(t) * NP + C_RG + h * 512 + c.lane * 8);
        const unsigned aw[4] = {a.x, a.y, a.z, a.w}, fw[4] = {f.x, f.y, f.z, f.w}, bw[4] = {bb.x, bb.y, bb.z, bb.w}, gw_[4] = {rg.x, rg.y, rg.z, rg.w};
        float v[8]; float ss = 0.f;
#pragma unroll
        for (int e = 0; e < 4; ++e) { v[2 * e] = lo_f(aw[e]) + lo_f(fw[e]) + lo_f(bw[e]); v[2 * e + 1] = hi_f(aw[e]) + hi_f(fw[e]) + hi_f(bw[e]); ss += v[2 * e] * v[2 * e] + v[2 * e + 1] * v[2 * e + 1]; }
        const float rs = __builtin_amdgcn_rsqf(wave_sum(ss) * (1.f / 512.f) + EPS);
        const float* g = p.ret_norm_g + h * 512 + c.lane * 8; unsigned ow[4];
#pragma unroll
        for (int e = 0; e < 4; ++e) ow[e] = pk2(v[2 * e] * rs * g[2 * e] * siluf_(lo_f(gw_[e])), v[2 * e + 1] * rs * g[2 * e + 1] * siluf_(hi_f(gw_[e])));
        *(u32x4*)(OI + off) = (u32x4){ow[0], ow[1], ow[2], ow[3]};
    }
}

DEVI void phase_route(const Params& p, const Ctx& c) {
    constexpr int RW_LD = 1028;
    float* rwT = (float*)c.lds;
    for (int i = c.tid; i < 8 * 1024; i += 512) {
        const f32x4 w4 = ((const f32x4*)p.router_w)[i]; const int k = i >> 3, e0 = (i & 7) * 4;
        rwT[(e0 + 0) * RW_LD + k] = w4[0]; rwT[(e0 + 1) * RW_LD + k] = w4[1]; rwT[(e0 + 2) * RW_LD + k] = w4[2]; rwT[(e0 + 3) * RW_LD + k] = w4[3]; }
    __syncthreads();
    const float* mod = (const float*)(p.ws + WS_MOD); bf16_t* H2 = (bf16_t*)(p.ws + WS_HL);
    int* cnt = (int*)(p.ws + WS_CNT); int* ltok = (int*)(p.ws + WS_LTOK); float* lgate = (float*)(p.ws + WS_LGATE); int* pos = (int*)(p.ws + WS_POS);
    int2* stash = (int2*)(c.lds + 135168) + c.wave * 64; int* stok = (int*)(c.lds + 135168 + 8 * 64 * 8) + c.wave * 16; int nst = 0;
    for (int t = c.gw; t < T; t += c.NGW) {
        const int b = t >> 13; const float* mv = mod + b * 6144;
        const f32x4* xr = (const f32x4*)(p.out + (size_t)t * DM) + c.lane; f32x4 v[4]; float ss = 0.f;
#pragma unroll
        for (int j = 0; j < 4; ++j) { v[j] = xr[64 * j]; ss += (v[j][0] * v[j][0] + v[j][1] * v[j][1]) + (v[j][2] * v[j][2] + v[j][3] * v[j][3]); }
        const float rstd = __builtin_amdgcn_rsqf(wave_sum(ss) * (1.f / DM) + EPS);
        u32x2* o8 = (u32x2*)(H2 + (size_t)t * DM) + c.lane;
#pragma unroll
        for (int j = 0; j < 4; ++j) { const int k = 4 * c.lane + 256 * j;
            const f32x4 g = *(const f32x4*)(p.norm2_g + k), sh = *(const f32x4*)(mv + 3072 + k), sc = *(const f32x4*)(mv + 4096 + k);
            v[j] = (v[j] * rstd * g) * (sc + 1.f) + sh; u32x2 w; w.x = pk2(v[j][0], v[j][1]); w.y = pk2(v[j][2], v[j][3]); o8[64 * j] = w; }
        float a[32];
#pragma unroll
        for (int e = 0; e < 32; ++e) { float s = 0.f;
#pragma unroll
            for (int j = 0; j < 4; ++j) { const f32x4 wv = *(const f32x4*)(rwT + e * RW_LD + 4 * c.lane + 256 * j); s += (v[j][0] * wv[0] + v[j][1] * wv[1]) + (v[j][2] * wv[2] + v[j][3] * wv[3]); }
            a[e] = s; if ((e & 3) == 3) __builtin_amdgcn_sched_barrier(0); }
#define HALVE(N, OFF) _Pragma("unroll") for (int i = 0; i < (N) / 2; ++i) { const bool up = (c.lane & (OFF)) != 0; const float snd = up ? a[i] : a[i + (N) / 2]; const float rcv = __shfl_xor(snd, (OFF)); a[i] = (up ? a[i + (N) / 2] : a[i]) + rcv; }
        HALVE(32, 32) HALVE(16, 16) HALVE(8, 8) HALVE(4, 4) HALVE(2, 2)
#undef HALVE
        float logit = a[0] + __shfl_xor(a[0], 1); const int myE = c.lane >> 1; logit += p.router_b[myE];
        float tv[4]; int ti[4]; float cur = logit;
#pragma unroll
        for (int k = 0; k < 4; ++k) { float bv = cur; int bi = myE;
#pragma unroll
            for (int o = 1; o < 64; o <<= 1) { const float ov = __shfl_xor(bv, o); const int oi = __shfl_xor(bi, o); if (ov > bv || (ov == bv && oi < bi)) { bv = ov; bi = oi; } }
            tv[k] = bv; ti[k] = bi; if (myE == bi) cur = -3.0e38f; }
        const float e1 = __expf(tv[1] - tv[0]), e2 = __expf(tv[2] - tv[0]), e3 = __expf(tv[3] - tv[0]); const float inv = 1.f / (1.f + e1 + e2 + e3);
        if (c.lane < 4) { const int k = c.lane; const int e = k == 0 ? ti[0] : (k == 1 ? ti[1] : (k == 2 ? ti[2] : ti[3])); const float g = (k == 0 ? 1.f : (k == 1 ? e1 : (k == 2 ? e2 : e3))) * inv;
            stash[nst * 4 + k] = make_int2(e, __float_as_int(g)); }
        if (c.lane == 0) stok[nst] = t;
        ++nst;
        if (nst == 16 || t + c.NGW >= T) {
            asm volatile("s_waitcnt lgkmcnt(0)" ::: "memory");
            if (c.lane < nst * 4) { const int2 eg = stash[c.lane]; const int tt = stok[c.lane >> 2], e = eg.x;
                const int slot = atomicAdd(cnt + e, 1); ltok[e * CAP + slot] = tt; lgate[e * CAP + slot] = __int_as_float(eg.y); pos[tt * 4 + (c.lane & 3)] = e * CAP + slot; }
            asm volatile("s_waitcnt lgkmcnt(0)" ::: "memory");
            nst = 0; }
    }
    __syncthreads();
}

DEVI int build_tiles(const Params& p, const Ctx& c) {
    LAS int* tb = (LAS int*)(c.lds + LDS_TAB);
    const int* cnt = (const int*)(p.ws + WS_CNT);
    if (c.tid < 32) tb[576 + c.tid] = cnt[c.tid];
    __syncthreads();
    if (c.tid < 32) {
        const int e = c.tid; int base = 0, tot = 0;
        for (int j = 0; j < 32; ++j) { const int nj = (tb[576 + j] + 255) >> 8; base += j < e ? nj : 0; tot += nj; }
        const int n = (tb[576 + e] + 255) >> 8; tb[608 + e] = base;
        for (int i = 0; i < n; ++i) { tb[base + i] = e; tb[288 + base + i] = i * 256; }
        if (e == 0) tb[640] = tot; }
    __syncthreads();
    return tb[640];
}

DEVI void phase_combine(const Params& p, const Ctx& c) {
    const int NT = build_tiles(p, c); (void)NT;
    const int lane = lane_id_fresh();
    LAS int* tb = (LAS int*)(c.lds + LDS_TAB);
    const float* mod = (const float*)(p.ws + WS_MOD); const int* pos = (const int*)(p.ws + WS_POS); const bf16_t* Y = (const bf16_t*)(p.ws + WS_Y);
    for (int t = c.gw; t < T; t += c.NGW) {
        const int b = t >> 13; size_t yr[4];
#pragma unroll
        for (int k = 0; k < 4; ++k) { const int pp = pos[t * 4 + k]; const int e = pp >> 14, slot = pp & (CAP - 1); yr[k] = (size_t)(tb[608 + e] * 256 + slot) * 1024; }
        float* orow = p.out + (size_t)t * DM;
#pragma unroll
        for (int j = 0; j < 2; ++j) { const int k0 = lane * 8 + 512 * j; float s[8] = {0.f, 0.f, 0.f, 0.f, 0.f, 0.f, 0.f, 0.f};
#pragma unroll
            for (int k = 0; k < 4; ++k) { const u32x4 y = *(const u32x4*)(Y + yr[k] + k0); s[0] += lo_f(y.x); s[1] += hi_f(y.x); s[2] += lo_f(y.y); s[3] += hi_f(y.y); s[4] += lo_f(y.z); s[5] += hi_f(y.z); s[6] += lo_f(y.w); s[7] += hi_f(y.w); }
            const float* gp = mod + b * 6144 + 5120 + k0;
            f32x4 x0 = *(const f32x4*)(orow + k0), x1 = *(const f32x4*)(orow + k0 + 4);
            const f32x4 g0 = *(const f32x4*)gp, g1 = *(const f32x4*)(gp + 4);
            x0 += g0 * (f32x4){s[0], s[1], s[2], s[3]}; x1 += g1 * (f32x4){s[4], s[5], s[6], s[7]};
            *(f32x4*)(orow + k0) = x0; *(f32x4*)(orow + k0 + 4) = x1; }
    }
}

__global__ void __launch_bounds__(512, 2) mk_fwd(Params p) {
    extern __shared__ __attribute__((aligned(16))) unsigned char lds_raw[];
    Ctx c; c.tid = threadIdx.x; c.lane = c.tid & 63; c.wave = __builtin_amdgcn_readfirstlane(c.tid >> 6); c.G = gridDim.x; c.bid = blockIdx.x;
    c.gw = c.bid * 8 + c.wave; c.NGW = c.G * 8; c.lds = (char*)lds_raw;
    LAS unsigned char* lds = (LAS unsigned char*)lds_raw;
    unsigned char* ws = p.ws;
    const int lo = p.ph_lo, hi = p.ph_hi;
#define IN(k) (lo <= (k) && (k) < hi)
#ifndef MK_REPEAT_PHASE
#define MK_REPEAT_PHASE (-1)
#define MK_REPEAT_N 0
#endif
#define REPS(k)
    volatile LAS unsigned* bst = (volatile LAS unsigned*)(lds + LDS_BYTES - 16);
    if (c.tid < 4) bst[c.tid] = 0u;
    __syncthreads();
    if (lo == 0 && hi == NPH) {
        { const int i = c.bid * 512 + c.tid; if (i < (int)(WS_ZERO_BYTES / 4)) { ((unsigned*)ws)[i] = 0u; __threadfence(); } }
        cg::this_grid().sync();
    }
    XcdBarrier xbar = xcd_barrier_post((unsigned*)(ws + WS_BAR), bst);
#define SEAM(k) do { if (IN(k) && IN((k) + 1)) xcd_barrier(xbar); } while (0)
#define PH0 { phase_prep(p, c); }
#define PH1 { phase_hl(p, c); }
#define PH2 { const int ncv = pg8::conv_count((TT / 256) * (NP / 256), c.G); \
        if (c.bid < c.G - ncv) { pg8::ProbDense S; S.init(ws + WS_HL, ws + WS_WIN, TT, NP, 1024, c.G, c.bid, ncv); EpiStoreBf16 E{(bf16_t*)(ws + WS_P), NP}; pg8::gemm_phase(lds, S, E); \
            if (c.tid == 0) atomicAdd((int*)(ws + WS_Q) + 128, 1); conv_run(p, c, 0, true, false); } \
        else { conv_run(p, c, 0, false, false); conv_run(p, c, 1, false, true); } }
#define PH3 { phase_post(p, c); }
#define PH4 { phase_mix(p, c); }
#define PH5 { phase_retgate(p, c); }
#define PH6 { { pg8::ProbDense S; S.init(ws + WS_OI, ws + WS_WBR, T, 1024, 2048, c.G, c.bid); EpiGate1 E{(float*)(ws + WS_OF), (const bf16_t*)(ws + WS_P)}; pg8::gemm_phase(lds, S, E); } \
        __syncthreads(); \
        { pg8::ProbDense S; S.init(ws + WS_OD, ws + WS_WBD, T, 1024, 1024, c.G, c.bid); EpiGate2 E{(const float*)(ws + WS_OF), (bf16_t*)(ws + WS_OB), (const bf16_t*)(ws + WS_P)}; pg8::gemm_phase(lds, S, E); } }
#define PH7 { pg8::ProbDense S; S.init(ws + WS_OB, ws + WS_WOUT, T, 1024, 1024, c.G, c.bid); EpiResid E{p.x, p.out, (const float*)(ws + WS_MOD)}; pg8::gemm_phase(lds, S, E); }
#define PH8 { phase_route(p, c); }
#define PH9 { const int NT = build_tiles(p, c); LAS int* tb = (LAS int*)(c.lds + LDS_TAB); \
        const int ncv = pg8::conv_count(NT * 8, c.G); \
        if (c.bid < c.G - ncv) { pg8::ProbMoe S; S.A = (const char*)(ws + WS_HL); S.Bt = (const char*)(ws + WS_W1); S.K = 1024; S.nN = 8; S.NT = NT; S.G = c.G; S.c = c.bid; S.nconv = ncv; S.bstride = (size_t)2048 * 1024 * 2; \
            S.tile_e = tb; S.tile_s0 = tb + 288; S.cnt = tb + 576; S.ltok = (const int*)(ws + WS_LTOK); S.gather = true; \
            EpiSwiglu E{(bf16_t*)(ws + WS_ACT), p.b1}; pg8::gemm_phase(lds, S, E); } \
        conv_run(p, c, 1, c.bid < c.G - ncv, false); }
#define PH10 { const int NT = build_tiles(p, c); LAS int* tb = (LAS int*)(c.lds + LDS_TAB); \
        pg8::ProbMoe S; S.A = (const char*)(ws + WS_ACT); S.Bt = (const char*)(ws + WS_W2); S.K = 1024; S.nN = 4; S.NT = NT; S.G = c.G; S.c = c.bid; S.nconv = 0; S.bstride = (size_t)1024 * 1024 * 2; \
        S.tile_e = tb; S.tile_s0 = tb + 288; S.cnt = tb + 576; S.ltok = (const int*)(ws + WS_LTOK); S.gather = false; \
        EpiMoe2 E{(bf16_t*)(ws + WS_Y), p.b2, (const float*)(ws + WS_LGATE), tb + 288, tb + 576}; pg8::gemm_phase(lds, S, E); }
#define PH11 { phase_combine(p, c); }
#ifndef MK_DUP
#define MK_DUP (-1)
#endif
#ifndef MK_ONLY
#define MK_ONLY (-1)
#endif
#define RUN(k, BODY) do { if ((MK_ONLY < 0 || MK_ONLY == (k)) && IN(k)) { BODY if (MK_DUP == (k)) { xcd_barrier(xbar); BODY } } SEAM(k); } while (0)
    RUN(0, PH0); RUN(1, PH1); RUN(2, PH2); RUN(3, PH3);
    if (MK_DUP == 23 && IN(3)) { PH2 xcd_barrier(xbar); PH3 xcd_barrier(xbar); }
    RUN(4, PH4); RUN(5, PH5); RUN(6, PH6); RUN(7, PH7); RUN(8, PH8); RUN(9, PH9); RUN(10, PH10);
    if ((MK_ONLY < 0 || MK_ONLY == 11) && IN(11)) PH11
#undef IN
#undef SEAM
}


extern "C" void kernel_launch(void* const* d_in, const int* in_sizes, int n_in, void* d_out, int out_size, void* d_ws, size_t ws_size, hipStream_t stream) {
    static int grid = 0;
    if (grid == 0) {
        if (n_in != 24 || ws_size < WS_END) { fprintf(stderr, "kernel_launch: unexpected inputs (n_in %d, ws %zu, need %zu)\n", n_in, ws_size, (size_t)WS_END); grid = -1; return; }
        int dev = 0, cus = 0, per_cu = 0;
        (void)hipGetDevice(&dev); (void)hipDeviceGetAttribute(&cus, hipDeviceAttributeMultiprocessorCount, dev);
        if (hipFuncSetAttribute((const void*)mk_fwd, hipFuncAttributeMaxDynamicSharedMemorySize, LDS_BYTES) != hipSuccess) { fprintf(stderr, "kernel_launch: hipFuncSetAttribute failed\n"); grid = -1; return; }
        if (hipOccupancyMaxActiveBlocksPerMultiprocessor(&per_cu, (const void*)mk_fwd, 512, LDS_BYTES) != hipSuccess || per_cu < 1) { fprintf(stderr, "kernel_launch: occupancy query says %d\n", per_cu); per_cu = 1; }
        (void)hipGetLastError();
        grid = cus;
    }
    if (grid < 0) return;
#if !MK_ONE_LAUNCH
    (void)hipMemsetAsync((char*)d_ws, 0, WS_ZERO_BYTES, stream);
#endif
    Params p{};
    const float** pp = (const float**)&p;
    for (int i = 0; i < 24; ++i) pp[i] = (const float*)d_in[i];
    p.out = (float*)d_out; p.ws = (unsigned char*)d_ws;
#if MK_ONE_LAUNCH
    p.ph_lo = 0; p.ph_hi = NPH;
    void* args[] = {&p};
    hipError_t e = hipLaunchCooperativeKernel((const void*)mk_fwd, dim3(grid), dim3(512), args, LDS_BYTES, stream);
    if (e != hipSuccess) fprintf(stderr, "cooperative launch failed: %s (grid %d)\n", hipGetErrorString(e), grid);
#else
#ifndef MK_LAST_PHASE
#define MK_LAST_PHASE (NPH - 1)
#endif
    for (int ph = 0; ph <= MK_LAST_PHASE; ++ph) {
        p.ph_lo = ph; p.ph_hi = ph + 1;
        hipLaunchKernelGGL(mk_fwd, dim3(grid), dim3(512), LDS_BYTES, stream, p);
    }

#endif
}
```

```cpp
#include <hip/hip_runtime.h>
#include <hip/hip_cooperative_groups.h>
#include <cstdio>
#include <cstdint>
namespace cg = cooperative_groups;

#ifndef MK_ONE_LAUNCH
#define MK_ONE_LAUNCH 1
#endif

#define DEVI __device__ __forceinline__
#define LAS __attribute__((address_space(3)))
typedef unsigned short bf16_t;
typedef short bf16x8 __attribute__((ext_vector_type(8)));
typedef short s16x4 __attribute__((ext_vector_type(4)));
typedef float f32x4 __attribute__((ext_vector_type(4)));
typedef float f32x16 __attribute__((ext_vector_type(16)));
typedef unsigned u32x4 __attribute__((ext_vector_type(4)));
typedef unsigned u32x2 __attribute__((ext_vector_type(2)));

constexpr int NB = 2, LSEQ = 8192, CTXL = 256, SEQ = LSEQ + CTXL;
constexpr int T = NB * LSEQ;
constexpr int TT = NB * SEQ;
constexpr int DM = 1024, NP = 11264;
constexpr int C_RQ = 0, C_RK = 1024, C_RV = 2048, C_RG = 4096, C_DQ = 6144, C_DK = 7168, C_DV = 8192, C_GA = 9216, C_GB = 10240;
constexpr int NE = 32, CAP = 16384, MAXTILES = 288;
constexpr float EPS = 1e-6f;
constexpr float LOG2E = 1.4426950408889634f;

constexpr size_t al256(size_t x) { return (x + 255) / 256 * 256; }
constexpr size_t WS_CNT = 0;
constexpr size_t WS_Q = 1024;
constexpr size_t WS_BAR = 4096;
constexpr size_t WS_ZERO_BYTES = 4096 + 16384;
constexpr size_t WS_MOD = WS_ZERO_BYTES;
constexpr size_t WS_SCAL = al256(WS_MOD + 3 * 6144 * 4);
constexpr size_t WS_TABR = WS_SCAL + 256;
constexpr size_t WS_TABD = WS_TABR + 128 * 64 * 8;
constexpr size_t WS_WIN = al256(WS_TABD + 128 * 16 * 8);
constexpr size_t WS_WBR = WS_WIN + (size_t)NP * DM * 2;
constexpr size_t WS_WBD = WS_WBR + (size_t)1024 * 2048 * 2;
constexpr size_t WS_WOUT = WS_WBD + (size_t)1024 * 1024 * 2;
constexpr size_t WS_W1 = WS_WOUT + (size_t)1024 * 1024 * 2;
constexpr size_t WS_W2 = WS_W1 + (size_t)NE * 2048 * 1024 * 2;
constexpr size_t WS_HL = WS_W2 + (size_t)NE * 1024 * 1024 * 2;
constexpr size_t WS_P = WS_HL + (size_t)TT * DM * 2;
constexpr size_t WS_KT = WS_P + (size_t)TT * NP * 2;
constexpr size_t WS_VT = WS_KT + (size_t)NB * 1024 * SEQ * 2;
constexpr size_t WS_OI = WS_VT + (size_t)NB * 2048 * SEQ * 2;
constexpr size_t WS_OF = WS_OI + (size_t)T * 2048 * 2;
constexpr size_t WS_OB = WS_OF + (size_t)T * 2048 * 2;
constexpr size_t WS_OD = WS_OB + (size_t)T * 2048 * 2;
constexpr size_t WS_LTOK = WS_OD + (size_t)T * 1024 * 2;
constexpr size_t WS_LGATE = WS_LTOK + (size_t)NE * CAP * 4;
constexpr size_t WS_POS = WS_LGATE + (size_t)NE * CAP * 4;
constexpr size_t WS_DV = WS_POS + (size_t)T * 4 * 4;
constexpr size_t WS_DUMMY = WS_DV + (size_t)NB * 8 * SEQ * 128 * 2;
constexpr size_t WS_END = WS_DUMMY + (size_t)128 * 2048 * 2;
constexpr size_t WS_ACT = WS_P;
constexpr size_t WS_Y = WS_P + (size_t)MAXTILES * 256 * 1024 * 2;
static_assert(WS_Y + (size_t)MAXTILES * 256 * 1024 * 2 <= WS_KT, "act/y overlay must fit in P");
static_assert(WS_END <= ((size_t)1 << 30), "workspace must fit 1 GiB");

struct Params {
    const float *x, *c, *ctx, *c_ctx, *norm1_g, *norm2_g, *w_mod, *b_mod, *w_in, *ret_decay, *ret_norm_g, *dq_g, *dk_g, *dlam, *dn_g,
        *w_br_ret, *w_br_diff, *w_out, *router_w, *router_b, *w1, *b1, *w2, *b2;
    float* out; unsigned char* ws;
    int ph_lo, ph_hi;
};

DEVI float bf2f(unsigned u) { return __uint_as_float(u << 16); }
DEVI unsigned f2bf(float f) { unsigned u = __float_as_uint(f); return (u + 0x7fffu + ((u >> 16) & 1u)) >> 16; }
typedef __bf16 bf16x2_t __attribute__((ext_vector_type(2)));
typedef float f32x2_t __attribute__((ext_vector_type(2)));
DEVI unsigned pk2(float lo, float hi) { const f32x2_t v = {lo, hi}; const bf16x2_t b = __builtin_convertvector(v, bf16x2_t); return __builtin_bit_cast(unsigned, b); }
DEVI unsigned pk2a(float lo, float hi) { unsigned r; asm volatile("v_cvt_pk_bf16_f32 %0, %1, %2" : "=v"(r) : "v"(lo), "v"(hi)); return r; }
DEVI float lo_f(unsigned w) { return __uint_as_float(w << 16); }
DEVI float hi_f(unsigned w) { return __uint_as_float(w & 0xffff0000u); }
DEVI float wave_sum(float v) {
#pragma unroll
    for (int o = 1; o < 64; o <<= 1) v += __shfl_xor(v, o);
    return v;
}
DEVI int lane_id_fresh() { int l; asm volatile("v_mbcnt_lo_u32_b32 %0, -1, 0\n\tv_mbcnt_hi_u32_b32 %0, -1, %0" : "=v"(l)); return l; }
DEVI float sigmoidf_(float x) { return __builtin_amdgcn_rcpf(1.f + __builtin_amdgcn_exp2f(-x * LOG2E)); }
DEVI float siluf_(float x) { return x * sigmoidf_(x); }
#define LDS_WAIT() asm volatile("s_waitcnt lgkmcnt(0)" ::: "memory")
#define VM_WAIT() asm volatile("s_waitcnt vmcnt(0)" ::: "memory")


#define XB_TMO      128
#define XB_XCNT(j)  (256  + 64 * (j))
#define XB_XSUB(j)  (1280 + 64 * (j))
#define XB_XGEN(j)  (2304 + 64 * (j))
#define XB_TOP      3328
#define XB_TOPGEN   3392
#define XCD_BAR_WORDS 3456
#define XB_SPIN_CAP (1u << 18)
DEVI unsigned xb_ld(unsigned* p)              { return __hip_atomic_load(p, __ATOMIC_RELAXED, __HIP_MEMORY_SCOPE_AGENT); }
DEVI unsigned xb_add(unsigned* p, unsigned v) { return __hip_atomic_fetch_add(p, v, __ATOMIC_RELAXED, __HIP_MEMORY_SCOPE_AGENT); }
DEVI unsigned xb_xcc_id() { return (unsigned)__builtin_amdgcn_s_getreg((3 << 11) | 20) & 0xFu; }
#define XB_SPIN(cond, bar) do { unsigned _sp = 0; while (cond) { __builtin_amdgcn_s_sleep(1); \
    if ((++_sp & 255u) == 0u) { if (xb_ld(&(bar)[XB_TMO])) break; if (_sp > XB_SPIN_CAP) { atomicAdd(&(bar)[XB_TMO], 1u); break; } } } } while (0)
struct XcdBarrier { unsigned* bar; unsigned x; volatile LAS unsigned* st; };
DEVI XcdBarrier xcd_barrier_post(unsigned* bar, volatile LAS unsigned* st) {
    XcdBarrier b; b.bar = bar; b.x = xb_xcc_id(); b.st = st;
    if (threadIdx.x == 0) (void)xb_add(&bar[XB_XCNT(b.x)], 1u);
    return b;
}
DEVI void xcd_barrier_complete(unsigned* bar, unsigned x, unsigned& nloc, unsigned& nx) {
    const unsigned G = gridDim.x * gridDim.y * gridDim.z;
    unsigned sum, cnt, mine, sp = 0u;
    for (;;) {
        sum = 0u; cnt = 0u; mine = 0u;
#pragma unroll
        for (unsigned j = 0; j < 16; ++j) { const unsigned c = xb_ld(&bar[XB_XCNT(j)]); sum += c; cnt += (c > 0u) ? 1u : 0u; mine = (j == x) ? c : mine; }
        if (sum == G) break;
        __builtin_amdgcn_s_sleep(1);
        if ((++sp & 255u) == 0u) { if (xb_ld(&bar[XB_TMO])) break; if (sp > XB_SPIN_CAP) { atomicAdd(&bar[XB_TMO], 1u); break; } }
    }
    nloc = mine > 0u ? mine : 1u; nx = cnt > 0u ? cnt : 1u;
}
DEVI void xcd_barrier(const XcdBarrier& b) {
    asm volatile("s_waitcnt vmcnt(0)" ::: "memory");
    __syncthreads();
    if (threadIdx.x == 0) {
        unsigned* bar = b.bar;
        __builtin_amdgcn_s_waitcnt(0);
        unsigned nloc = b.st[0], nx = b.st[1];
        if (nloc == 0u) { xcd_barrier_complete(bar, b.x, nloc, nx); b.st[0] = nloc; b.st[1] = nx; }
        const unsigned old = xb_add(&bar[XB_XSUB(b.x)], 1u);
        const unsigned gen = old / nloc;
        if (old + 1u == (gen + 1u) * nloc) {
            __builtin_amdgcn_fence(__ATOMIC_RELEASE, "agent");
            asm volatile("s_waitcnt vmcnt(0)" ::: "memory");
            const unsigned og = xb_add(&bar[XB_TOP], 1u);
            const unsigned tg = og / nx;
            if (og + 1u == (tg + 1u) * nx) xb_add(&bar[XB_TOPGEN], 1u);
            else XB_SPIN(xb_ld(&bar[XB_TOPGEN]) == tg, bar);
            __builtin_amdgcn_fence(__ATOMIC_ACQUIRE, "agent");
            xb_add(&bar[XB_XGEN(b.x)], 1u);
            asm volatile("s_waitcnt vmcnt(0)" ::: "memory");
        } else {
            XB_SPIN(xb_ld(&bar[XB_XGEN(b.x)]) == gen, bar);
            __builtin_amdgcn_fence(__ATOMIC_ACQUIRE, "agent");
            asm volatile("s_waitcnt vmcnt(0)" ::: "memory");
        }
    }
    __syncthreads();
}

namespace pg8 {
constexpr int BM = 256, BK = 64, HALF = 128, HTB = HALF * BK * 2, STAGE_BYTES = 8 * HTB, NXCD = 8, WGM = 8;
__host__ __device__ __forceinline__ int lds_byte(int r, int c) { const int st = (r >> 4) * 2 + (c >> 5), rr = r & 15, cc = c & 31, ob = rr * 64 + cc * 2; return st * 1024 + (ob ^ (((ob >> 9) & 1) << 5)); }
__host__ __device__ __forceinline__ void stage_rc(int b, int& R, int& C) { const int st = b / 1024, sb = b % 1024, swz = sb ^ (((sb >> 9) & 1) << 5); R = (st >> 1) * 16 + swz / 64; C = (st & 1) * 32 + (swz % 64) / 2; }
__host__ __device__ __forceinline__ int perm32(int rho) { const int n = rho >> 4, i = rho & 15; return 8 * (i >> 2) + 4 * n + (i & 3); }
struct Unit { int pm, pn, g; };

DEVI int conv_count(int units, int G) { const int Rf = units / G, rem = units - Rf * G; return rem ? (G - rem) / (Rf + 1) : 0; }
DEVI bool adopt(int units, int G, int c, int nconv, int i, long& L) {
    const int Rf = units / G, rem = units - Rf * G;
    if (i > Rf) return false;
    if (i == Rf && c >= rem) { const int j = c - rem; if (j >= nconv * Rf) return false; L = (long)(j / nconv) * G + (G - nconv) + (j % nconv); }
    return true;
}
struct ProbDense {
    const char* A; const char* Bt; int K, nM, nN, nwg, G, c, nconv;
    DEVI void init(const void* A_, const void* Bt_, int M, int N, int K_, int G_, int c_, int nconv_ = 0) { A = (const char*)A_; Bt = (const char*)Bt_; K = K_; nM = M / BM; nN = N / BM; nwg = nM * nN; G = G_; c = c_; nconv = nconv_; }
    DEVI bool next(int i, Unit& u) const {
        long L = (long)i * G + c;
        if (nconv) { if (!adopt(nwg, G, c, nconv, i, L)) return false; }
        if (L >= nwg) return false;
        int wgid = (int)L; { const int q = nwg / NXCD, r = nwg % NXCD, xcd = wgid % NXCD, off = wgid / NXCD; wgid = (xcd < r ? xcd * (q + 1) : r * (q + 1) + (xcd - r) * q) + off; }
        const int nig = WGM * nN, gid = wgid / nig, fm = gid * WGM, gsz = (nM - fm) < WGM ? (nM - fm) : WGM;
        u.pm = fm + ((wgid % nig) % gsz); u.pn = (wgid % nig) / gsz; u.g = 0; return true;
    }
    DEVI void a_offs(const Unit& u, const int (&R)[2], const int (&C)[2], unsigned (&va)[2][2]) const {
#pragma unroll
        for (int h = 0; h < 2; ++h)
#pragma unroll
            for (int i = 0; i < 2; ++i) va[h][i] = (unsigned)(((u.pm * BM + h * HALF + R[i]) * K + C[i]) * 2);
    }
    DEVI const char* b_base(const Unit& u) const { return Bt + (size_t)u.pn * BM * K * 2; }
};

struct ProbMoe {
    const char* A; const char* Bt; int K, nN, NT, G, c, nconv; size_t bstride;
    const LAS int* tile_e; const LAS int* tile_s0; const LAS int* cnt; const int* ltok; bool gather;
    DEVI bool next(int i, Unit& u) const {
        long Ll = (long)i * G + c;
        if (nconv) { if (!adopt(NT * nN, G, c, nconv, i, Ll)) return false; }
        const int L = (int)Ll; const int tile = L / nN; if (tile >= NT) return false;
        u.pm = tile; u.pn = L % nN; u.g = tile_e[tile]; return true;
    }
    DEVI void a_offs(const Unit& u, const int (&R)[2], const int (&C)[2], unsigned (&va)[2][2]) const {
        const int s0 = tile_s0[u.pm], n = cnt[u.g];
#pragma unroll
        for (int h = 0; h < 2; ++h)
#pragma unroll
            for (int i = 0; i < 2; ++i) {
                int row;
                if (gather) { const int slot = s0 + h * HALF + R[i]; row = (slot < n) ? ltok[u.g * CAP + slot] : 0; }
                else row = u.pm * BM + h * HALF + R[i];
                va[h][i] = (unsigned)((row * K + C[i]) * 2);
            }
    }
    DEVI const char* b_base(const Unit& u) const { return Bt + (size_t)u.g * bstride + (size_t)u.pn * BM * K * 2; }
};

template <class Prob, class Epi>
DEVI void gemm_phase(LAS unsigned char* lds, const Prob& S, const Epi& E) {
    const int tid = threadIdx.x, wid = __builtin_amdgcn_readfirstlane(tid >> 6), lane = tid & 63, wr = wid >> 2, wc = wid & 3, fr = lane & 15, fq = lane >> 4;
    const int K = S.K, nt = K / BK;
    int Rs[2], Cs[2]; unsigned voffB[2];
#pragma unroll
    for (int i = 0; i < 2; ++i) { int R, C; stage_rc(tid * 16 + i * 8192, R, C); Rs[i] = R; Cs[i] = C; const int Rb = (R & ~31) + perm32(R & 31); voffB[i] = (unsigned)(Rb * K + C) * 2u; }
    const size_t kstep = (size_t)(BK * 2);
    const size_t hstep = (size_t)HALF * K * 2;
    const unsigned ldsw = (unsigned)wid * 1024u;
    const int aoff = lds_byte(wr * 64 + fr, fq * 8), boff = lds_byte(wc * 32 + fr, fq * 8);
#define PG8_SA(b, h) (((b) * 2 + (h)) * HTB)
#define PG8_SB(b, h) ((4 + (b) * 2 + (h)) * HTB)
#define PG8_STAGE(bufoff, gbase, voff) do { _Pragma("unroll") for (int _i = 0; _i < 2; ++_i) \
        __builtin_amdgcn_global_load_lds((const unsigned*)((const char*)(gbase) + (voff)[_i]), (LAS unsigned*)(lds + (bufoff) + ldsw + _i * 8192), 16, 0, 0); } while (0)
#define PG8_LDA(dst, b, h) do { _Pragma("unroll") for (int m = 0; m < 4; ++m) _Pragma("unroll") for (int k = 0; k < 2; ++k) dst[m][k] = *(const LAS bf16x8*)(lds + PG8_SA(b, h) + aoff + m * 2048 + k * 1024); } while (0)
#define PG8_LDB(dst, b, h) do { _Pragma("unroll") for (int n = 0; n < 2; ++n) _Pragma("unroll") for (int k = 0; k < 2; ++k) dst[n][k] = *(const LAS bf16x8*)(lds + PG8_SB(b, h) + boff + n * 2048 + k * 1024); } while (0)
#define PG8_MMA(ai, bj, At, Bt) do { __builtin_amdgcn_s_setprio(1); _Pragma("unroll") for (int m = 0; m < 4; ++m) _Pragma("unroll") for (int n = 0; n < 2; ++n) _Pragma("unroll") for (int k = 0; k < 2; ++k) \
        acc[ai][bj][m][n] = __builtin_amdgcn_mfma_f32_16x16x32_bf16(Bt[n][k], At[m][k], acc[ai][bj][m][n], 0, 0, 0); __builtin_amdgcn_s_setprio(0); } while (0)
#define PG8_WAIT_V(n) asm volatile("s_waitcnt vmcnt(" #n ")" ::: "memory")
#define PG8_WAIT_L(n) asm volatile("s_waitcnt lgkmcnt(" #n ")" ::: "memory")
#define PG8_BAR __builtin_amdgcn_s_barrier()
#define PG8_SCHED __builtin_amdgcn_sched_barrier(0)
    Unit cur, nxt; int ui = 0;
    if (!S.next(0, cur)) return;
    f32x4 acc[2][2][4][2];
#pragma unroll
    for (int a = 0; a < 2; ++a)
#pragma unroll
        for (int b = 0; b < 2; ++b)
#pragma unroll
            for (int m = 0; m < 4; ++m)
#pragma unroll
                for (int n = 0; n < 2; ++n) acc[a][b][m][n] = (f32x4){0.f, 0.f, 0.f, 0.f};
    bf16x8 At[4][2], B0[2][2], B1[2][2];
    unsigned va[2][2], nva[2][2];
    S.a_offs(cur, Rs, Cs, va);
    const char* cB = S.b_base(cur);
    const char* A0 = S.A;
    PG8_STAGE(PG8_SB(0, 0), cB, voffB); PG8_STAGE(PG8_SB(0, 1), cB + hstep, voffB); PG8_STAGE(PG8_SA(0, 0), A0, va[0]); PG8_STAGE(PG8_SA(0, 1), A0, va[1]);
    if (wr == 1) PG8_BAR;
    PG8_WAIT_V(2); PG8_BAR;
    PG8_STAGE(PG8_SB(1, 0), cB + kstep, voffB); PG8_STAGE(PG8_SA(1, 0), A0 + kstep, va[0]); PG8_STAGE(PG8_SB(1, 1), cB + hstep + kstep, voffB);
    PG8_WAIT_V(6); PG8_BAR;
    for (;;) {
        const bool has_next = S.next(ui + 1, nxt);
        const char* nB = cB;
#pragma unroll
        for (int h = 0; h < 2; ++h)
#pragma unroll
            for (int i = 0; i < 2; ++i) nva[h][i] = va[h][i];
        if (has_next) { S.a_offs(nxt, Rs, Cs, nva); nB = S.b_base(nxt); }
        for (int t = 0; t < nt; t += 2) {
            const bool last = (t == nt - 2);
            const char* a1 = A0 + (size_t)(t + 1) * kstep;
            const char* a2 = last ? A0 : A0 + (size_t)(t + 2) * kstep; const char* b2 = last ? nB : cB + (size_t)(t + 2) * kstep;
            const char* a3 = a2 + kstep; const char* b3 = b2 + kstep;
            unsigned v2[2][2];
#pragma unroll
            for (int h = 0; h < 2; ++h)
#pragma unroll
                for (int i = 0; i < 2; ++i) v2[h][i] = last ? nva[h][i] : va[h][i];
            PG8_LDB(B0, 0, 0); PG8_LDB(B1, 0, 1); PG8_SCHED; PG8_LDA(At, 0, 0); PG8_STAGE(PG8_SA(1, 1), a1, va[1]);
            PG8_WAIT_V(8); PG8_WAIT_L(0); PG8_BAR; PG8_MMA(0, 0, At, B0); PG8_MMA(0, 1, At, B1); PG8_BAR; PG8_SCHED;
            PG8_LDA(At, 0, 1); PG8_STAGE(PG8_SB(0, 0), b2, voffB); PG8_STAGE(PG8_SB(0, 1), b2 + hstep, voffB); PG8_STAGE(PG8_SA(0, 0), a2, v2[0]);
            PG8_WAIT_V(8); PG8_WAIT_L(0); PG8_BAR; PG8_MMA(1, 0, At, B0); PG8_MMA(1, 1, At, B1); PG8_BAR; PG8_SCHED;
            PG8_LDB(B0, 1, 0); PG8_LDB(B1, 1, 1); PG8_SCHED; PG8_LDA(At, 1, 0); PG8_STAGE(PG8_SA(0, 1), a2, v2[1]);
            PG8_WAIT_V(8); PG8_WAIT_L(0); PG8_BAR; PG8_MMA(0, 0, At, B0); PG8_MMA(0, 1, At, B1); PG8_BAR; PG8_SCHED;
            PG8_LDA(At, 1, 1); PG8_STAGE(PG8_SB(1, 0), b3, voffB); PG8_STAGE(PG8_SB(1, 1), b3 + hstep, voffB); PG8_STAGE(PG8_SA(1, 0), a3, v2[0]);
            PG8_WAIT_V(8); PG8_WAIT_L(0); PG8_BAR; PG8_MMA(1, 0, At, B0); PG8_MMA(1, 1, At, B1); PG8_BAR; PG8_SCHED;
        }
        if (wr == 0) PG8_BAR;
        E(acc, cur, wr, wc, fr, fq);
        if (!has_next) break;
#pragma unroll
        for (int a = 0; a < 2; ++a)
#pragma unroll
            for (int b = 0; b < 2; ++b)
#pragma unroll
                for (int m = 0; m < 4; ++m)
#pragma unroll
                    for (int n = 0; n < 2; ++n) acc[a][b][m][n] = (f32x4){0.f, 0.f, 0.f, 0.f};
        cur = nxt; cB = nB; ++ui;
#pragma unroll
        for (int h = 0; h < 2; ++h)
#pragma unroll
            for (int i = 0; i < 2; ++i) va[h][i] = nva[h][i];
        if (wr == 1) PG8_BAR;
    }
    PG8_WAIT_V(0);
    PG8_BAR;
#undef PG8_SA
#undef PG8_SB
#undef PG8_STAGE
#undef PG8_LDA
#undef PG8_LDB
#undef PG8_MMA
#undef PG8_WAIT_V
#undef PG8_WAIT_L
#undef PG8_BAR
#undef PG8_SCHED
}
}

typedef f32x4 AccT[2][2][4][2];
#define EPI_LOOP(...) _Pragma("unroll") for (int ai = 0; ai < 2; ++ai) _Pragma("unroll") for (int m = 0; m < 4; ++m) { const int row = u.pm * 256 + ai * 128 + wr * 64 + m * 16 + fr; \
    _Pragma("unroll") for (int bj = 0; bj < 2; ++bj) { const int col = u.pn * 256 + bj * 128 + wc * 32 + 8 * fq; const f32x4 v0 = acc[ai][bj][m][0], v1 = acc[ai][bj][m][1]; __VA_ARGS__ } }

struct EpiStoreBf16 {
    bf16_t* O; int ldc;
    DEVI void operator()(const AccT& acc, const pg8::Unit& u, int wr, int wc, int fr, int fq) const {
        EPI_LOOP({ u32x4 w; w.x = pk2(v0[0], v0[1]); w.y = pk2(v0[2], v0[3]); w.z = pk2(v1[0], v1[1]); w.w = pk2(v1[2], v1[3]);
                   *(u32x4*)(O + (size_t)row * ldc + col) = w; })
    }
};
DEVI int rowc_of(int t) { return (t >> 13) * SEQ + CTXL + (t & 8191); }
struct EpiGate1 {
    float* M1; const bf16_t* P;
    DEVI void operator()(const AccT& acc, const pg8::Unit& u, int wr, int wc, int fr, int fq) const {
        EPI_LOOP({ const u32x4 g = *(const u32x4*)(P + (size_t)rowc_of(row) * NP + C_GA + col);
                   f32x4 o0, o1; o0[0] = sigmoidf_(lo_f(g.x)) * v0[0]; o0[1] = sigmoidf_(hi_f(g.x)) * v0[1]; o0[2] = sigmoidf_(lo_f(g.y)) * v0[2]; o0[3] = sigmoidf_(hi_f(g.y)) * v0[3];
                   o1[0] = sigmoidf_(lo_f(g.z)) * v1[0]; o1[1] = sigmoidf_(hi_f(g.z)) * v1[1]; o1[2] = sigmoidf_(lo_f(g.w)) * v1[2]; o1[3] = sigmoidf_(hi_f(g.w)) * v1[3];
                   float* d = M1 + (size_t)row * DM + col; *(f32x4*)d = o0; *(f32x4*)(d + 4) = o1; })
    }
};
struct EpiGate2 {
    const float* M1; bf16_t* M; const bf16_t* P;
    DEVI void operator()(const AccT& acc, const pg8::Unit& u, int wr, int wc, int fr, int fq) const {
        EPI_LOOP({ const u32x4 g = *(const u32x4*)(P + (size_t)rowc_of(row) * NP + C_GB + col);
                   const float* s = M1 + (size_t)row * DM + col; const f32x4 a0 = *(const f32x4*)s, a1 = *(const f32x4*)(s + 4);
                   u32x4 w; w.x = pk2(a0[0] + sigmoidf_(lo_f(g.x)) * v0[0], a0[1] + sigmoidf_(hi_f(g.x)) * v0[1]); w.y = pk2(a0[2] + sigmoidf_(lo_f(g.y)) * v0[2], a0[3] + sigmoidf_(hi_f(g.y)) * v0[3]);
                   w.z = pk2(a1[0] + sigmoidf_(lo_f(g.z)) * v1[0], a1[1] + sigmoidf_(hi_f(g.z)) * v1[1]); w.w = pk2(a1[2] + sigmoidf_(lo_f(g.w)) * v1[2], a1[3] + sigmoidf_(hi_f(g.w)) * v1[3]);
                   *(u32x4*)(M + (size_t)row * DM + col) = w; })
    }
};
struct EpiResid {
    const float* x; float* out; const float* mod;
    DEVI void operator()(const AccT& acc, const pg8::Unit& u, int wr, int wc, int fr, int fq) const {
        EPI_LOOP({ const int b = row >> 13; const float* gp = mod + b * 6144 + 2048 + col;
                   const f32x4 g0 = *(const f32x4*)gp, g1 = *(const f32x4*)(gp + 4);
                   const float* xs = x + (size_t)row * DM + col; float* d = out + (size_t)row * DM + col;
                   *(f32x4*)d = *(const f32x4*)xs + g0 * v0; *(f32x4*)(d + 4) = *(const f32x4*)(xs + 4) + g1 * v1; })
    }
};
struct EpiSwiglu {
    bf16_t* act; const float* b1;
    DEVI void operator()(const AccT& acc, const pg8::Unit& u, int wr, int wc, int fr, int fq) const {
        const int cc = u.pn * 128 + wc * 32 + 8 * fq; const float* bg = b1 + (size_t)u.g * 2048 + cc; const float* bl = bg + 1024;
        float g_[8], l_[8];
#pragma unroll
        for (int j = 0; j < 8; ++j) { g_[j] = bg[j]; l_[j] = bl[j]; }
#pragma unroll
        for (int ai = 0; ai < 2; ++ai)
#pragma unroll
            for (int m = 0; m < 4; ++m) {
                const int row = u.pm * 256 + ai * 128 + wr * 64 + m * 16 + fr; float o[8];
#pragma unroll
                for (int j = 0; j < 8; ++j) {
                    const float hg = acc[ai][0][m][j >> 2][j & 3] + g_[j], hl = acc[ai][1][m][j >> 2][j & 3] + l_[j];
                    const float glu = fminf(hg, 7.f), lin = fminf(fmaxf(hl, -7.f), 7.f);
                    o[j] = glu * sigmoidf_(1.702f * glu) * (lin + 1.f);
                }
                u32x4 w; w.x = pk2(o[0], o[1]); w.y = pk2(o[2], o[3]); w.z = pk2(o[4], o[5]); w.w = pk2(o[6], o[7]);
                *(u32x4*)(act + (size_t)row * 1024 + cc) = w;
            }
    }
};
struct EpiMoe2 {
    bf16_t* Y; const float* b2; const float* lgate; const LAS int* tile_s0; const LAS int* cnt;
    DEVI void operator()(const AccT& acc, const pg8::Unit& u, int wr, int wc, int fr, int fq) const {
        const int s0 = tile_s0[u.pm], n = cnt[u.g];
#pragma unroll
        for (int ai = 0; ai < 2; ++ai)
#pragma unroll
            for (int m = 0; m < 4; ++m) {
                const int rl = ai * 128 + wr * 64 + m * 16 + fr, slot = s0 + rl; const int row = u.pm * 256 + rl;
                const float gate = (slot < n) ? lgate[u.g * CAP + slot] : 0.f;
#pragma unroll
                for (int bj = 0; bj < 2; ++bj) {
                    const int col = u.pn * 256 + bj * 128 + wc * 32 + 8 * fq; const float* bp = b2 + (size_t)u.g * 1024 + col;
                    const f32x4 v0 = (acc[ai][bj][m][0] + *(const f32x4*)bp) * gate, v1 = (acc[ai][bj][m][1] + *(const f32x4*)(bp + 4)) * gate;
                    u32x4 w; w.x = pk2(v0[0], v0[1]); w.y = pk2(v0[2], v0[3]); w.z = pk2(v1[0], v1[1]); w.w = pk2(v1[2], v1[3]);
                    *(u32x4*)(Y + (size_t)row * 1024 + col) = w;
                }
            }
    }
};

namespace att {
constexpr int KVBLK = 64, LDQ = NP, LDK = NP;
constexpr float SCALE = 0.125f, THR = 8.f;
constexpr int SHM_V = KVBLK * 128 * 2, SHM_K = KVBLK * 128 * 2;
constexpr int OFF_VR = 0, OFF_KR = 4 * SHM_V;
constexpr int OFF_WS = 4 * SHM_V + 3 * SHM_K;
constexpr int OFF_E = 0;
constexpr int E_LD = 132;
constexpr int LDS_BYTES = OFF_WS + 8 * 64 * 4;
static_assert(128 * E_LD * 4 <= OFF_WS, "epilogue scratch must fit under the per-wave words");
#define KSWZ(row, colB) ((row) * 256 + ((colB) ^ (((row) & 7) << 4)))
#define SBAR() __builtin_amdgcn_sched_barrier(0)
DEVI int crow(int r, int hi) { return (r & 3) + 8 * (r >> 2) + 4 * hi; }
template <bool FIRST>
DEVI void partialSM(f32x16& p0, f32x16& p1, f32x16& negm, float& alpha, bool fixedref) {
    constexpr float THRL = (THR / SCALE) * (SCALE * LOG2E);
    if (fixedref) { alpha = 1.f;
#pragma unroll
        for (int r = 0; r < 16; ++r) p0[r] = __builtin_amdgcn_exp2f(p0[r]);
        return; }
    float pmax = p0[0];
#pragma unroll
    for (int r = 1; r < 16; ++r) pmax = fmaxf(pmax, p0[r]);
#pragma unroll
    for (int r = 0; r < 16; ++r) pmax = fmaxf(pmax, p1[r]);
    { auto rr = __builtin_amdgcn_permlane32_swap(__float_as_uint(pmax), __float_as_uint(pmax), false, false);
      pmax = fmaxf(__uint_as_float(rr[0]), __uint_as_float(rr[1])); }
    if (!FIRST && __builtin_expect(__all(pmax <= THRL), 1)) { alpha = 1.f; }
    else { const float d = FIRST ? pmax : fmaxf(pmax, 0.f); alpha = FIRST ? 1.f : __builtin_amdgcn_exp2f(-d);
#pragma unroll
        for (int r = 0; r < 16; ++r) { p0[r] -= d; p1[r] -= d; negm[r] -= d; } }
#pragma unroll
    for (int r = 0; r < 16; ++r) p0[r] = __builtin_amdgcn_exp2f(p0[r]);
}
DEVI void finishSM(f32x16& p0, f32x16& p1, float alpha, float& l_reg, bf16x8& pa0, bf16x8& pa1, bf16x8& pa2, bf16x8& pa3) {
#pragma unroll
    for (int r = 0; r < 16; ++r) p1[r] = __builtin_amdgcn_exp2f(p1[r]);
    float ps = 0;
#pragma unroll
    for (int r = 0; r < 16; ++r) ps += p0[r];
#pragma unroll
    for (int r = 0; r < 16; ++r) ps += p1[r];
    { auto rr = __builtin_amdgcn_permlane32_swap(__float_as_uint(ps), __float_as_uint(ps), false, false);
      ps = __uint_as_float(rr[0]) + __uint_as_float(rr[1]); }
    l_reg = l_reg * alpha + ps;
#define PK4(P, BASE, OUT) do { unsigned a0 = pk2a(P[BASE + 0], P[BASE + 1]), a1 = pk2a(P[BASE + 2], P[BASE + 3]);   \
    unsigned b0 = pk2a(P[BASE + 4], P[BASE + 5]), b1 = pk2a(P[BASE + 6], P[BASE + 7]);                              \
    auto r0 = __builtin_amdgcn_permlane32_swap(a0, b0, false, false); auto r1 = __builtin_amdgcn_permlane32_swap(a1, b1, false, false); \
    u32x4 w = {r0[0], r1[0], r0[1], r1[1]}; OUT = *reinterpret_cast<bf16x8*>(&w); } while (0)
    PK4(p0, 0, pa0); PK4(p0, 8, pa1); PK4(p1, 0, pa2); PK4(p1, 8, pa3);
#undef PK4
}
DEVI void qkt(f32x16& p0, f32x16& p1, const char* Ks, const bf16x8* qr, int r32, int hi, int st, const f32x16& negm) {
#pragma unroll
    for (int d0 = 0; d0 < 4; ++d0) { const int cb = ((st * 4 + d0) * 16 + hi * 8) * 2;
        const bf16x8 b0 = *reinterpret_cast<const bf16x8*>(Ks + KSWZ(r32, cb));
        const bf16x8 b1 = *reinterpret_cast<const bf16x8*>(Ks + KSWZ(32 + r32, cb));
        p0 = __builtin_amdgcn_mfma_f32_32x32x16_bf16(b0, qr[d0], d0 == 0 ? negm : p0, 0, 0, 0);
        p1 = __builtin_amdgcn_mfma_f32_32x32x16_bf16(b1, qr[d0], d0 == 0 ? negm : p1, 0, 0, 0); }
}
DEVI int v_st(int k, int c) { const int kk = (k & ~0xC) | ((k & 4) << 1) | ((k & 8) >> 1); return ((kk >> 3) * 4 + (c >> 5)) * 512 + ((kk & 7) * 32 + (c & 31)) * 2; }
DEVI int v_rd_base(int lane) { return ((lane & 3) << 3) | (((lane >> 2) & 3) << 6) | (((lane >> 4) & 1) << 5) | (((lane >> 5) & 1) << 8); }
constexpr int v_rd_off(int d0, int ks, int half) { return d0 * 512 + ks * 4096 + half * 2048; }
template <int OFF> DEVI s16x4 tr_read(int vb) {
    s16x4 r; asm volatile("ds_read_b64_tr_b16 %0, %1 offset:%2" : "=&v"(r) : "v"(vb), "i"(OFF) : "memory"); return r;
}
template <int D0> DEVI void pv_one(f32x16& od, int vb, bf16x8 pa0, bf16x8 pa1, bf16x8 pa2, bf16x8 pa3) {
    const s16x4 l0 = tr_read<v_rd_off(D0, 0, 0)>(vb), h0 = tr_read<v_rd_off(D0, 0, 1)>(vb), l1 = tr_read<v_rd_off(D0, 1, 0)>(vb), h1 = tr_read<v_rd_off(D0, 1, 1)>(vb);
    const s16x4 l2 = tr_read<v_rd_off(D0, 2, 0)>(vb), h2 = tr_read<v_rd_off(D0, 2, 1)>(vb), l3 = tr_read<v_rd_off(D0, 3, 0)>(vb), h3 = tr_read<v_rd_off(D0, 3, 1)>(vb);
    asm volatile("s_waitcnt lgkmcnt(0)" ::: "memory"); SBAR();
#define PK(L, H) (bf16x8){L[0], L[1], L[2], L[3], H[0], H[1], H[2], H[3]}
    od = __builtin_amdgcn_mfma_f32_32x32x16_bf16(pa0, PK(l0, h0), od, 0, 0, 0);
    od = __builtin_amdgcn_mfma_f32_32x32x16_bf16(pa1, PK(l1, h1), od, 0, 0, 0);
    od = __builtin_amdgcn_mfma_f32_32x32x16_bf16(pa2, PK(l2, h2), od, 0, 0, 0);
    od = __builtin_amdgcn_mfma_f32_32x32x16_bf16(pa3, PK(l3, h3), od, 0, 0, 0);
#undef PK
}
DEVI void pv_d0(f32x16* o, int vb, bf16x8 pa0, bf16x8 pa1, bf16x8 pa2, bf16x8 pa3) {
    pv_one<0>(o[0], vb, pa0, pa1, pa2, pa3); pv_one<1>(o[1], vb, pa0, pa1, pa2, pa3); pv_one<2>(o[2], vb, pa0, pa1, pa2, pa3); pv_one<3>(o[3], vb, pa0, pa1, pa2, pa3);
}
DEVI void attn_unit(const bf16_t* __restrict__ Qb, const bf16_t* __restrict__ Kh, const bf16_t* __restrict__ Vh, bf16_t* __restrict__ Ob, float lam, bool fixedref, const float* __restrict__ dng, char* lds) {
    const int tid = threadIdx.x, wid = __builtin_amdgcn_readfirstlane(tid >> 6), lane = tid & 63, r32 = lane & 31, hi = lane >> 5, w4 = wid & 3, st = wid >> 2;
    char* V_lds = lds + OFF_VR; char* K_lds = lds + OFF_KR; LAS unsigned char* ldsL = (LAS unsigned char*)lds;
    float* wsf = (float*)(lds + OFF_WS) + wid * 64; float* li_l = wsf; float* al_l = wsf + 32;
    float l_reg = 0; f32x16 o[4] = {}; f32x16 negm = {}; bf16x8 qr[4];
    const bf16_t* Qw = Qb + (size_t)(w4 * 32 + r32) * LDQ + st * 64 + hi * 8;
#pragma unroll
    for (int d0 = 0; d0 < 4; ++d0) qr[d0] = *reinterpret_cast<const bf16x8*>(Qw + d0 * 16);
    unsigned kof[2], vof[2];
#pragma unroll
    for (int i = 0; i < 2; ++i) { const int q = 2 * wid + i;
        { const int row = 4 * q + (lane >> 4), colB = ((lane & 15) * 16) ^ ((row & 7) << 4); kof[i] = (unsigned)(row * LDK + colB / 2) * 2u; }
        { const int sub = 2 * q + (lane >> 5), kk = (sub >> 2) * 8 + ((lane & 31) >> 2), cc = (sub & 3) * 32 + (lane & 3) * 8;
          const int k = (kk & ~0xC) | ((kk & 4) << 1) | ((kk & 8) >> 1); vof[i] = (unsigned)(k * LDK + cc) * 2u; } }
    const int vb0 = (int)(uintptr_t)V_lds + v_rd_base(lane);
#define DMA_K(src_tile, slot) do { const char* kb_ = (const char*)Kh + (size_t)(src_tile) * (KVBLK * LDK * 2); _Pragma("unroll") for (int i_ = 0; i_ < 2; ++i_) \
        __builtin_amdgcn_global_load_lds((const unsigned*)(kb_ + kof[i_]), (LAS unsigned*)(ldsL + OFF_KR + (slot) * SHM_K + (2 * wid + i_) * 1024), 16, 0, 0); } while (0)
#define DMA_V(src_tile, slot) do { const char* vb_ = (const char*)Vh + (size_t)(src_tile) * (KVBLK * LDK * 2); _Pragma("unroll") for (int i_ = 0; i_ < 2; ++i_) \
        __builtin_amdgcn_global_load_lds((const unsigned*)(vb_ + vof[i_]), (LAS unsigned*)(ldsL + OFF_VR + (slot) * SHM_V + (2 * wid + i_) * 1024), 16, 0, 0); } while (0)
#define TILE_SYNC(n) do { asm volatile("s_waitcnt vmcnt(" #n ")" ::: "memory"); __builtin_amdgcn_s_barrier(); asm volatile("" ::: "memory"); } while (0)
#define RESC(a) do { if (__any((a) < 1.f)) { const int ln_ = lane_id_fresh(), hi_ = ln_ >> 5; float* al_ = (float*)(lds + OFF_WS) + wid * 64 + 32; \
    if (hi_ == 0) al_[ln_ & 31] = (a); asm volatile("s_waitcnt lgkmcnt(0)" ::: "memory"); \
    _Pragma("unroll") for (int d = 0; d < 4; ++d) _Pragma("unroll") for (int r = 0; r < 16; ++r) o[d][r] *= al_[crow(r, hi_)]; } } while (0)
    f32x16 pA0, pA1, pB0, pB1; float mnA = 0.f, mnB = 0.f, alA, alB; (void)mnA; (void)mnB; bf16x8 pa0, pa1, pa2, pa3; constexpr int NT = SEQ / KVBLK;
#define SEG_X(PN0, PN1, h_, PP0, PP1, alP) do { SBAR(); qkt(PN0, PN1, K_lds + ((h_) % 3) * SHM_K, qr, r32, hi, st, negm); finishSM(PP0, PP1, alP, l_reg, pa0, pa1, pa2, pa3); SBAR(); } while (0)
#define SEG_Y(PN0, PN1, h_, mnN, alN) do { pv_d0(o, vb0 + (((h_) - 1) & 3) * SHM_V, pa0, pa1, pa2, pa3); partialSM<false>(PN0, PN1, negm, alN, fixedref); if (!fixedref) RESC(alN); } while (0)
#define ISSUE(h_) do { const int jk_ = (h_) + 2; DMA_K(jk_ < NT ? jk_ : NT - 1, jk_ % 3); DMA_V((h_) + 1, ((h_) + 1) & 3); } while (0)
    DMA_K(0, 0); DMA_V(0, 0); DMA_K(1, 1);
    TILE_SYNC(0);
    if (st == 0) {
        ISSUE(0); qkt(pA0, pA1, K_lds, qr, r32, hi, st, negm); partialSM<true>(pA0, pA1, negm, alA, fixedref); TILE_SYNC(4);
        for (int h = 1; h + 1 < NT; h += 2) {
            ISSUE(h);     SEG_X(pB0, pB1, h, pA0, pA1, alA);     SEG_Y(pB0, pB1, h, mnB, alB);     TILE_SYNC(4);
            ISSUE(h + 1); SEG_X(pA0, pA1, h + 1, pB0, pB1, alB); SEG_Y(pA0, pA1, h + 1, mnA, alA); TILE_SYNC(4);
        }
        SEG_X(pB0, pB1, NT - 1, pA0, pA1, alA); SEG_Y(pB0, pB1, NT - 1, mnB, alB); TILE_SYNC(0);
        finishSM(pB0, pB1, alB, l_reg, pa0, pa1, pa2, pa3); SBAR();
        pv_d0(o, vb0 + ((NT - 1) & 3) * SHM_V, pa0, pa1, pa2, pa3);
    } else {
        ISSUE(0); qkt(pA0, pA1, K_lds, qr, r32, hi, st, negm); TILE_SYNC(4);
        ISSUE(1); partialSM<true>(pA0, pA1, negm, alA, fixedref); SEG_X(pB0, pB1, 1, pA0, pA1, alA); TILE_SYNC(4);
        for (int h = 2; h + 3 < NT; h += 2) {
            ISSUE(h);     SEG_Y(pB0, pB1, h - 1, mnB, alB); SEG_X(pA0, pA1, h, pB0, pB1, alB);     TILE_SYNC(4);
            ISSUE(h + 1); SEG_Y(pA0, pA1, h, mnA, alA);     SEG_X(pB0, pB1, h + 1, pA0, pA1, alA); TILE_SYNC(4);
        }
        ISSUE(NT - 2); SEG_Y(pB0, pB1, NT - 3, mnB, alB); SEG_X(pA0, pA1, NT - 2, pB0, pB1, alB); TILE_SYNC(4);
        SEG_Y(pA0, pA1, NT - 2, mnA, alA); SEG_X(pB0, pB1, NT - 1, pA0, pA1, alA); TILE_SYNC(0);
        SEG_Y(pB0, pB1, NT - 1, mnB, alB);
        finishSM(pB0, pB1, alB, l_reg, pa0, pa1, pa2, pa3); SBAR();
        pv_d0(o, vb0 + ((NT - 1) & 3) * SHM_V, pa0, pa1, pa2, pa3);
    }
    asm volatile("s_waitcnt lgkmcnt(0)" ::: "memory"); __builtin_amdgcn_s_barrier(); asm volatile("" ::: "memory");
#undef SEG_X
#undef SEG_Y
#undef ISSUE
    if (hi == 0) li_l[r32] = l_reg; asm volatile("s_waitcnt lgkmcnt(0)" ::: "memory");
    float rli[16];
    const float sgn = st ? lam : 1.f;
#pragma unroll
    for (int r = 0; r < 16; ++r) rli[r] = __builtin_amdgcn_rcpf(li_l[crow(r, hi)]) * sgn;
    float* Es = (float*)(lds + OFF_E);
    if (st == 1) {
#pragma unroll
        for (int r = 0; r < 16; ++r) { const int orow = w4 * 32 + crow(r, hi);
#pragma unroll
            for (int d0 = 0; d0 < 4; ++d0) Es[orow * E_LD + d0 * 32 + r32] = o[d0][r] * rli[r]; }
    }
    __syncthreads();
    if (st == 0) {
#pragma unroll
        for (int r = 0; r < 16; ++r) { const int orow = w4 * 32 + crow(r, hi);
#pragma unroll
            for (int d0 = 0; d0 < 4; ++d0) { float* e = &Es[orow * E_LD + d0 * 32 + r32]; *e = o[d0][r] * rli[r] - *e; } }
    }
    __syncthreads();
    { const int row = tid >> 2, q = tid & 3; const float* e = &Es[row * E_LD + q * 32]; float v[32]; float ss = 0.f;
#pragma unroll
      for (int j = 0; j < 8; ++j) { const f32x4 t4 = *(const f32x4*)(e + 4 * j); v[4 * j] = t4[0]; v[4 * j + 1] = t4[1]; v[4 * j + 2] = t4[2]; v[4 * j + 3] = t4[3]; }
#pragma unroll
      for (int j = 0; j < 32; ++j) ss += v[j] * v[j];
      ss += __shfl_xor(ss, 1); ss += __shfl_xor(ss, 2);
      const float rs = __builtin_amdgcn_rsqf(ss * (1.f / 128.f) + EPS) * 0.8f;
      bf16_t* op = Ob + (size_t)row * 1024 + q * 32; const float* g = dng + q * 32;
#pragma unroll
      for (int j = 0; j < 4; ++j) { u32x4 w; w.x = pk2(v[8 * j] * rs * g[8 * j], v[8 * j + 1] * rs * g[8 * j + 1]); w.y = pk2(v[8 * j + 2] * rs * g[8 * j + 2], v[8 * j + 3] * rs * g[8 * j + 3]);
          w.z = pk2(v[8 * j + 4] * rs * g[8 * j + 4], v[8 * j + 5] * rs * g[8 * j + 5]); w.w = pk2(v[8 * j + 6] * rs * g[8 * j + 6], v[8 * j + 7] * rs * g[8 * j + 7]);
          *(u32x4*)(op + 8 * j) = w; }
    }
    __syncthreads();
#undef DMA_K
#undef DMA_V
#undef TILE_SYNC
#undef RESC
}
}

#define LDS_BAR() do { asm volatile("s_waitcnt lgkmcnt(0)" ::: "memory"); __builtin_amdgcn_s_barrier(); asm volatile("" ::: "memory"); } while (0)
namespace ret {
using att::crow;
DEVI size_t qf_index(int b, int h, int c, int w, int ks, int fq, int fr) { return (((((((size_t)(b * 4 + h) * 66 + c) * 8 + w) * 8 + ks) * 4 + fq) * 16 + fr) * 8); }
DEVI size_t ktf_index(int b, int h, int c, int w, int ks, int hh, int r32) { return (((((((size_t)(b * 4 + h) * 66 + c) * 8 + w) * 8 + ks) * 2 + hh) * 32 + r32) * 8); }
constexpr int VS_LD = 136;
constexpr int ST_LD = 264;
constexpr int TS_LD = 40;
constexpr int OFF_VS = 0, OFF_ST = 2 * 32 * VS_LD * 2, OFF_TS = OFF_ST + 2 * 32 * ST_LD * 2;
DEVI void scan_unit(int u, const bf16_t* __restrict__ QF, const bf16_t* __restrict__ KTF, const bf16_t* __restrict__ VT, bf16_t* __restrict__ OF, bf16_t* __restrict__ OB, const float* __restrict__ scal, char* lds) {
    const int b = u >> 7, h = (u >> 5) & 3, dir = (u >> 4) & 1, vs = u & 15;
    const int tid = threadIdx.x, w = __builtin_amdgcn_readfirstlane(tid >> 6), lane = tid & 63, r32 = lane & 31, hh = lane >> 5, fr = lane & 15, fq = lane >> 4;
    const float lgn = scal[dir * 4 + h];
    const float gch = __expf(lgn * 128.f);
    bf16_t* Vs = (bf16_t*)(lds + OFF_VS); bf16_t* St = (bf16_t*)(lds + OFF_ST); bf16_t* Ts = (bf16_t*)(lds + OFF_TS) + w * (16 * TS_LD);
    for (int i = tid; i < 32 * ST_LD / 2; i += 512) ((unsigned*)St)[i] = 0u;
    f32x16 S = {};
    const bf16_t* QFb = QF + qf_index(b, h, 0, w, 0, 0, 0) + lane * 8;
    const bf16_t* KTFb = KTF + ktf_index(b, h, 0, w, 0, 0, 0) + lane * 8;
    const bf16_t* VTb = VT + ((size_t)(b * 4 + h) * 512 + vs * 32) * SEQ;
    bf16_t* Odir = dir ? OB : OF;
    bf16_t* sink = (bf16_t*)((char*)OF + (WS_DUMMY - WS_OF));
    const int sv = tid >> 4, sj = (tid & 15) * 8;
    float wj[8];
#pragma unroll
    for (int e = 0; e < 8; ++e) { const int j = sj + e; wj[e] = __expf(lgn * (float)(dir ? j : 127 - j)); }
    const int itok = 16 * w + fr;
    const float qd = __expf(lgn * (float)(dir ? 128 - itok : itok + 1));
    bf16x8 kfA[8], kfB[8], qfA[8], qfB[8]; bf16x8 vA, vB;
#define CHUNK_OF(k) (dir ? ((k) == 0 ? 1 : ((k) == 1 ? 0 : 67 - (k))) : (k))
#define CLAMPK(kk) ((kk) < 66 ? (kk) : 65)
#define LOADK(KF_, kk) do { const size_t co_ = (size_t)CHUNK_OF(CLAMPK(kk)) * 32768; \
        _Pragma("unroll") for (int ks = 0; ks < 8; ++ks) KF_[ks] = *(const bf16x8*)(KTFb + co_ + ((ks + vs) & 7) * 512); } while (0)
#define LOADV(VR_, kk) do { VR_ = *(const bf16x8*)(VTb + (size_t)sv * SEQ + CHUNK_OF(CLAMPK(kk)) * 128 + sj); } while (0)
#define LOADQ(QF_, kk) do { const size_t co_ = (size_t)CHUNK_OF(CLAMPK(kk)) * 32768;     \
        _Pragma("unroll") for (int ks = 0; ks < 8; ++ks) QF_[ks] = *(const bf16x8*)(QFb + co_ + ((ks + vs) & 7) * 512); } while (0)
#define STEP(k, KF_, V_, QF_) do { \
        const int cn = CHUNK_OF(k); \
        bf16_t* Vsk = Vs + ((k) & 1) * (32 * VS_LD); const bf16_t* Stk = St + ((k) & 1) * (32 * ST_LD); bf16_t* Stn = St + (((k) + 1) & 1) * (32 * ST_LD); \
        { u32x4 vv = *reinterpret_cast<u32x4*>(&V_); u32x4 ww; \
          ww.x = pk2(lo_f(vv.x) * wj[0], hi_f(vv.x) * wj[1]); ww.y = pk2(lo_f(vv.y) * wj[2], hi_f(vv.y) * wj[3]); \
          ww.z = pk2(lo_f(vv.z) * wj[4], hi_f(vv.z) * wj[5]); ww.w = pk2(lo_f(vv.w) * wj[6], hi_f(vv.w) * wj[7]); \
          *(u32x4*)(Vsk + sv * VS_LD + sj) = ww; } \
        LOADV(V_, (k) + 2); \
        __syncthreads();     \
        _Pragma("unroll") for (int r = 0; r < 16; ++r) S[r] *= gch; \
        _Pragma("unroll") for (int ks = 0; ks < 8; ++ks) { \
            const bf16x8 vf = *(const bf16x8*)(Vsk + r32 * VS_LD + ((ks + vs) & 7) * 16 + hh * 8); \
            S = __builtin_amdgcn_mfma_f32_32x32x16_bf16(KF_[ks], vf, S, 0, 0, 0); } \
        LOADK(KF_, (k) + 2); \
        _Pragma("unroll") for (int g = 0; g < 4; ++g) { u32x2 ww; ww.x = pk2(S[4 * g], S[4 * g + 1]); ww.y = pk2(S[4 * g + 2], S[4 * g + 3]); \
            *(u32x2*)(Stn + r32 * ST_LD + 32 * w + 8 * g + 4 * hh) = ww; } \
        {                    \
            f32x4 a0 = {0.f, 0.f, 0.f, 0.f}, a1 = {0.f, 0.f, 0.f, 0.f}; \
            _Pragma("unroll") for (int ks = 0; ks < 8; ++ks) { \
                const bf16x8 s0f = *(const bf16x8*)(Stk + (fr) * ST_LD + ((ks + vs) & 7) * 32 + fq * 8); \
                const bf16x8 s1f = *(const bf16x8*)(Stk + (16 + fr) * ST_LD + ((ks + vs) & 7) * 32 + fq * 8); \
                a0 = __builtin_amdgcn_mfma_f32_16x16x32_bf16(s0f, QF_[ks], a0, 0, 0, 0); \
                a1 = __builtin_amdgcn_mfma_f32_16x16x32_bf16(s1f, QF_[ks], a1, 0, 0, 0); } \
            u32x2 w0, w1; w0.x = pk2(a0[0] * qd, a0[1] * qd); w0.y = pk2(a0[2] * qd, a0[3] * qd); w1.x = pk2(a1[0] * qd, a1[1] * qd); w1.y = pk2(a1[2] * qd, a1[3] * qd); \
            *(u32x2*)(Ts + fr * TS_LD + 4 * fq) = w0; *(u32x2*)(Ts + fr * TS_LD + 16 + 4 * fq) = w1;        \
            asm volatile("s_waitcnt lgkmcnt(0)" ::: "memory"); \
            const int tk = lane >> 2, l = (cn - 2) * 128 + 16 * w + tk; \
            const u32x4 ov = *(const u32x4*)(Ts + tk * TS_LD + (lane & 3) * 8); \
            bf16_t* op = (cn >= 2 ? Odir + (size_t)(b * LSEQ + l) * 2048 : sink + (size_t)(16 * w + tk) * 2048) + h * 512 + vs * 32 + (lane & 3) * 8; \
            *(u32x4*)op = ov; } \
        LOADQ(QF_, (k) + 2); \
    } while (0)
    LOADK(kfA, 0); LOADV(vA, 0); LOADK(kfB, 1); LOADV(vB, 1); LOADQ(qfA, 0); LOADQ(qfB, 1);
#pragma unroll 1
    for (int k2 = 0; k2 < 66; k2 += 2) {
        STEP(k2 + 0, kfA, vA, qfA);
        STEP(k2 + 1, kfB, vB, qfB);
    }
    __syncthreads();
#undef STEP
#undef LOADK
#undef LOADV
#undef LOADQ
#undef CHUNK_OF
}
constexpr int QL_LD = 264, PL_LD = 136, VL_LD = 136;
constexpr int OFF_QL = 0, OFF_KL = 128 * QL_LD * 2, OFF_PL = 0, OFF_VL = OFF_KL;
DEVI void intra_unit(int u, const bf16_t* __restrict__ P, const bf16_t* __restrict__ VT, bf16_t* __restrict__ OI, const float* __restrict__ scal, char* lds) {
    const int b = u >> 8, h = (u >> 6) & 3, lc = u & 63, s0 = (lc + 2) * 128;
    const int tid = threadIdx.x, w = __builtin_amdgcn_readfirstlane(tid >> 6), lane = tid & 63, r32 = lane & 31, hh = lane >> 5;
    const int tr = w >> 1, tc0 = 2 * (w & 1);
    bf16_t* Ql = (bf16_t*)(lds + OFF_QL); bf16_t* Kl = (bf16_t*)(lds + OFF_KL); bf16_t* Pl = (bf16_t*)(lds + OFF_PL); bf16_t* Vl = (bf16_t*)(lds + OFF_VL);
    {
        const int srow = tid >> 5, pc = (tid & 31) * 8;
        const bf16_t* qg = P + ((size_t)b * SEQ + s0 + srow) * NP + C_RQ + h * 256 + pc; const bf16_t* kg = qg + (C_RK - C_RQ);
        u32x4 qv[8], kv[8];
#pragma unroll
        for (int it = 0; it < 8; ++it) { qv[it] = *(const u32x4*)(qg + (size_t)it * 16 * NP); kv[it] = *(const u32x4*)(kg + (size_t)it * 16 * NP); }
#pragma unroll
        for (int it = 0; it < 8; ++it) { *(u32x4*)(Ql + (it * 16 + srow) * QL_LD + pc) = qv[it]; *(u32x4*)(Kl + (it * 16 + srow) * QL_LD + pc) = kv[it]; }
    }
    __syncthreads();
    f32x16 c0 = {}, c1 = {};
#pragma unroll 4
    for (int ks = 0; ks < 16; ++ks) {
        const bf16x8 a = *(const bf16x8*)(Ql + (32 * tr + r32) * QL_LD + ks * 16 + hh * 8);
        const bf16x8 b0 = *(const bf16x8*)(Kl + (32 * tc0 + r32) * QL_LD + ks * 16 + hh * 8), b1 = *(const bf16x8*)(Kl + (32 * tc0 + 32 + r32) * QL_LD + ks * 16 + hh * 8);
        c0 = __builtin_amdgcn_mfma_f32_32x32x16_bf16(a, b0, c0, 0, 0, 0);
        c1 = __builtin_amdgcn_mfma_f32_32x32x16_bf16(a, b1, c1, 0, 0, 0);
    }
    const int vrow = tid >> 4, vpc = (tid & 15) * 8;
    const bf16_t* vg = VT + ((size_t)(b * 4 + h) * 512 + vrow) * SEQ + s0 + vpc;
    u32x4 vv[4];
#pragma unroll
    for (int it = 0; it < 4; ++it) vv[it] = *(const u32x4*)(vg + (size_t)(it * 32) * SEQ);
    LDS_BAR();
    const float lf2 = scal[h] * LOG2E, lb2 = scal[4 + h] * LOG2E;
#pragma unroll
    for (int t = 0; t < 2; ++t) {
        const int j = 32 * (tc0 + t) + r32;
#pragma unroll
        for (int r = 0; r < 16; ++r) {
            const int i = 32 * tr + crow(r, hh); const float dlt = (float)(i - j);
            float dm = 0.f;
            if (j <= i) dm += __builtin_amdgcn_exp2f(dlt * lf2);
            if (j >= i) dm += __builtin_amdgcn_exp2f(-dlt * lb2);
            const float v = (t ? c1[r] : c0[r]) * dm;
            Pl[i * PL_LD + j] = (bf16_t)f2bf(v);
        }
    }
    bf16x8 pf[8];
    bf16_t* Ob = OI + ((size_t)b * LSEQ + lc * 128 + 32 * tr + r32) * 2048 + h * 512;
#pragma unroll 1
    for (int vb = 0; vb < 4; ++vb) {
        bf16_t* Vb = Vl + (vb & 1) * (128 * VL_LD);
#pragma unroll
        for (int it = 0; it < 4; ++it) *(u32x4*)(Vb + (it * 32 + vrow) * VL_LD + vpc) = vv[it];
        if (vb < 3) {
#pragma unroll
            for (int it = 0; it < 4; ++it) vv[it] = *(const u32x4*)(vg + (size_t)((vb + 1) * 128 + it * 32) * SEQ);
        }
        LDS_BAR();
        if (vb == 0) {
#pragma unroll
            for (int ks = 0; ks < 8; ++ks) pf[ks] = *(const bf16x8*)(Pl + (32 * tr + r32) * PL_LD + ks * 16 + hh * 8);
        }
#pragma unroll
        for (int t = 0; t < 2; ++t) {
            const int vt = (w & 1) * 2 + t;
            f32x16 oacc = {};
#pragma unroll
            for (int ks = 0; ks < 8; ++ks) {
                const bf16x8 a = *(const bf16x8*)(Vb + (32 * vt + r32) * VL_LD + ks * 16 + hh * 8);
                oacc = __builtin_amdgcn_mfma_f32_32x32x16_bf16(a, pf[ks], oacc, 0, 0, 0);
            }
            const int v0 = vb * 128 + vt * 32;
#pragma unroll
            for (int g = 0; g < 4; ++g) { u32x2 ww; ww.x = pk2(oacc[4 * g], oacc[4 * g + 1]); ww.y = pk2(oacc[4 * g + 2], oacc[4 * g + 3]);
                *(u32x2*)(Ob + v0 + 8 * g + 4 * hh) = ww; }
        }
    }
    __syncthreads();
}
}

constexpr int NPH = 12;
constexpr int LDS_BYTES = 160 * 1024;
constexpr int LDS_TAB = 131072;

struct Ctx {
    int tid, lane, wave, gw, NGW, G, bid;
    char* lds;
};

struct TrTile { const float* W; bf16_t* WT; int K, N, k0, n0, perm; };
DEVI int tr_orow(const TrTile& t, int n) { return t.perm ? 256 * ((n & 1023) >> 7) + 128 * (n >> 10) + (n & 127) : n; }
DEVI void tr_load(const TrTile& t, f32x4 (&v)[16], int tid) { const int wv = tid >> 6, l = tid & 63;
#pragma unroll
    for (int i = 0; i < 16; ++i) v[i] = *(const f32x4*)(t.W + (size_t)(t.k0 + 16 * wv + i) * t.N + t.n0 + 4 * l); }
DEVI void tr_to_lds(const f32x4 (&v)[16], unsigned* T, int tid) { const int wv = tid >> 6, l = tid & 63;
#pragma unroll
    for (int e = 0; e < 4; ++e) { const int n = 4 * l + e;
#pragma unroll
        for (int h = 0; h < 2; ++h) { u32x4 o; o.x = pk2(v[8 * h][e], v[8 * h + 1][e]); o.y = pk2(v[8 * h + 2][e], v[8 * h + 3][e]); o.z = pk2(v[8 * h + 4][e], v[8 * h + 5][e]); o.w = pk2(v[8 * h + 6][e], v[8 * h + 7][e]);
            *(u32x4*)(T + n * 64 + 4 * ((2 * wv + h) ^ (l & 7))) = o; } } }
DEVI void tr_store(const TrTile& t, const unsigned* T, int tid) { const int piece = tid & 15;
#pragma unroll
    for (int it = 0; it < 8; ++it) { const int n = (tid >> 4) + 32 * it;
        const u32x4 o = *(const u32x4*)(T + n * 64 + 4 * (piece ^ ((n >> 2) & 7)));
        *(u32x4*)(t.WT + (size_t)tr_orow(t, t.n0 + n) * t.K + t.k0 + piece * 8) = o; } }

DEVI void phase_prep(const Params& p, const Ctx& c) {
    unsigned char* ws = p.ws;
    constexpr int T_IN = 8 * (NP / 256), T_BR = 16 * 4, T_BD = 8 * 4, T_OUT = T_BD, T_W1 = 8 * 8, T_W2 = 8 * 4;
    int NTIL = T_IN + T_BR + T_BD + T_OUT;
    asm volatile("" : "+s"(NTIL));
    auto tile_of = [&](int it) { TrTile t; int r = it; t.perm = 0;
        if (r < T_IN) { const int nb = NP / 256; t.W = p.w_in; t.WT = (bf16_t*)(ws + WS_WIN); t.K = 1024; t.N = NP; t.k0 = (r / nb) * 128; t.n0 = (r % nb) * 256; return t; } r -= T_IN;
        if (r < T_BR) { t.W = p.w_br_ret; t.WT = (bf16_t*)(ws + WS_WBR); t.K = 2048; t.N = 1024; t.k0 = (r / 4) * 128; t.n0 = (r % 4) * 256; return t; } r -= T_BR;
        if (r < T_BD) { t.W = p.w_br_diff; t.WT = (bf16_t*)(ws + WS_WBD); t.K = 1024; t.N = 1024; t.k0 = (r / 4) * 128; t.n0 = (r % 4) * 256; return t; } r -= T_BD;
        if (r < T_OUT) { t.W = p.w_out; t.WT = (bf16_t*)(ws + WS_WOUT); t.K = 1024; t.N = 1024; t.k0 = (r / 4) * 128; t.n0 = (r % 4) * 256; return t; } r -= T_OUT;
        const int e = r / (T_W1 + T_W2); r -= e * (T_W1 + T_W2);
        if (r < T_W1) { t.W = p.w1 + (size_t)e * 1024 * 2048; t.WT = (bf16_t*)(ws + WS_W1) + (size_t)e * 2048 * 1024; t.K = 1024; t.N = 2048; t.k0 = (r / 8) * 128; t.n0 = (r % 8) * 256; t.perm = 1; return t; } r -= T_W1;
        t.W = p.w2 + (size_t)e * 1024 * 1024; t.WT = (bf16_t*)(ws + WS_W2) + (size_t)e * 1024 * 1024; t.K = 1024; t.N = 1024; t.k0 = (r / 4) * 128; t.n0 = (r % 4) * 256; return t; };
    {
        unsigned* Tl = (unsigned*)c.lds; f32x4 v[16];
        int it = c.bid; TrTile cur = tile_of(it < NTIL ? it : 0);
        if (it < NTIL) tr_load(cur, v, c.tid);
        while (it < NTIL) {
            tr_to_lds(v, Tl, c.tid);
            const int nx = it + c.G; TrTile nxt = tile_of(nx < NTIL ? nx : 0);
            if (nx < NTIL) tr_load(nxt, v, c.tid);
            LDS_BAR();
            tr_store(cur, Tl, c.tid);
            LDS_BAR();
            cur = nxt; it = nx;
        }
    }
    float* mod = (float*)(ws + WS_MOD);
    __syncthreads();
    float* sil = (float*)c.lds + 1024;
    if (c.G - 1 - c.bid < 192) { for (int i = c.tid; i < 3072; i += 512) sil[i] = siluf_(i < 2048 ? p.c[i] : p.c_ctx[i - 2048]); }
    __syncthreads();
    for (int cgp = c.G - 1 - c.bid; cgp < 192; cgp += c.G) {
        const int col = cgp * 32 + (c.lane & 31), kh = c.lane >> 5; float a0 = 0.f, a1 = 0.f, a2 = 0.f;
        for (int k0 = c.wave * 128; k0 < c.wave * 128 + 128; k0 += 64) {
            float wv[32];
#pragma unroll
            for (int i = 0; i < 32; ++i) wv[i] = p.w_mod[(size_t)(k0 + 2 * i + kh) * 6144 + col];
#pragma unroll
            for (int i = 0; i < 32; ++i) { const float* sp = sil + k0 + 2 * i + kh; a0 += sp[0] * wv[i]; a1 += sp[1024] * wv[i]; a2 += sp[2048] * wv[i]; }
        }
        a0 += __shfl_xor(a0, 32); a1 += __shfl_xor(a1, 32); a2 += __shfl_xor(a2, 32);
        float* red = (float*)c.lds;
        if (kh == 0) { red[(c.wave * 3 + 0) * 32 + c.lane] = a0; red[(c.wave * 3 + 1) * 32 + c.lane] = a1; red[(c.wave * 3 + 2) * 32 + c.lane] = a2; }
        __syncthreads();
        if (c.tid < 96) { const int v = c.tid >> 5, l = c.tid & 31; float s = 0.f;
#pragma unroll
            for (int w = 0; w < 8; ++w) s += red[(w * 3 + v) * 32 + l];
            mod[v * 6144 + cgp * 32 + l] = s + p.b_mod[cgp * 32 + l]; }
        __syncthreads();
    }
    const int gt = c.bid * 512 + c.tid;
    if (gt < 128 * 64) { const int pos = gt >> 6, i = gt & 63; const float inv = powf(10000.f, -(float)i / 64.f); float s, co; sincosf((float)pos * inv, &s, &co);
        ((float2*)(ws + WS_TABR))[gt] = make_float2(co, s); }
    else if (gt < 128 * 64 + 128 * 16) { const int q = gt - 128 * 64, pos = q >> 4, i = q & 15; const float inv = powf(10000.f, -(float)i / 16.f); float s, co; sincosf((float)pos * inv, &s, &co);
        ((float2*)(ws + WS_TABD))[q] = make_float2(co, s); }
    else if (gt < 128 * 80 + 8) { const int q = gt - 128 * 80; const float xl = p.ret_decay[q]; ((float*)(ws + WS_SCAL))[q] = -log1pf(expf(-xl)); }
    else if (gt >= 128 * 80 + 64 && gt < 128 * 80 + 128) {
        const int i = gt - (128 * 80 + 64); const float s01 = wave_sum(p.dlam[i] * p.dlam[64 + i]), s23 = wave_sum(p.dlam[128 + i] * p.dlam[192 + i]);
        if (i == 0) ((float*)(ws + WS_SCAL))[8] = expf(s01) - expf(s23) + 0.2f; }
    else if (gt >= 128 * 80 + 128 && gt < 128 * 80 + 192) {
        const int i = gt - (128 * 80 + 128); float gq = fabsf(p.dq_g[i]), gk = fabsf(p.dk_g[i]);
#pragma unroll
        for (int o = 1; o < 64; o <<= 1) { gq = fmaxf(gq, __shfl_xor(gq, o)); gk = fmaxf(gk, __shfl_xor(gk, o)); }
        if (i == 0) ((float*)(ws + WS_SCAL))[9] = 64.f * 1.02f * gq * gk * (att::SCALE * LOG2E); }
}

constexpr int Q1_TILES = NE * 64, Q2_TILES = NE * 32;
DEVI TrTile conv_tile(const Params& p, int qsel, int t) {
    TrTile tt;
    if (qsel == 0) { const int e = t >> 6, r = t & 63; tt.W = p.w1 + (size_t)e * 1024 * 2048; tt.WT = (bf16_t*)(p.ws + WS_W1) + (size_t)e * 2048 * 1024; tt.K = 1024; tt.N = 2048; tt.k0 = (r >> 3) * 128; tt.n0 = (r & 7) * 256; tt.perm = 1; }
    else { const int e = t >> 5, r = t & 31; tt.W = p.w2 + (size_t)e * 1024 * 1024; tt.WT = (bf16_t*)(p.ws + WS_W2) + (size_t)e * 1024 * 1024; tt.K = 1024; tt.N = 1024; tt.k0 = (r >> 2) * 128; tt.n0 = (r & 3) * 256; tt.perm = 0; }
    return tt;
}
DEVI void conv_run(const Params& p, const Ctx& c, int qsel, bool peek, bool stoppable) {
    unsigned* Tl = (unsigned*)c.lds; int* qs = (int*)(c.lds + 65536);
    int* q = (int*)(p.ws + WS_Q) + 64 * qsel; const int lim = qsel ? Q2_TILES : Q1_TILES;
    __syncthreads();
    const int* flagp = (const int*)(p.ws + WS_Q) + 128; int flg = 0; bool live = true;
    int pre = lim;
    if (c.tid == 0) {
        int t0 = lim, t1 = lim;
        if ((!peek || __hip_atomic_load(q, __ATOMIC_RELAXED, __HIP_MEMORY_SCOPE_AGENT) < lim) && !(stoppable && __hip_atomic_load(flagp, __ATOMIC_RELAXED, __HIP_MEMORY_SCOPE_AGENT) != 0)) { t0 = (int)atomicInc((unsigned*)q, 0xFFFFFFFFu); t1 = (int)atomicInc((unsigned*)q, 0xFFFFFFFFu); pre = (int)atomicInc((unsigned*)q, 0xFFFFFFFFu); }
        qs[0] = t0 < lim ? t0 : -1; qs[1] = t1 < lim ? t1 : -1; }
    __syncthreads();
    int ia = __builtin_amdgcn_readfirstlane(qs[0]), ib = __builtin_amdgcn_readfirstlane(qs[1]);
    if (ia < 0) return;
    f32x4 va[16], vb[16];
    TrTile dummy; dummy.W = p.w1; dummy.WT = nullptr; dummy.K = 0; dummy.N = 0; dummy.k0 = 0; dummy.n0 = 0; dummy.perm = 0;
    TrTile ta = conv_tile(p, qsel, ia), tb = ib >= 0 ? conv_tile(p, qsel, ib) : dummy;
    tr_load(ta, va, c.tid);
    tr_load(tb, vb, c.tid);
    LDS_BAR();
#define CONV_STEP(IT, TT_, V) { tr_to_lds(V, Tl, c.tid); \
        if (c.tid == 0) { const bool ok = live && pre < lim; qs[0] = ok ? pre : -1; live = ok && flg == 0; if (live) pre = (int)atomicInc((unsigned*)q, 0xFFFFFFFFu); \
                          if (stoppable) flg = __hip_atomic_load(flagp, __ATOMIC_RELAXED, __HIP_MEMORY_SCOPE_AGENT); } \
        LDS_BAR(); \
        const int nx = __builtin_amdgcn_readfirstlane(qs[0]); const TrTile done = TT_; TT_ = nx >= 0 ? conv_tile(p, qsel, nx) : dummy; \
        tr_load(TT_, V, c.tid); \
        tr_store(done, Tl, c.tid); IT = nx; \
        LDS_BAR(); }
    CONV_STEP(ia, ta, va)
    if (ib >= 0) {
        CONV_STEP(ib, tb, vb)
        while (ia >= 0) {
            CONV_STEP(ia, ta, va)
            if (ib < 0) break;
            CONV_STEP(ib, tb, vb)
        }
    }
#undef CONV_STEP
}

DEVI void phase_hl(const Params& p, const Ctx& c) {
    const float* mod = (const float*)(p.ws + WS_MOD); bf16_t* HL = (bf16_t*)(p.ws + WS_HL);
    for (int r = c.gw; r < TT; r += c.NGW) {
        const int b = r / SEQ, s = r % SEQ; const bool isctx = s < CTXL;
        const float* src = isctx ? p.ctx + ((size_t)b * CTXL + s) * DM : p.x + ((size_t)b * LSEQ + (s - CTXL)) * DM;
        const float* mv = mod + (isctx ? 2 : b) * 6144;
        const f32x4* xr = (const f32x4*)src + c.lane; f32x4 v[4]; float ss = 0.f;
#pragma unroll
        for (int j = 0; j < 4; ++j) { v[j] = xr[64 * j]; ss += (v[j][0] * v[j][0] + v[j][1] * v[j][1]) + (v[j][2] * v[j][2] + v[j][3] * v[j][3]); }
        const float rstd = __builtin_amdgcn_rsqf(wave_sum(ss) * (1.f / DM) + EPS);
        u32x2* o8 = (u32x2*)(HL + (size_t)r * DM) + c.lane;
#pragma unroll
        for (int j = 0; j < 4; ++j) { const int k = 4 * c.lane + 256 * j;
            const f32x4 g = *(const f32x4*)(p.norm1_g + k), sh = *(const f32x4*)(mv + k), sc = *(const f32x4*)(mv + 1024 + k);
            const f32x4 y = (v[j] * rstd * g) * (sc + 1.f) + sh; u32x2 w; w.x = pk2(y[0], y[1]); w.y = pk2(y[2], y[3]); o8[64 * j] = w; }
    }
}

DEVI void phase_post(const Params& p, const Ctx& c) {
    bf16_t* P = (bf16_t*)(p.ws + WS_P); const float2* tabR = (const float2*)(p.ws + WS_TABR); const float2* tabD = (const float2*)(p.ws + WS_TABD);
    for (int r = c.gw; r < TT; r += c.NGW) {
        const int s = r % SEQ; const bool lat = s >= CTXL; const int tpos = lat ? s - CTXL : 0; const int prow = tpos >> 6, pcol = tpos & 63;
        bf16_t* pr = P + (size_t)r * NP;
        if (lat) {
            const int blk = c.lane >> 3, i8 = (c.lane & 7) * 8; const int pos = (blk & 1) ? pcol : prow;
            bf16_t* q1 = pr + C_RQ + blk * 128 + i8; const u32x4 a = *(const u32x4*)q1, bq = *(const u32x4*)(q1 + 64);
            const unsigned aw[4] = {a.x, a.y, a.z, a.w}, bw[4] = {bq.x, bq.y, bq.z, bq.w}; unsigned o1[4], o2[4];
#pragma unroll
            for (int e = 0; e < 4; ++e) { const float2 t0 = tabR[pos * 64 + i8 + 2 * e], t1 = tabR[pos * 64 + i8 + 2 * e + 1];
                const float x1a = lo_f(aw[e]), x1b = hi_f(aw[e]), x2a = lo_f(bw[e]), x2b = hi_f(bw[e]);
                o1[e] = pk2((x1a * t0.x - x2a * t0.y) * 0.0625f, (x1b * t1.x - x2b * t1.y) * 0.0625f);
                o2[e] = pk2((x1a * t0.y + x2a * t0.x) * 0.0625f, (x1b * t1.y + x2b * t1.x) * 0.0625f); }
            *(u32x4*)q1 = (u32x4){o1[0], o1[1], o1[2], o1[3]}; *(u32x4*)(q1 + 64) = (u32x4){o2[0], o2[1], o2[2], o2[3]};
            {
                const int bb = r / SEQ, hq = blk >> 1, d0 = (blk & 1) * 128 + i8, cc = s >> 7, ii = s & 127;
                bf16_t* QFp = (bf16_t*)(p.ws + WS_DV);
                *(u32x4*)(QFp + ret::qf_index(bb, hq, cc, ii >> 4, d0 >> 5, (d0 >> 3) & 3, ii & 15)) = (u32x4){o1[0], o1[1], o1[2], o1[3]};
                *(u32x4*)(QFp + ret::qf_index(bb, hq, cc, ii >> 4, (d0 >> 5) + 2, (d0 >> 3) & 3, ii & 15)) = (u32x4){o2[0], o2[1], o2[2], o2[3]};
            }
        }
#pragma unroll
        for (int which = 0; which < 2; ++which) {
            if (which == 0 && !lat) continue;
            const float* gq = which ? p.dk_g : p.dq_g;
            const int q4 = c.lane & 3; bf16_t* dp = pr + (which ? C_DK : C_DQ) + (c.lane >> 2) * 64 + q4 * 16;
            const u32x4 a = *(const u32x4*)dp, bq = *(const u32x4*)(dp + 8); const unsigned wv[8] = {a.x, a.y, a.z, a.w, bq.x, bq.y, bq.z, bq.w};
            float v[16]; float ss = 0.f;
#pragma unroll
            for (int e = 0; e < 8; ++e) { v[2 * e] = lo_f(wv[e]); v[2 * e + 1] = hi_f(wv[e]); ss += v[2 * e] * v[2 * e] + v[2 * e + 1] * v[2 * e + 1]; }
            ss += __shfl_xor(ss, 1); ss += __shfl_xor(ss, 2);
            const float rs = __builtin_amdgcn_rsqf(ss * (1.f / 64.f) + EPS) * (which ? 1.f : att::SCALE * LOG2E);
            const int pos = (q4 & 2) ? pcol : prow; unsigned ow[8]; float y[16];
#pragma unroll
            for (int e = 0; e < 16; ++e) y[e] = v[e] * rs * gq[q4 * 16 + e];
#pragma unroll
            for (int e = 0; e < 16; ++e) { const float other = __shfl_xor(y[e], 1); const float2 t = tabD[pos * 16 + e];
                y[e] = (q4 & 1) ? (other * t.y + y[e] * t.x) : (y[e] * t.x - other * t.y); }
#pragma unroll
            for (int e = 0; e < 8; ++e) ow[e] = pk2(y[2 * e], y[2 * e + 1]);
            *(u32x4*)dp = (u32x4){ow[0], ow[1], ow[2], ow[3]}; *(u32x4*)(dp + 8) = (u32x4){ow[4], ow[5], ow[6], ow[7]};
        }
    }
    bf16_t* KT = (bf16_t*)(p.ws + WS_KT); bf16_t* VT = (bf16_t*)(p.ws + WS_VT);
    bf16_t* Tl = (bf16_t*)c.lds;
    constexpr int TLD = 72;
    constexpr int NU = NB * 132 * 24;
    const int tok = c.tid >> 3, c8 = (c.tid & 7) * 8, wsw = (c.tid & 7) << 3;
    auto unit_src = [&](int u) { const int cb = u % 24, tb = (u / 24) % 132, b = u / (24 * 132); const int colbase = cb < 8 ? C_RK + cb * 128 : C_RV + (cb - 8) * 128;
        return P + ((size_t)b * SEQ + tb * 64 + tok) * NP + colbase + c8; };
    u32x4 a, bq;
    { bf16_t* s0 = unit_src(c.bid < NU ? c.bid : NU - 1); a = *(const u32x4*)s0; bq = *(const u32x4*)(s0 + 64); }
    for (int u = c.bid; u < NU; u += c.G) {
        const int cb = u % 24, tb = (u / 24) % 132, b = u / (24 * 132);
        const int s = tb * 64 + tok; const bool isk = cb < 8;
        bf16_t* src = unit_src(u);
        u32x4 an, bn; { const int un = u + c.G; bf16_t* sn = unit_src(un < NU ? un : NU - 1); an = *(const u32x4*)sn; bn = *(const u32x4*)(sn + 64); }
        if (isk) {
            const bool lat = s >= CTXL; const int tpos = lat ? s - CTXL : 0; const int pos = (cb & 1) ? (tpos & 63) : (tpos >> 6);
            const unsigned aw[4] = {a.x, a.y, a.z, a.w}, bw[4] = {bq.x, bq.y, bq.z, bq.w}; unsigned o1[4], o2[4];
#pragma unroll
            for (int e = 0; e < 4; ++e) { const float2 t0 = tabR[pos * 64 + c8 + 2 * e], t1 = tabR[pos * 64 + c8 + 2 * e + 1];
                const float x1a = lo_f(aw[e]), x1b = hi_f(aw[e]), x2a = lo_f(bw[e]), x2b = hi_f(bw[e]);
                o1[e] = pk2(x1a * t0.x - x2a * t0.y, x1b * t1.x - x2b * t1.y);
                o2[e] = pk2(x1a * t0.y + x2a * t0.x, x1b * t1.y + x2b * t1.x); }
            a = (u32x4){o1[0], o1[1], o1[2], o1[3]}; bq = (u32x4){o2[0], o2[1], o2[2], o2[3]};
            *(u32x4*)src = a; *(u32x4*)(src + 64) = bq;
        }
        { const unsigned aw[4] = {a.x, a.y, a.z, a.w}, bw[4] = {bq.x, bq.y, bq.z, bq.w}; const int tk = tok ^ wsw;
#pragma unroll
          for (int e = 0; e < 4; ++e) { Tl[(c8 + 2 * e) * TLD + tk] = (bf16_t)(aw[e] & 0xffffu); Tl[(c8 + 2 * e + 1) * TLD + tk] = (bf16_t)(aw[e] >> 16);
              Tl[(64 + c8 + 2 * e) * TLD + tk] = (bf16_t)(bw[e] & 0xffffu); Tl[(64 + c8 + 2 * e + 1) * TLD + tk] = (bf16_t)(bw[e] >> 16); } }
        LDS_BAR();
        if (isk) {
            const int col = c.tid & 127, tp = c.tid >> 7, sw = ((col >> 3) & 7) << 3; const u32x4 r0 = *(const u32x4*)(Tl + col * TLD + ((16 * tp) ^ sw)), r1 = *(const u32x4*)(Tl + col * TLD + ((16 * tp + 8) ^ sw));
            const int hk = cb >> 1, d = (cb & 1) * 128 + col, jb = (tb & 1) * 64 + 16 * tp;
            bf16_t* dst = KT + ret::ktf_index(b, hk, tb >> 1, d >> 5, jb >> 4, 0, d & 31);
            *(u32x4*)dst = r0; *(u32x4*)(dst + 32 * 8) = r1;
        } else {
          const int col = c.tid >> 2, t4 = (c.tid & 3) * 16, sw = ((col >> 3) & 7) << 3; const u32x4 r0 = *(const u32x4*)(Tl + col * TLD + (t4 ^ sw)), r1 = *(const u32x4*)(Tl + col * TLD + ((t4 + 8) ^ sw));
          bf16_t* dst = VT + ((size_t)b * 2048 + (cb - 8) * 128 + col) * SEQ + tb * 64 + t4;
          *(u32x4*)dst = r0; *(u32x4*)(dst + 8) = r1; }
        LDS_BAR();
        a = an; bq = bn;
    }
    __syncthreads();
}

DEVI int scan_map(int u, int G) { if (G != 256) return u; const int x = u & 7, j = u >> 3; return ((x + 8 * (j >> 4)) << 4) | (j & 15); }
DEVI void phase_mix(const Params& p, const Ctx& c) {
    const bf16_t* P = (const bf16_t*)(p.ws + WS_P); const bf16_t* KT = (const bf16_t*)(p.ws + WS_KT); const bf16_t* VT = (const bf16_t*)(p.ws + WS_VT);
    const float* scal = (const float*)(p.ws + WS_SCAL);
#ifndef MK_MIX_PROBE
#define MK_MIX_PROBE 0
#endif
#ifndef MK_MIX_ONLY
#define MK_MIX_ONLY 0
#endif
    const float lam = scal[8];
    const bool fixedref = __builtin_amdgcn_readfirstlane(__float_as_int(scal[9])) != 0 && scal[9] <= 60.f && scal[9] > 0.f;
    const bool attn_first = (c.G == 256) && (c.bid >= 128);
#define MIX_RET() do { for (int u = c.bid; u < 256; u += c.G) ret::scan_unit(scan_map(u & 255, c.G), (const bf16_t*)(p.ws + WS_DV), KT, VT, (bf16_t*)(p.ws + WS_OF), (bf16_t*)(p.ws + WS_OB), scal, c.lds); \
        for (int u = c.bid; u < 512; u += c.G) ret::intra_unit(u & 511, P, VT, (bf16_t*)(p.ws + WS_OI), scal, c.lds); } while (0)
    if (!attn_first) MIX_RET();
    for (int a_ = c.bid; a_ < 1024; a_ += c.G) { const int a = a_ & 1023;
        const int rr = a / c.G, wq = a % c.G; int bh, qb;
        if (c.G == 256) { const int xcd = wq & 7, j = wq >> 3; bh = xcd * 2 + (rr >> 1); qb = (rr & 1) * 32 + j; } else { bh = a >> 6; qb = a & 63; }
        const int b = bh >> 3, h = bh & 7;
        const bf16_t* Qb = P + ((size_t)b * SEQ + CTXL + qb * 128) * NP + C_DQ + h * 128;
        const bf16_t* Kh = P + ((size_t)b * SEQ) * NP + C_DK + h * 128;
        const bf16_t* Vh = P + ((size_t)b * SEQ) * NP + C_DV + h * 128;
        bf16_t* Ob = (bf16_t*)(p.ws + WS_OD) + ((size_t)b * LSEQ + qb * 128) * 1024 + h * 128;
        att::attn_unit(Qb, Kh, Vh, Ob, lam, fixedref, p.dn_g, c.lds);
    }
    if (attn_first) { __syncthreads(); MIX_RET(); }
#undef MIX_RET
}

DEVI void phase_retgate(const Params& p, const Ctx& c) {
    bf16_t* OI = (bf16_t*)(p.ws + WS_OI); const bf16_t* OF = (const bf16_t*)(p.ws + WS_OF); const bf16_t* OB = (const bf16_t*)(p.ws + WS_OB); const bf16_t* P = (const bf16_t*)(p.ws + WS_P);
    for (int it = c.gw; it < T * 4; it += c.NGW) {
        const int t = it >> 2, h = it & 3; const size_t off = (size_t)t * 2048 + h * 512 + c.lane * 8;
        const u32x4 a = *(const u32x4*)(OI + off), f = *(const u32x4*)(OF + off), bb = *(const u32x4*)(OB + off);
        const u32x4 rg = *(const u32x4*)(P + (size_t)rowc_of(t) * NP + C_RG + h * 512 + c.lane * 8);
        const unsigned aw[4] = {a.x, a.y, a.z, a.w}, fw[4] = {f.x, f.y, f.z, f.w}, bw[4] = {bb.x, bb.y, bb.z, bb.w}, gw_[4] = {rg.x, rg.y, rg.z, rg.w};
        float v[8]; float ss = 0.f;
#pragma unroll
        for (int e = 0; e < 4; ++e) { v[2 * e] = lo_f(aw[e]) + lo_f(fw[e]) + lo_f(bw[e]); v[2 * e + 1] = hi_f(aw[e]) + hi_f(fw[e]) + hi_f(bw[e]); ss += v[2 * e] * v[2 * e] + v[2 * e + 1] * v[2 * e + 1]; }
        const float rs = __builtin_amdgcn_rsqf(wave_sum(ss) * (1.f / 512.f) + EPS);
        const float* g = p.ret_norm_g + h * 512 + c.lane * 8; unsigned ow[4];
#pragma unroll
        for (int e = 0; e < 4; ++e) ow[e] = pk2(v[2 * e] * rs * g[2 * e] * siluf_(lo_f(gw_[e])), v[2 * e + 1] * rs * g[2 * e + 1] * siluf_(hi_f(gw_[e])));
        *(u32x4*)(OI + off) = (u32x4){ow[0], ow[1], ow[2], ow[3]};
    }
}

DEVI void phase_route(const Params& p, const Ctx& c) {
    constexpr int RW_LD = 1028;
    float* rwT = (float*)c.lds;
    for (int i = c.tid; i < 8 * 1024; i += 512) {
        const f32x4 w4 = ((const f32x4*)p.router_w)[i]; const int k = i >> 3, e0 = (i & 7) * 4;
        rwT[(e0 + 0) * RW_LD + k] = w4[0]; rwT[(e0 + 1) * RW_LD + k] = w4[1]; rwT[(e0 + 2) * RW_LD + k] = w4[2]; rwT[(e0 + 3) * RW_LD + k] = w4[3]; }
    __syncthreads();
    const float* mod = (const float*)(p.ws + WS_MOD); bf16_t* H2 = (bf16_t*)(p.ws + WS_HL);
    int* cnt = (int*)(p.ws + WS_CNT); int* ltok = (int*)(p.ws + WS_LTOK); float* lgate = (float*)(p.ws + WS_LGATE); int* pos = (int*)(p.ws + WS_POS);
    int2* stash = (int2*)(c.lds + 135168) + c.wave * 64; int* stok = (int*)(c.lds + 135168 + 8 * 64 * 8) + c.wave * 16; int nst = 0;
    for (int t = c.gw; t < T; t += c.NGW) {
        const int b = t >> 13; const float* mv = mod + b * 6144;
        const f32x4* xr = (const f32x4*)(p.out + (size_t)t * DM) + c.lane; f32x4 v[4]; float ss = 0.f;
#pragma unroll
        for (int j = 0; j < 4; ++j) { v[j] = xr[64 * j]; ss += (v[j][0] * v[j][0] + v[j][1] * v[j][1]) + (v[j][2] * v[j][2] + v[j][3] * v[j][3]); }
        const float rstd = __builtin_amdgcn_rsqf(wave_sum(ss) * (1.f / DM) + EPS);
        u32x2* o8 = (u32x2*)(H2 + (size_t)t * DM) + c.lane;
#pragma unroll
        for (int j = 0; j < 4; ++j) { const int k = 4 * c.lane + 256 * j;
            const f32x4 g = *(const f32x4*)(p.norm2_g + k), sh = *(const f32x4*)(mv + 3072 + k), sc = *(const f32x4*)(mv + 4096 + k);
            v[j] = (v[j] * rstd * g) * (sc + 1.f) + sh; u32x2 w; w.x = pk2(v[j][0], v[j][1]); w.y = pk2(v[j][2], v[j][3]); o8[64 * j] = w; }
        float a[32];
#pragma unroll
        for (int e = 0; e < 32; ++e) { float s = 0.f;
#pragma unroll
            for (int j = 0; j < 4; ++j) { const f32x4 wv = *(const f32x4*)(rwT + e * RW_LD + 4 * c.lane + 256 * j); s += (v[j][0] * wv[0] + v[j][1] * wv[1]) + (v[j][2] * wv[2] + v[j][3] * wv[3]); }
            a[e] = s; if ((e & 3) == 3) __builtin_amdgcn_sched_barrier(0); }
#define HALVE(N, OFF) _Pragma("unroll") for (int i = 0; i < (N) / 2; ++i) { const bool up = (c.lane & (OFF)) != 0; const float snd = up ? a[i] : a[i + (N) / 2]; const float rcv = __shfl_xor(snd, (OFF)); a[i] = (up ? a[i + (N) / 2] : a[i]) + rcv; }
        HALVE(32, 32) HALVE(16, 16) HALVE(8, 8) HALVE(4, 4) HALVE(2, 2)
#undef HALVE
        float logit = a[0] + __shfl_xor(a[0], 1); const int myE = c.lane >> 1; logit += p.router_b[myE];
        float tv[4]; int ti[4]; float cur = logit;
#pragma unroll
        for (int k = 0; k < 4; ++k) { float bv = cur; int bi = myE;
#pragma unroll
            for (int o = 1; o < 64; o <<= 1) { const float ov = __shfl_xor(bv, o); const int oi = __shfl_xor(bi, o); if (ov > bv || (ov == bv && oi < bi)) { bv = ov; bi = oi; } }
            tv[k] = bv; ti[k] = bi; if (myE == bi) cur = -3.0e38f; }
        const float e1 = __expf(tv[1] - tv[0]), e2 = __expf(tv[2] - tv[0]), e3 = __expf(tv[3] - tv[0]); const float inv = 1.f / (1.f + e1 + e2 + e3);
        if (c.lane < 4) { const int k = c.lane; const int e = k == 0 ? ti[0] : (k == 1 ? ti[1] : (k == 2 ? ti[2] : ti[3])); const float g = (k == 0 ? 1.f : (k == 1 ? e1 : (k == 2 ? e2 : e3))) * inv;
            stash[nst * 4 + k] = make_int2(e, __float_as_int(g)); }
        if (c.lane == 0) stok[nst] = t;
        ++nst;
        if (nst == 16 || t + c.NGW >= T) {
            asm volatile("s_waitcnt lgkmcnt(0)" ::: "memory");
            if (c.lane < nst * 4) { const int2 eg = stash[c.lane]; const int tt = stok[c.lane >> 2], e = eg.x;
                const int slot = atomicAdd(cnt + e, 1); ltok[e * CAP + slot] = tt; lgate[e * CAP + slot] = __int_as_float(eg.y); pos[tt * 4 + (c.lane & 3)] = e * CAP + slot; }
            asm volatile("s_waitcnt lgkmcnt(0)" ::: "memory");
            nst = 0; }
    }
    __syncthreads();
}

DEVI int build_tiles(const Params& p, const Ctx& c) {
    LAS int* tb = (LAS int*)(c.lds + LDS_TAB);
    const int* cnt = (const int*)(p.ws + WS_CNT);
    if (c.tid < 32) tb[576 + c.tid] = cnt[c.tid];
    __syncthreads();
    if (c.tid < 32) {
        const int e = c.tid; int base = 0, tot = 0;
        for (int j = 0; j < 32; ++j) { const int nj = (tb[576 + j] + 255) >> 8; base += j < e ? nj : 0; tot += nj; }
        const int n = (tb[576 + e] + 255) >> 8; tb[608 + e] = base;
        for (int i = 0; i < n; ++i) { tb[base + i] = e; tb[288 + base + i] = i * 256; }
        if (e == 0) tb[640] = tot; }
    __syncthreads();
    return tb[640];
}

DEVI void phase_combine(const Params& p, const Ctx& c) {
    const int NT = build_tiles(p, c); (void)NT;
    const int lane = lane_id_fresh();
    LAS int* tb = (LAS int*)(c.lds + LDS_TAB);
    const float* mod = (const float*)(p.ws + WS_MOD); const int* pos = (const int*)(p.ws + WS_POS); const bf16_t* Y = (const bf16_t*)(p.ws + WS_Y);
    for (int t = c.gw; t < T; t += c.NGW) {
        const int b = t >> 13; size_t yr[4];
#pragma unroll
        for (int k = 0; k < 4; ++k) { const int pp = pos[t * 4 + k]; const int e = pp >> 14, slot = pp & (CAP - 1); yr[k] = (size_t)(tb[608 + e] * 256 + slot) * 1024; }
        float* orow = p.out + (size_t)t * DM;
#pragma unroll
        for (int j = 0; j < 2; ++j) { const int k0 = lane * 8 + 512 * j; float s[8] = {0.f, 0.f, 0.f, 0.f, 0.f, 0.f, 0.f, 0.f};
#pragma unroll
            for (int k = 0; k < 4; ++k) { const u32x4 y = *(const u32x4*)(Y + yr[k] + k0); s[0] += lo_f(y.x); s[1] += hi_f(y.x); s[2] += lo_f(y.y); s[3] += hi_f(y.y); s[4] += lo_f(y.z); s[5] += hi_f(y.z); s[6] += lo_f(y.w); s[7] += hi_f(y.w); }
            const float* gp = mod + b * 6144 + 5120 + k0;
            f32x4 x0 = *(const f32x4*)(orow + k0), x1 = *(const f32x4*)(orow + k0 + 4);
            const f32x4 g0 = *(const f32x4*)gp, g1 = *(const f32x4*)(gp + 4);
            x0 += g0 * (f32x4){s[0], s[1], s[2], s[3]}; x1 += g1 * (f32x4){s[4], s[5], s[6], s[7]};
            *(f32x4*)(orow + k0) = x0; *(f32x4*)(orow + k0 + 4) = x1; }
    }
}

__global__ void __launch_bounds__(512, 2) mk_fwd(Params p) {
    extern __shared__ __attribute__((aligned(16))) unsigned char lds_raw[];
    Ctx c; c.tid = threadIdx.x; c.lane = c.tid & 63; c.wave = __builtin_amdgcn_readfirstlane(c.tid >> 6); c.G = gridDim.x; c.bid = blockIdx.x;
    c.gw = c.bid * 8 + c.wave; c.NGW = c.G * 8; c.lds = (char*)lds_raw;
    LAS unsigned char* lds = (LAS unsigned char*)lds_raw;
    unsigned char* ws = p.ws;
    const int lo = p.ph_lo, hi = p.ph_hi;
#define IN(k) (lo <= (k) && (k) < hi)
#ifndef MK_REPEAT_PHASE
#define MK_REPEAT_PHASE (-1)
#define MK_REPEAT_N 0
#endif
#define REPS(k)
    volatile LAS unsigned* bst = (volatile LAS unsigned*)(lds + LDS_BYTES - 16);
    if (c.tid < 4) bst[c.tid] = 0u;
    __syncthreads();
    if (lo == 0 && hi == NPH) {
        { const int i = c.bid * 512 + c.tid; if (i < (int)(WS_ZERO_BYTES / 4)) { ((unsigned*)ws)[i] = 0u; __threadfence(); } }
        cg::this_grid().sync();
    }
    XcdBarrier xbar = xcd_barrier_post((unsigned*)(ws + WS_BAR), bst);
#define SEAM(k) do { if (IN(k) && IN((k) + 1)) xcd_barrier(xbar); } while (0)
#define PH0 { phase_prep(p, c); }
#define PH1 { phase_hl(p, c); }
#define PH2 { const int ncv = pg8::conv_count((TT / 256) * (NP / 256), c.G); \
        if (c.bid < c.G - ncv) { pg8::ProbDense S; S.init(ws + WS_HL, ws + WS_WIN, TT, NP, 1024, c.G, c.bid, ncv); EpiStoreBf16 E{(bf16_t*)(ws + WS_P), NP}; pg8::gemm_phase(lds, S, E); \
            if (c.tid == 0) atomicAdd((int*)(ws + WS_Q) + 128, 1); conv_run(p, c, 0, true, false); } \
        else { conv_run(p, c, 0, false, false); conv_run(p, c, 1, false, true); } }
#define PH3 { phase_post(p, c); }
#define PH4 { phase_mix(p, c); }
#define PH5 { phase_retgate(p, c); }
#define PH6 { { pg8::ProbDense S; S.init(ws + WS_OI, ws + WS_WBR, T, 1024, 2048, c.G, c.bid); EpiGate1 E{(float*)(ws + WS_OF), (const bf16_t*)(ws + WS_P)}; pg8::gemm_phase(lds, S, E); } \
        __syncthreads(); \
        { pg8::ProbDense S; S.init(ws + WS_OD, ws + WS_WBD, T, 1024, 1024, c.G, c.bid); EpiGate2 E{(const float*)(ws + WS_OF), (bf16_t*)(ws + WS_OB), (const bf16_t*)(ws + WS_P)}; pg8::gemm_phase(lds, S, E); } }
#define PH7 { pg8::ProbDense S; S.init(ws + WS_OB, ws + WS_WOUT, T, 1024, 1024, c.G, c.bid); EpiResid E{p.x, p.out, (const float*)(ws + WS_MOD)}; pg8::gemm_phase(lds, S, E); }
#define PH8 { phase_route(p, c); }
#define PH9 { const int NT = build_tiles(p, c); LAS int* tb = (LAS int*)(c.lds + LDS_TAB); \
        const int ncv = pg8::conv_count(NT * 8, c.G); \
        if (c.bid < c.G - ncv) { pg8::ProbMoe S; S.A = (const char*)(ws + WS_HL); S.Bt = (const char*)(ws + WS_W1); S.K = 1024; S.nN = 8; S.NT = NT; S.G = c.G; S.c = c.bid; S.nconv = ncv; S.bstride = (size_t)2048 * 1024 * 2; \
            S.tile_e = tb; S.tile_s0 = tb + 288; S.cnt = tb + 576; S.ltok = (const int*)(ws + WS_LTOK); S.gather = true; \
            EpiSwiglu E{(bf16_t*)(ws + WS_ACT), p.b1}; pg8::gemm_phase(lds, S, E); } \
        conv_run(p, c, 1, c.bid < c.G - ncv, false); }
#define PH10 { const int NT = build_tiles(p, c); LAS int* tb = (LAS int*)(c.lds + LDS_TAB); \
        pg8::ProbMoe S; S.A = (const char*)(ws + WS_ACT); S.Bt = (const char*)(ws + WS_W2); S.K = 1024; S.nN = 4; S.NT = NT; S.G = c.G; S.c = c.bid; S.nconv = 0; S.bstride = (size_t)1024 * 1024 * 2; \
        S.tile_e = tb; S.tile_s0 = tb + 288; S.cnt = tb + 576; S.ltok = (const int*)(ws + WS_LTOK); S.gather = false; \
        EpiMoe2 E{(bf16_t*)(ws + WS_Y), p.b2, (const float*)(ws + WS_LGATE), tb + 288, tb + 576}; pg8::gemm_phase(lds, S, E); }
#define PH11 { phase_combine(p, c); }
#ifndef MK_DUP
#define MK_DUP (-1)
#endif
#ifndef MK_ONLY
#define MK_ONLY (-1)
#endif
#define RUN(k, BODY) do { if ((MK_ONLY < 0 || MK_ONLY == (k)) && IN(k)) { BODY if (MK_DUP == (k)) { xcd_barrier(xbar); BODY } } SEAM(k); } while (0)
    RUN(0, PH0); RUN(1, PH1); RUN(2, PH2); RUN(3, PH3);
    if (MK_DUP == 23 && IN(3)) { PH2 xcd_barrier(xbar); PH3 xcd_barrier(xbar); }
    RUN(4, PH4); RUN(5, PH5); RUN(6, PH6); RUN(7, PH7); RUN(8, PH8); RUN(9, PH9); RUN(10, PH10);
    if ((MK_ONLY < 0 || MK_ONLY == 11) && IN(11)) PH11
#undef IN
#undef SEAM
}


extern "C" void kernel_launch(void* const* d_in, const int* in_sizes, int n_in, void* d_out, int out_size, void* d_ws, size_t ws_size, hipStream_t stream) {
    static int grid = 0;
    if (grid == 0) {
        if (n_in != 24 || ws_size < WS_END) { fprintf(stderr, "kernel_launch: unexpected inputs (n_in %d, ws %zu, need %zu)\n", n_in, ws_size, (size_t)WS_END); grid = -1; return; }
        int dev = 0, cus = 0, per_cu = 0;
        (void)hipGetDevice(&dev); (void)hipDeviceGetAttribute(&cus, hipDeviceAttributeMultiprocessorCount, dev);
        if (hipFuncSetAttribute((const void*)mk_fwd, hipFuncAttributeMaxDynamicSharedMemorySize, LDS_BYTES) != hipSuccess) { fprintf(stderr, "kernel_launch: hipFuncSetAttribute failed\n"); grid = -1; return; }
        if (hipOccupancyMaxActiveBlocksPerMultiprocessor(&per_cu, (const void*)mk_fwd, 512, LDS_BYTES) != hipSuccess || per_cu < 1) { fprintf(stderr, "kernel_launch: occupancy query says %d\n", per_cu); per_cu = 1; }
        (void)hipGetLastError();
        grid = cus;
    }
    if (grid < 0) return;
#if !MK_ONE_LAUNCH
    (void)hipMemsetAsync((char*)d_ws, 0, WS_ZERO_BYTES, stream);
#endif
    Params p{};
    const float** pp = (const float**)&p;
    for (int i = 0; i < 24; ++i) pp[i] = (const float*)d_in[i];
    p.out = (float*)d_out; p.ws = (unsigned char*)d_ws;
#if MK_ONE_LAUNCH
    p.ph_lo = 0; p.ph_hi = NPH;
    void* args[] = {&p};
    hipError_t e = hipLaunchCooperativeKernel((const void*)mk_fwd, dim3(grid), dim3(512), args, LDS_BYTES, stream);
    if (e != hipSuccess) fprintf(stderr, "cooperative launch failed: %s (grid %d)\n", hipGetErrorString(e), grid);
#else
#ifndef MK_LAST_PHASE
#define MK_LAST_PHASE (NPH - 1)
#endif
    for (int ph = 0; ph <= MK_LAST_PHASE; ++ph) {
        p.ph_lo = ph; p.ph_hi = ph + 1;
        hipLaunchKernelGGL(mk_fwd, dim3(grid), dim3(512), LDS_BYTES, stream, p);
    }

#endif
}
```
